# Optimizing an MI355X kernel written in HIP

```python
import jax, jax.numpy as jnp
from jax import lax
import numpy as np

D_MODEL = 1024
BATCH = 8
SEQ = 2048
DEPTH = 2

N_HEADS_ATT = 8
HEAD_DIM_ATT = 64
ATT_WIDTH = N_HEADS_ATT * HEAD_DIM_ATT
MOBA_BLOCK = 256
MOBA_TOPK = 3
MOBA_QCHUNK = 16
N_HEADS_RW = 8
HEAD_DIM_RW = 64
RW_WIDTH = N_HEADS_RW * HEAD_DIM_RW
DECAY_LORA = 64
ICLR_LORA = 64
VMIX_LORA = 32
RW_SHIFT_WIDTH = 3 * RW_WIDTH + DECAY_LORA + ICLR_LORA
IN_WIDTHS = (ATT_WIDTH, ATT_WIDTH, ATT_WIDTH, ATT_WIDTH, RW_SHIFT_WIDTH, RW_WIDTH, D_MODEL, D_MODEL)
D_IN = 4 * ATT_WIDTH + RW_SHIFT_WIDTH + RW_WIDTH + 2 * D_MODEL
RMS_EPS = 1e-6
GN_EPS = 64e-5
L2_EPS = 1e-12
NEG_INF = -1e30

kernel_name = "hybrid_moba_rwkv7_gated_block"


def split_cols(p, widths):
    idx = np.cumsum(np.array(widths))[:-1].tolist()
    return jnp.split(p, idx, axis=-1)


def rmsnorm(x, g):
    xf = x.astype(jnp.float32)
    y = xf * lax.rsqrt(jnp.mean(xf * xf, axis=-1, keepdims=True) + RMS_EPS)
    return (y * g.astype(jnp.float32)).astype(x.dtype)


def token_shift_mix(y, mu):
    prev = jnp.pad(y[:, :-1], ((0, 0), (1, 0), (0, 0)))
    return y + (prev - y) * mu


def alibi_slopes(n_heads):
    return 2.0 ** (-8.0 * jnp.arange(1, n_heads + 1, dtype=jnp.float32) / n_heads)


def moba_attention(q, k, v):
    B, S, H, Dh = q.shape
    nb = -(-S // MOBA_BLOCK)
    Sp = nb * MOBA_BLOCK
    nc = Sp // MOBA_QCHUNK
    kk = min(MOBA_TOPK, nb)

    def prep(t):
        return jnp.pad(jnp.transpose(t, (0, 2, 1, 3)), ((0, 0), (0, 0), (0, Sp - S), (0, 0)))

    q = prep(q) * (Dh ** -0.5)
    k = prep(k)
    v = prep(v)
    kb = k.reshape(B, H, nb, MOBA_BLOCK, Dh)
    vb = v.reshape(B, H, nb, MOBA_BLOCK, Dh)

    kmean = jnp.mean(kb.astype(jnp.float32), axis=3)
    gate = jnp.einsum('bhsd,bhnd->bhsn', q.astype(jnp.float32), kmean)
    qblk = jnp.arange(Sp) // MOBA_BLOCK
    past = jnp.arange(nb)[None, :] < qblk[:, None]
    gate = jnp.where(past, gate, NEG_INF)
    _, sel = lax.top_k(gate, kk)

    slopes = alibi_slopes(H)
    bi = jnp.arange(B)[:, None, None, None]
    hi = jnp.arange(H)[None, :, None, None]
    kpos_in = jnp.arange(MOBA_BLOCK)

    def chunk(args):
        qc, selc, start = args
        blk = start // MOBA_BLOCK
        qpos = (start + jnp.arange(MOBA_QCHUNK)).astype(jnp.float32)
        ksel = kb[bi, hi, selc]
        vsel = vb[bi, hi, selc]
        spos = (selc[..., None] * MOBA_BLOCK + kpos_in).astype(jnp.float32)
        ls = jnp.einsum('bhqd,bhqjkd->bhqjk', qc, ksel).astype(jnp.float32)
        ls = ls - slopes[None, :, None, None, None] * (qpos[None, None, :, None, None] - spos)
        ls = jnp.where((selc < blk)[..., None], ls, NEG_INF)
        kown = lax.dynamic_index_in_dim(kb, blk, axis=2, keepdims=False)
        vown = lax.dynamic_index_in_dim(vb, blk, axis=2, keepdims=False)
        opos = (blk * MOBA_BLOCK + kpos_in).astype(jnp.float32)
        dist = qpos[:, None] - opos[None, :]
        lo = jnp.einsum('bhqd,bhkd->bhqk', qc, kown).astype(jnp.float32)
        lo = lo - slopes[None, :, None, None] * dist
        lo = jnp.where(dist >= 0, lo, NEG_INF)
        logits = jnp.concatenate([ls.reshape(B, H, MOBA_QCHUNK, kk * MOBA_BLOCK), lo], axis=-1)
        p = jax.nn.softmax(logits, axis=-1).astype(vb.dtype)
        psel = p[..., :kk * MOBA_BLOCK].reshape(B, H, MOBA_QCHUNK, kk, MOBA_BLOCK)
        pown = p[..., kk * MOBA_BLOCK:]
        return (jnp.einsum('bhqjk,bhqjkd->bhqd', psel, vsel)
                + jnp.einsum('bhqk,bhkd->bhqd', pown, vown))

    qcs = jnp.moveaxis(q.reshape(B, H, nc, MOBA_QCHUNK, Dh), 2, 0)
    sels = jnp.moveaxis(sel.reshape(B, H, nc, MOBA_QCHUNK, kk), 2, 0)
    starts = jnp.arange(nc) * MOBA_QCHUNK
    out = lax.map(chunk, (qcs, sels, starts))
    out = jnp.moveaxis(out, 0, 2).reshape(B, H, Sp, Dh)[:, :, :S]
    return jnp.transpose(out, (0, 2, 1, 3)).reshape(B, S, H * Dh)


def rwkv7_scan(r, w, k, v, kk, a):
    B, S, H, N = r.shape

    def step(state, inp):
        r_t, w_t, k_t, v_t, kk_t, a_t = inp
        sa = jnp.einsum('bhvk,bhk->bhv', state, -kk_t)
        state = (state * w_t[:, :, None, :]
                 + sa[..., None] * (kk_t * a_t)[:, :, None, :]
                 + v_t[..., None] * k_t[:, :, None, :])
        return state, jnp.einsum('bhvk,bhk->bhv', state, r_t)

    xs = tuple(jnp.moveaxis(t.astype(jnp.float32), 1, 0) for t in (r, w, k, v, kk, a))
    state0 = jnp.zeros((B, H, N, N), jnp.float32)
    _, out = lax.scan(step, state0, xs)
    return jnp.moveaxis(out, 0, 1)


def head_groupnorm(o, g, b):
    B, S, H, N = o.shape
    mu = jnp.mean(o, axis=-1, keepdims=True)
    var = jnp.mean(jnp.square(o - mu), axis=-1, keepdims=True)
    on = ((o - mu) * lax.rsqrt(var + GN_EPS)).reshape(B, S, H * N)
    return on * g.astype(jnp.float32) + b.astype(jnp.float32)


def setup_inputs(seed: int = 0) -> dict:
    key = jax.random.key(seed)
    ks = jax.random.split(key, 24)
    f32 = jnp.float32
    L, D, Lv = DEPTH, D_MODEL, DEPTH - 1

    def nrm(k, shape, scale):
        return jax.random.normal(k, shape, f32) * scale

    return {
        "x": nrm(ks[0], (BATCH, SEQ, D), 1.0),
        "norm_pre": 1.0 + nrm(ks[1], (L, D), 0.05),
        "norm_post": 1.0 + nrm(ks[2], (L, D), 0.05),
        "w_in": nrm(ks[3], (L, D, D_IN), D ** -0.5),
        "rw_mu": jax.random.uniform(ks[4], (L, RW_SHIFT_WIDTH), f32, 0.0, 1.0),
        "rw_w0": jax.random.uniform(ks[5], (L, RW_WIDTH), f32, -6.0, 0.5),
        "rw_w_up": nrm(ks[6], (L, DECAY_LORA, RW_WIDTH), 0.1 * DECAY_LORA ** -0.5),
        "rw_a0": nrm(ks[7], (L, RW_WIDTH), 0.5),
        "rw_a_up": nrm(ks[8], (L, ICLR_LORA, RW_WIDTH), 0.5 * ICLR_LORA ** -0.5),
        "rw_k_k": 0.85 + nrm(ks[9], (L, RW_WIDTH), 0.05),
        "rw_k_a": 1.0 + nrm(ks[10], (L, RW_WIDTH), 0.05),
        "rw_r_k": nrm(ks[11], (L, RW_WIDTH), 0.1),
        "rw_ln_g": 1.0 + nrm(ks[12], (L, RW_WIDTH), 0.05),
        "rw_ln_b": nrm(ks[13], (L, RW_WIDTH), 0.02),
        "rw_vmix_down": nrm(ks[14], (Lv, D, VMIX_LORA), D ** -0.5),
        "rw_vmix_mu": jax.random.uniform(ks[15], (Lv, VMIX_LORA), f32, 0.0, 1.0),
        "rw_vmix_up": nrm(ks[16], (Lv, VMIX_LORA, RW_WIDTH), 0.5 * VMIX_LORA ** -0.5),
        "rw_vmix0": nrm(ks[17], (Lv, RW_WIDTH), 0.5),
        "w_up_att": nrm(ks[18], (L, ATT_WIDTH, D), ATT_WIDTH ** -0.5),
        "w_up_rw": nrm(ks[19], (L, RW_WIDTH, D), RW_WIDTH ** -0.5),
        "w_out": nrm(ks[20], (L, D, D), D ** -0.5),
    }


def reference(x, norm_pre, norm_post, w_in, rw_mu, rw_w0, rw_w_up, rw_a0, rw_a_up, rw_k_k, rw_k_a,
              rw_r_k, rw_ln_g, rw_ln_b, rw_vmix_down, rw_vmix_mu, rw_vmix_up, rw_vmix0,
              w_up_att, w_up_rw, w_out):
    B, S, _ = x.shape
    v_first = None
    for l in range(DEPTH):
        h = rmsnorm(x, norm_pre[l])
        proj = jnp.einsum('bsd,de->bse', h, w_in[l])
        aq, ak, av, az, rw_stream, rz, g_att, g_rw = split_cols(proj, IN_WIDTHS)

        heads_a = lambda t: t.reshape(B, S, N_HEADS_ATT, HEAD_DIM_ATT)
        ya = moba_attention(heads_a(aq), heads_a(ak), heads_a(av)).astype(x.dtype)
        ya = ya * jax.nn.silu(az)

        rs, ksr, vs, wd, ad = split_cols(token_shift_mix(rw_stream, rw_mu[l]),
                                         (RW_WIDTH, RW_WIDTH, RW_WIDTH, DECAY_LORA, ICLR_LORA))
        w_log = -jax.nn.softplus(-(rw_w0[l] + jnp.tanh(wd) @ rw_w_up[l])) - 0.5
        decay = jnp.exp(-jnp.exp(w_log.astype(jnp.float32)))
        a = jax.nn.sigmoid(rw_a0[l] + ad @ rw_a_up[l])
        if l == 0:
            v_first = vs
            vr = vs
        else:
            vd = token_shift_mix(h @ rw_vmix_down[l - 1], rw_vmix_mu[l - 1])
            vr = vs + (v_first - vs) * jax.nn.sigmoid(rw_vmix0[l - 1] + vd @ rw_vmix_up[l - 1])
        heads_b = lambda t: t.reshape(B, S, N_HEADS_RW, HEAD_DIM_RW)
        kkf = heads_b(ksr * rw_k_k[l]).astype(jnp.float32)
        kkf = kkf / jnp.maximum(jnp.sqrt(jnp.sum(kkf * kkf, axis=-1, keepdims=True)), L2_EPS)
        kmod = ksr * (1.0 + (a - 1.0) * rw_k_a[l])
        o = rwkv7_scan(heads_b(rs), heads_b(decay), heads_b(kmod), heads_b(vr), kkf, heads_b(a))
        o = head_groupnorm(o, rw_ln_g[l], rw_ln_b[l])
        bonus = (jnp.sum(heads_b((rs * kmod * rw_r_k[l]).astype(jnp.float32)), axis=-1, keepdims=True)
                 * heads_b(vr.astype(jnp.float32))).reshape(B, S, RW_WIDTH)
        yb = (o + bonus).astype(x.dtype) * jax.nn.silu(rz)

        u = (jax.nn.sigmoid(g_att) * (ya @ w_up_att[l])
             + jax.nn.sigmoid(g_rw) * (yb @ w_up_rw[l]))
        y = u @ w_out[l]
        x = x + rmsnorm(y, norm_post[l])
    return x
```

```cpp
#ifndef MK_SINGLE
#define MK_SINGLE 0
#endif
#include <hip/hip_runtime.h>
#include <cstdio>
#include <cstdint>
namespace pg8 {
#define PG8_LAS __attribute__((address_space(3)))
typedef unsigned short bf16_t;
typedef short bf16x8 __attribute__((ext_vector_type(8)));
typedef float f32x4 __attribute__((ext_vector_type(4)));
typedef unsigned u32x4 __attribute__((ext_vector_type(4)));
constexpr int BM = 256, BK = 64, HALF = 128, HTB = HALF * BK * 2  , STAGE_BYTES = 8 * HTB, NXCD = 8, WGM = 8;

__host__ __device__ __forceinline__ int lds_byte(int r, int c) { const int st = (r >> 4) * 2 + (c >> 5), rr = r & 15, cc = c & 31, ob = rr * 64 + cc * 2; return st * 1024 + (ob ^ (((ob >> 9) & 1) << 5)); }
__host__ __device__ __forceinline__ void stage_rc(int b, int& R, int& C) { const int st = b / 1024, sb = b % 1024, swz = sb ^ (((sb >> 9) & 1) << 5); R = (st >> 1) * 16 + swz / 64; C = (st & 1) * 32 + (swz % 64) / 2; }
__host__ __device__ __forceinline__ int perm32(int rho) { const int n = rho >> 4, i = rho & 15; return 8 * (i >> 2) + 4 * n + (i & 3); }

struct Unit { int pm, pn; };
struct Gemm { const bf16_t* A; const bf16_t* Bt; int M, N, K; };

struct StaticOrder {
    int nM, nN, nwg, G, c;
    __host__ __device__ void init(int M, int N, int G_, int c_) { nM = M / BM; nN = N / BM; nwg = nM * nN; G = G_; c = c_; }
    __host__ __device__ bool next(int i, Unit& u) const {
        const long L = (long)i * G + c; if (L >= nwg) return false;
        int wgid = (int)L; { const int q = nwg / NXCD, r = nwg % NXCD, xcd = wgid % NXCD, off = wgid / NXCD; wgid = (xcd < r ? xcd * (q + 1) : r * (q + 1) + (xcd - r) * q) + off; }
        const int nig = WGM * nN, gid = wgid / nig, fm = gid * WGM, gsz = (nM - fm) < WGM ? (nM - fm) : WGM;
        u.pm = fm + ((wgid % nig) % gsz); u.pn = (wgid % nig) / gsz; return true;
    }
    __device__ __forceinline__ void a_ready(const Unit&) const {}
    __device__ __forceinline__ void done(const Unit&) const {}
};


__device__ __forceinline__ unsigned cvt_pk_bf16(float lo, float hi) { unsigned r; asm volatile("v_cvt_pk_bf16_f32 %0, %1, %2" : "=v"(r) : "v"(lo), "v"(hi)); return r; }
__device__ __forceinline__ float bf_lo(unsigned w) { return __builtin_bit_cast(float, w << 16); }
__device__ __forceinline__ float bf_hi(unsigned w) { return __builtin_bit_cast(float, w & 0xffff0000u); }
__device__ __forceinline__ float sigmoidf_(float x) { return 1.0f / (1.0f + __expf(-x)); }

struct EpiProjA {
    static constexpr bool PERM = true, AFTER_DRAIN = false;
    const float* rinv; bf16_t* base0;
    __device__ __forceinline__ void operator()(const f32x4 (&acc)[2][2][4][2], const Unit& u, int wr, int wc, int fr, int fq) const {
        const int row0 = u.pm * BM + wr * 64 + fr;
#pragma unroll
        for (int bj = 0; bj < 2; ++bj) {
            const int colw = u.pn * BM + bj * HALF + wc * 32;
            size_t boff; int ld, c;
            if (colw < 2048) { boff = (size_t)(colw >> 9) * (8u << 20); ld = 512; c = colw & 511; }
            else if (colw < 3712) { boff = (size_t)5 * (8u << 20); ld = 1664; c = colw - 2048; }
            else if (colw < 4224) { boff = (size_t)4 * (8u << 20); ld = 512; c = colw - 3712; }
            else if (colw < 4256) { boff = (size_t)5 * (8u << 20) + (size_t)26 * (1u << 20); ld = 32; c = colw - 4224; }
            else continue;
            bf16_t* base = base0 + boff + c + 8 * fq;
#pragma unroll
            for (int ai = 0; ai < 2; ++ai)
#pragma unroll
                for (int m = 0; m < 4; ++m) {
                    const int row = row0 + ai * HALF + m * 16; const float rs = rinv[row];
                    const f32x4 v0 = acc[ai][bj][m][0] * rs, v1 = acc[ai][bj][m][1] * rs;
                    u32x4 w; w.x = cvt_pk_bf16(v0[0], v0[1]); w.y = cvt_pk_bf16(v0[2], v0[3]); w.z = cvt_pk_bf16(v1[0], v1[1]); w.w = cvt_pk_bf16(v1[2], v1[3]);
                    *(u32x4*)(base + (size_t)row * ld) = w;
                }
        }
    }
};
struct EpiProjB {
    static constexpr bool PERM = true, AFTER_DRAIN = false;
    const float* rinv; bf16_t *GA, *GR;
    __device__ __forceinline__ void operator()(const f32x4 (&acc)[2][2][4][2], const Unit& u, int wr, int wc, int fr, int fq) const {
        const int row0 = u.pm * BM + wr * 64 + fr;
#pragma unroll
        for (int bj = 0; bj < 2; ++bj) {
            const int colw = u.pn * BM + bj * HALF + wc * 32;
            bf16_t* base = (colw < 1024 ? GA : GR) + (colw & 1023) + 8 * fq;
#pragma unroll
            for (int ai = 0; ai < 2; ++ai)
#pragma unroll
                for (int m = 0; m < 4; ++m) {
                    const int row = row0 + ai * HALF + m * 16; const float rs = rinv[row];
                    f32x4 v0 = acc[ai][bj][m][0] * rs, v1 = acc[ai][bj][m][1] * rs;
#pragma unroll
                    for (int e = 0; e < 4; ++e) { v0[e] = sigmoidf_(v0[e]); v1[e] = sigmoidf_(v1[e]); }
                    u32x4 w; w.x = cvt_pk_bf16(v0[0], v0[1]); w.y = cvt_pk_bf16(v0[2], v0[3]); w.z = cvt_pk_bf16(v1[0], v1[1]); w.w = cvt_pk_bf16(v1[2], v1[3]);
                    *(u32x4*)(base + (size_t)row * 1024) = w;
                }
        }
    }
};
template <bool ADD> struct EpiUp {
    static constexpr bool PERM = true, AFTER_DRAIN = false;
    const bf16_t* G; bf16_t* U;
    __device__ __forceinline__ void operator()(const f32x4 (&acc)[2][2][4][2], const Unit& u, int wr, int wc, int fr, int fq) const {
        const int row0 = u.pm * BM + wr * 64 + fr;
#pragma unroll
        for (int bj = 0; bj < 2; ++bj) {
            const int c = u.pn * BM + bj * HALF + wc * 32 + 8 * fq;
#pragma unroll
            for (int ai = 0; ai < 2; ++ai)
#pragma unroll
                for (int m = 0; m < 4; ++m) {
                    const size_t off = (size_t)(row0 + ai * HALF + m * 16) * 1024 + c;
                    const u32x4 g = *(const u32x4*)(G + off);
                    f32x4 v0 = acc[ai][bj][m][0], v1 = acc[ai][bj][m][1];
                    v0[0] *= bf_lo(g.x); v0[1] *= bf_hi(g.x); v0[2] *= bf_lo(g.y); v0[3] *= bf_hi(g.y);
                    v1[0] *= bf_lo(g.z); v1[1] *= bf_hi(g.z); v1[2] *= bf_lo(g.w); v1[3] *= bf_hi(g.w);
                    if (ADD) { const u32x4 p = *(const u32x4*)(U + off);
                        v0[0] += bf_lo(p.x); v0[1] += bf_hi(p.x); v0[2] += bf_lo(p.y); v0[3] += bf_hi(p.y);
                        v1[0] += bf_lo(p.z); v1[1] += bf_hi(p.z); v1[2] += bf_lo(p.w); v1[3] += bf_hi(p.w); }
                    u32x4 w; w.x = cvt_pk_bf16(v0[0], v0[1]); w.y = cvt_pk_bf16(v0[2], v0[3]); w.z = cvt_pk_bf16(v1[0], v1[1]); w.w = cvt_pk_bf16(v1[2], v1[3]);
                    *(u32x4*)(U + off) = w;
                }
        }
    }
};
struct EpiF32 {
    static constexpr bool PERM = false, AFTER_DRAIN = false;
    float* O; int ldc;
    __device__ __forceinline__ void operator()(const f32x4 (&acc)[2][2][4][2], const Unit& u, int wr, int wc, int fr, int fq) const {
        const int row0 = u.pm * BM + wr * 64 + fr, col0 = u.pn * BM + wc * 32 + 4 * fq;
#pragma unroll
        for (int ai = 0; ai < 2; ++ai)
#pragma unroll
            for (int m = 0; m < 4; ++m) { float* rowp = O + (size_t)(row0 + ai * HALF + m * 16) * ldc + col0;
#pragma unroll
                for (int bj = 0; bj < 2; ++bj)
#pragma unroll
                    for (int n = 0; n < 2; ++n) *(f32x4*)(rowp + bj * HALF + n * 16) = acc[ai][bj][m][n]; }
    }
};
template <class Epi, class Sched, bool ALIGN_EPI = false, bool SP2 = false>
__device__ __forceinline__ void gemm_phase(PG8_LAS unsigned char* lds, const Gemm g, const Sched& S, const Epi& E) {
    int tid_o = threadIdx.x; asm volatile("" : "+v"(tid_o));
    const int tid = tid_o, wid = __builtin_amdgcn_readfirstlane(tid >> 6), lane = tid & 63, wr = wid >> 2, wc = wid & 3, fr = lane & 15, fq = lane >> 4;
    const int K = g.K, nt = K / BK;
    unsigned voffA[2], voffB[2];
#pragma unroll
    for (int i = 0; i < 2; ++i) { int R, C; stage_rc(tid * 16 + i * 8192, R, C); const int Rb = Epi::PERM ? ((R & ~31) + perm32(R & 31)) : R;
        voffA[i] = (unsigned)(R * K + C) * 2u; voffB[i] = (unsigned)(Rb * K + C) * 2u; }
    const size_t kstep = (size_t)(BK * 2);
    const size_t hstep = (size_t)HALF * K * 2;
    const size_t tstep = 2 * hstep;
    const unsigned ldsw = (unsigned)wid * 1024u;
    const int aoff = lds_byte(wr * 64 + fr, fq * 8), boff = lds_byte(wc * 32 + fr, fq * 8);
#define PG8_SA(b, h) (((b) * 2 + (h)) * HTB)
#define PG8_SB(b, h) ((4 + (b) * 2 + (h)) * HTB)
#define PG8_STAGE(bufoff, gbase, voff) do { _Pragma("unroll") for (int _i = 0; _i < 2; ++_i) \
        __builtin_amdgcn_global_load_lds((const unsigned*)((const char*)(gbase) + (voff)[_i]), (PG8_LAS unsigned*)(lds + (bufoff) + ldsw + _i * 8192), 16, 0, 0); } while (0)
#define PG8_LDA(dst, b, h) do { _Pragma("unroll") for (int m = 0; m < 4; ++m) _Pragma("unroll") for (int k = 0; k < 2; ++k) dst[m][k] = *(const PG8_LAS bf16x8*)(lds + PG8_SA(b, h) + aoff + m * 2048 + k * 1024); } while (0)
#define PG8_LDB(dst, b, h) do { _Pragma("unroll") for (int n = 0; n < 2; ++n) _Pragma("unroll") for (int k = 0; k < 2; ++k) dst[n][k] = *(const PG8_LAS bf16x8*)(lds + PG8_SB(b, h) + boff + n * 2048 + k * 1024); } while (0)
#define PG8_MMA(ai, bj, At, Bt) do { __builtin_amdgcn_s_setprio(1); _Pragma("unroll") for (int m = 0; m < 4; ++m) _Pragma("unroll") for (int n = 0; n < 2; ++n) _Pragma("unroll") for (int k = 0; k < 2; ++k) \
        acc[ai][bj][m][n] = __builtin_amdgcn_mfma_f32_16x16x32_bf16(Bt[n][k], At[m][k], acc[ai][bj][m][n], 0, 0, 0); __builtin_amdgcn_s_setprio(0); } while (0)
#define PG8_WAIT_V(n) asm volatile("s_waitcnt vmcnt(" #n ")" ::: "memory")
#define PG8_WAIT_L(n) asm volatile("s_waitcnt lgkmcnt(" #n ")" ::: "memory")
#define PG8_BAR __builtin_amdgcn_s_barrier()
#define PG8_SCHED __builtin_amdgcn_sched_barrier(0)
    Unit cur, nxt; int ui = 0;
    if (!S.next(0, cur)) return;
    f32x4 acc[2][2][4][2];
#pragma unroll
    for (int a = 0; a < 2; ++a)
#pragma unroll
        for (int b = 0; b < 2; ++b)
#pragma unroll
            for (int m = 0; m < 4; ++m)
#pragma unroll
                for (int n = 0; n < 2; ++n) acc[a][b][m][n] = (f32x4){0.f, 0.f, 0.f, 0.f};
    bf16x8 At[4][2], B0[2][2], B1[2][2];
    const char* cA = (const char*)g.A + (size_t)cur.pm * tstep; const char* cB = (const char*)g.Bt + (size_t)cur.pn * tstep;
    S.a_ready(cur);
    if constexpr (SP2) {
        PG8_STAGE(PG8_SB(0, 0), cB, voffB); PG8_STAGE(PG8_SB(0, 1), cB + hstep, voffB); PG8_STAGE(PG8_SA(0, 0), cA, voffA); PG8_STAGE(PG8_SA(0, 1), cA + hstep, voffA);
        if (wr == 1) PG8_BAR;
        PG8_WAIT_V(2); PG8_BAR;
        PG8_STAGE(PG8_SB(1, 0), cB + kstep, voffB); PG8_STAGE(PG8_SA(1, 0), cA + kstep, voffA); PG8_STAGE(PG8_SB(1, 1), cB + hstep + kstep, voffB);
        PG8_WAIT_V(6); PG8_BAR;
    } else {
        PG8_STAGE(PG8_SB(0, 0), cB, voffB); PG8_STAGE(PG8_SA(0, 0), cA, voffA); PG8_STAGE(PG8_SB(0, 1), cB + hstep, voffB); PG8_STAGE(PG8_SA(0, 1), cA + hstep, voffA);
        if (wr == 1) PG8_BAR;
        PG8_WAIT_V(4); PG8_BAR;
        PG8_STAGE(PG8_SB(1, 0), cB + kstep, voffB); PG8_STAGE(PG8_SA(1, 0), cA + kstep, voffA); PG8_STAGE(PG8_SB(1, 1), cB + hstep + kstep, voffB);
        PG8_WAIT_V(6); PG8_BAR;
    }
    for (;;) {
        const bool has_next = S.next(ui + 1, nxt);
        const char* nA = has_next ? (const char*)g.A + (size_t)nxt.pm * tstep : cA; const char* nB = has_next ? (const char*)g.Bt + (size_t)nxt.pn * tstep : cB;
        for (int t = 0; t < nt; t += 2) {
            const bool last = (t == nt - 2);
            const char* a1 = cA + (size_t)(t + 1) * kstep;
            const char* a2 = last ? nA : cA + (size_t)(t + 2) * kstep; const char* b2 = last ? nB : cB + (size_t)(t + 2) * kstep;
            const char* a3 = a2 + kstep; const char* b3 = b2 + kstep;
            if (last && has_next) S.a_ready(nxt);
            if constexpr (SP2) {
            PG8_LDB(B0, 0, 0); PG8_LDB(B1, 0, 1); PG8_SCHED; PG8_LDA(At, 0, 0); PG8_STAGE(PG8_SA(1, 1), a1 + hstep, voffA);
            PG8_WAIT_V(8); PG8_WAIT_L(0); PG8_BAR; PG8_MMA(0, 0, At, B0); PG8_MMA(0, 1, At, B1); PG8_BAR; PG8_SCHED;
            PG8_LDA(At, 0, 1); PG8_STAGE(PG8_SB(0, 0), b2, voffB); PG8_STAGE(PG8_SB(0, 1), b2 + hstep, voffB); PG8_STAGE(PG8_SA(0, 0), a2, voffA);
            PG8_WAIT_V(8); PG8_WAIT_L(0); PG8_BAR; PG8_MMA(1, 0, At, B0); PG8_MMA(1, 1, At, B1); PG8_BAR; PG8_SCHED;
            PG8_LDB(B0, 1, 0); PG8_LDB(B1, 1, 1); PG8_SCHED; PG8_LDA(At, 1, 0); PG8_STAGE(PG8_SA(0, 1), a2 + hstep, voffA);
            PG8_WAIT_V(8); PG8_WAIT_L(0); PG8_BAR; PG8_MMA(0, 0, At, B0); PG8_MMA(0, 1, At, B1); PG8_BAR; PG8_SCHED;
            PG8_LDA(At, 1, 1); PG8_STAGE(PG8_SB(1, 0), b3, voffB); PG8_STAGE(PG8_SB(1, 1), b3 + hstep, voffB); PG8_STAGE(PG8_SA(1, 0), a3, voffA);
            PG8_WAIT_V(8); PG8_WAIT_L(0); PG8_BAR; PG8_MMA(1, 0, At, B0); PG8_MMA(1, 1, At, B1); PG8_BAR; PG8_SCHED;
            } else {
            PG8_LDB(B0, 0, 0); PG8_SCHED; PG8_LDA(At, 0, 0); PG8_STAGE(PG8_SA(1, 1), a1 + hstep, voffA);
            PG8_WAIT_L(8); PG8_BAR; PG8_WAIT_L(0); PG8_MMA(0, 0, At, B0); PG8_BAR; PG8_SCHED;
            PG8_LDB(B1, 0, 1); PG8_STAGE(PG8_SB(0, 0), b2, voffB);
            PG8_BAR; PG8_WAIT_L(0); PG8_MMA(0, 1, At, B1); PG8_BAR;
            PG8_LDA(At, 0, 1); PG8_STAGE(PG8_SA(0, 0), a2, voffA);
            PG8_BAR; PG8_WAIT_L(0); PG8_MMA(1, 0, At, B0); PG8_BAR; PG8_SCHED;
            PG8_STAGE(PG8_SB(0, 1), b2 + hstep, voffB);
            PG8_WAIT_V(6); PG8_BAR; PG8_MMA(1, 1, At, B1); PG8_BAR;
            PG8_LDB(B0, 1, 0); PG8_SCHED; PG8_LDA(At, 1, 0); PG8_STAGE(PG8_SA(0, 1), a2 + hstep, voffA);
            PG8_WAIT_L(8); PG8_BAR; PG8_WAIT_L(0); PG8_MMA(0, 0, At, B0); PG8_BAR; PG8_SCHED;
            PG8_LDB(B1, 1, 1); PG8_STAGE(PG8_SB(1, 0), b3, voffB);
            PG8_BAR; PG8_WAIT_L(0); PG8_MMA(0, 1, At, B1); PG8_BAR;
            PG8_LDA(At, 1, 1); PG8_STAGE(PG8_SA(1, 0), a3, voffA);
            PG8_BAR; PG8_WAIT_L(0); PG8_MMA(1, 0, At, B0); PG8_BAR; PG8_SCHED;
            PG8_STAGE(PG8_SB(1, 1), b3 + hstep, voffB);
            PG8_WAIT_V(6); PG8_BAR; PG8_MMA(1, 1, At, B1); PG8_BAR;
            }
        }
        if constexpr (ALIGN_EPI) { if (wr == 0) PG8_BAR; }
        if constexpr (!Epi::AFTER_DRAIN) { E(acc, cur, wr, wc, fr, fq); S.done(cur); }
        if (!has_next) break;
#pragma unroll
        for (int a = 0; a < 2; ++a)
#pragma unroll
            for (int b = 0; b < 2; ++b)
#pragma unroll
                for (int m = 0; m < 4; ++m)
#pragma unroll
                    for (int n = 0; n < 2; ++n) acc[a][b][m][n] = (f32x4){0.f, 0.f, 0.f, 0.f};
        cur = nxt; cA = nA; cB = nB; ++ui;
        if constexpr (ALIGN_EPI) { if (wr == 1) PG8_BAR; }
    }
    PG8_WAIT_V(0);
    if constexpr (!ALIGN_EPI) { if (wr == 0) PG8_BAR; }
    PG8_BAR;
    if constexpr (Epi::AFTER_DRAIN) { E.fused(acc, cur, wr, wc, fr, fq, lds, wid, lane); S.done(cur); }
#undef PG8_SA
#undef PG8_SB
#undef PG8_STAGE
#undef PG8_LDA
#undef PG8_LDB
#undef PG8_MMA
#undef PG8_WAIT_V
#undef PG8_WAIT_L
#undef PG8_BAR
#undef PG8_SCHED
}
}
#define GAS __attribute__((address_space(1)))
#define LAS __attribute__((address_space(3)))
typedef unsigned short bf16;
typedef unsigned v4u __attribute__((ext_vector_type(4)));
typedef float f32x4 __attribute__((ext_vector_type(4)));
typedef short bf16x8 __attribute__((ext_vector_type(8)));
typedef GAS unsigned gu32;
typedef GAS unsigned long long gu64;
#define RLX_AGENT __ATOMIC_RELAXED, __HIP_MEMORY_SCOPE_AGENT
#define LDS_WAIT() asm volatile("s_waitcnt lgkmcnt(0)" ::: "memory")
#define VM_WAIT() asm volatile("s_waitcnt vmcnt(0)" ::: "memory")
__device__ __forceinline__ unsigned long long rt() { return __builtin_amdgcn_s_memrealtime(); }
__device__ __forceinline__ unsigned f2bf(float f) { unsigned u = __builtin_bit_cast(unsigned, f); return (u + 0x7fffu + ((u >> 16) & 1u)) >> 16; }
__device__ __forceinline__ unsigned pk2(float lo, float hi) { return f2bf(lo) | (f2bf(hi) << 16); }

#define XB_TMO      128
#define XB_XCNT(j)  (256  + 64 * (j))
#define XB_XSUB(j)  (1280 + 64 * (j))
#define XB_XGEN(j)  (2304 + 64 * (j))
#define XB_TOP      3328
#define XB_TOPGEN   3392
#define XCD_BAR_WORDS 3456
#define XB_SPIN_CAP (1u << 18)

__device__ __forceinline__ unsigned xb_ld(unsigned* p)              { return __hip_atomic_load(p, __ATOMIC_RELAXED, __HIP_MEMORY_SCOPE_AGENT); }
__device__ __forceinline__ unsigned xb_add(unsigned* p, unsigned v) { return __hip_atomic_fetch_add(p, v, __ATOMIC_RELAXED, __HIP_MEMORY_SCOPE_AGENT); }
__device__ __forceinline__ unsigned xb_xcc_id() { return (unsigned)__builtin_amdgcn_s_getreg((3 << 11) | 20) & 0xFu; }
#define XB_SPIN(cond, bar) do { unsigned _sp = 0; while (cond) { __builtin_amdgcn_s_sleep(1); \
    if ((++_sp & 255u) == 0u) { if (xb_ld(&(bar)[XB_TMO])) break; if (_sp > XB_SPIN_CAP) { atomicAdd(&(bar)[XB_TMO], 1u); break; } } } } while (0)

struct XcdBarrier {
    unsigned* bar; unsigned x;
    volatile LAS unsigned* st;
};

__device__ __forceinline__ XcdBarrier xcd_barrier_post(unsigned* bar, volatile LAS unsigned* st) {
    XcdBarrier b; b.bar = bar; b.x = xb_xcc_id(); b.st = st;
    if (threadIdx.x == 0) (void)xb_add(&bar[XB_XCNT(b.x)], 1u);
    return b;
}
__device__ __forceinline__ void xcd_barrier_complete(unsigned* bar, unsigned x, unsigned& nloc, unsigned& nx) {
    const unsigned G = gridDim.x * gridDim.y * gridDim.z;
    unsigned sum, cnt, mine, sp = 0u;
    for (;;) {
        sum = 0u; cnt = 0u; mine = 0u;
#pragma unroll
        for (unsigned j = 0; j < 16; ++j) { const unsigned c = xb_ld(&bar[XB_XCNT(j)]); sum += c; cnt += (c > 0u) ? 1u : 0u; mine = (j == x) ? c : mine; }
        if (sum == G) break;
        __builtin_amdgcn_s_sleep(1);
        if ((++sp & 255u) == 0u) { if (xb_ld(&bar[XB_TMO])) break; if (sp > XB_SPIN_CAP) { atomicAdd(&bar[XB_TMO], 1u); break; } }
    }
    nloc = mine > 0u ? mine : 1u; nx = cnt > 0u ? cnt : 1u;
}

__device__ __forceinline__ void xcd_barrier(const XcdBarrier& b) {
    asm volatile("s_waitcnt vmcnt(0)" ::: "memory");
    __syncthreads();
    if (threadIdx.x == 0) {
        unsigned* bar = b.bar;
        __builtin_amdgcn_s_waitcnt(0);
        unsigned nloc = b.st[0], nx = b.st[1];
        if (nloc == 0u) { xcd_barrier_complete(bar, b.x, nloc, nx); b.st[0] = nloc; b.st[1] = nx; }
        const unsigned old = xb_add(&bar[XB_XSUB(b.x)], 1u);
        const unsigned gen = old / nloc;
        if (old + 1u == (gen + 1u) * nloc) {
            __builtin_amdgcn_fence(__ATOMIC_RELEASE, "agent");
            asm volatile("s_waitcnt vmcnt(0)" ::: "memory");
            const unsigned og = xb_add(&bar[XB_TOP], 1u);
            const unsigned tg = og / nx;
            if (og + 1u == (tg + 1u) * nx) xb_add(&bar[XB_TOPGEN], 1u);
            else XB_SPIN(xb_ld(&bar[XB_TOPGEN]) == tg, bar);
            __builtin_amdgcn_fence(__ATOMIC_ACQUIRE, "agent");
            xb_add(&bar[XB_XGEN(b.x)], 1u);
            asm volatile("s_waitcnt vmcnt(0)" ::: "memory");
        } else {
            XB_SPIN(xb_ld(&bar[XB_XGEN(b.x)]) == gen, bar);
            __builtin_amdgcn_fence(__ATOMIC_ACQUIRE, "agent");
            asm volatile("s_waitcnt vmcnt(0)" ::: "memory");
        }
    }
    __syncthreads();
}
__device__ __forceinline__ float bf_lo_(unsigned w) { return __builtin_bit_cast(float, w << 16); }
__device__ __forceinline__ float bf_hi_(unsigned w) { return __builtin_bit_cast(float, w & 0xffff0000u); }

constexpr int NWAVES = 8;
constexpr int NB = 8, SEQ = 2048, DM = 1024, M = NB * SEQ;
constexpr int NH = 8, HD = 64, AW = 512;
constexpr int RWS = 1664;
constexpr int DIN = 6272;
constexpr int NA = 4352, NBW = 2048;
constexpr int BLK = 256, NBLK = SEQ / BLK, TOPK = 3;
constexpr float RMS_EPS = 1e-6f, GN_EPS = 64e-5f;
#ifndef MK_SINGLE
#define MK_SINGLE 0
#endif
constexpr int NPH_LAYER = 9, NPHASE = 1 + 2 * NPH_LAYER;

constexpr size_t MiB = 1u << 20;
constexpr size_t WS_CTL = 0, CTL_ZERO_BYTES = 64 * 1024;
constexpr size_t WS_RINV = 1 * MiB, WS_KMEAN = 1 * MiB + 256 * 1024;
constexpr size_t WS_WA = 2 * MiB, WA_BYTES = (size_t)NA * DM * 2;
constexpr size_t WS_WB = 19 * MiB, WB_BYTES = (size_t)NBW * DM * 2;
constexpr size_t WS_WUP = 27 * MiB, WUP_BYTES = 2 * MiB;
constexpr size_t WS_WOUT = 31 * MiB, WOUT_BYTES = 2 * MiB;
constexpr size_t WS_XB = 35 * MiB, WS_VFIRST = 67 * MiB, WS_U = 83 * MiB;
constexpr size_t WS_Q = 115 * MiB, WS_K = 131 * MiB, WS_V = 147 * MiB, WS_AZ = 163 * MiB, WS_RZ = 179 * MiB, WS_RW = 195 * MiB, WS_VD = 247 * MiB;
static_assert(WS_K - WS_Q == 16 * MiB && WS_V - WS_Q == 32 * MiB && WS_AZ - WS_Q == 48 * MiB && WS_RZ - WS_Q == 64 * MiB && WS_RW - WS_Q == 80 * MiB && WS_VD - WS_RW == 52 * MiB, "EpiProjA routing offsets");
constexpr size_t WS_GA = WS_K, WS_GR = WS_RW, WS_Y = WS_Q, WS_END = 248 * MiB;
constexpr int CW_BAR = 1024;

constexpr int RING_OFF = 0, RING_BYTES = 131072;
constexpr int LDSCTL_OFF = RING_BYTES, MISC_OFF = LDSCTL_OFF + 320;
constexpr int LDS_BYTES = 147456;

struct Frame {
    LAS unsigned char* lds;
    volatile LAS unsigned* MISC;
    gu32* ctl;
    int tid, lane, wave, vcu, G;
};
__device__ __forceinline__ float wave_sum(float v) {
#pragma unroll
    for (int o = 1; o < 64; o <<= 1) v += __shfl_xor(v, o);
    return v;
}
__device__ __forceinline__ float wave_max(float v) {
#pragma unroll
    for (int o = 1; o < 64; o <<= 1) v = fmaxf(v, __shfl_xor(v, o));
    return v;
}
__device__ __forceinline__ float bf2f(bf16 v) { return __builtin_bit_cast(float, (unsigned)v << 16); }
__device__ __forceinline__ float rl(float v, int l) { return __builtin_bit_cast(float, __builtin_amdgcn_readlane(__builtin_bit_cast(int, v), l)); }

struct Args { const float* in[21]; float* out; unsigned char* ws; int ph_lo, ph_hi; };
__device__ __forceinline__ const float* inp(const Args& a, int i) { asm volatile("" : "+s"(i)); return a.in[i]; }

__device__ __forceinline__ void p0_transpose_item(const float* W, int ldw, int c0, int k0, const float* g, bf16* WT, int ldk, int n_row0, LAS float* scr, int lane) {
#pragma unroll 8
    for (int i = 0; i < 32; ++i) { const int kk = 2 * i + (lane >> 5); const float s = g ? g[k0 + kk] : 1.0f; scr[kk * 33 + (lane & 31)] = W[(size_t)(k0 + kk) * ldw + c0 + (lane & 31)] * s; }
    LDS_WAIT(); asm volatile("" ::: "memory");
    const int c = lane & 7;
#pragma unroll
    for (int j = 0; j < 4; ++j) { const int n = (lane >> 3) + 8 * j; const LAS float* s = scr + (8 * c) * 33 + n;
        v4u o; o.x = pk2(s[0 * 33], s[1 * 33]); o.y = pk2(s[2 * 33], s[3 * 33]); o.z = pk2(s[4 * 33], s[5 * 33]); o.w = pk2(s[6 * 33], s[7 * 33]);
        *(GAS v4u*)(WT + (size_t)(n_row0 + n) * ldk + k0 + 8 * c) = o; }
    LDS_WAIT(); asm volatile("" ::: "memory");
}
__device__ __forceinline__ void row_to_bf16_rinv(const float* xrow, bf16* orow, float* rinv, int lane) {
    const GAS f32x4* xr = (const GAS f32x4*)xrow + lane;
    f32x4 v[4]; float s = 0.f;
#pragma unroll
    for (int j = 0; j < 4; ++j) { v[j] = xr[64 * j]; s += (v[j].x * v[j].x + v[j].y * v[j].y) + (v[j].z * v[j].z + v[j].w * v[j].w); }
    s = wave_sum(s);
    GAS unsigned long long* o8 = (GAS unsigned long long*)orow + lane;
#pragma unroll
    for (int j = 0; j < 4; ++j) o8[64 * j] = (unsigned long long)pk2(v[j].x, v[j].y) | ((unsigned long long)pk2(v[j].z, v[j].w) << 32);
    if (lane == 0) *rinv = 1.0f / sqrtf(s * (1.0f / DM) + RMS_EPS);
}

__device__ __forceinline__ void p0_prologue(Frame& F, const Args& a) {
    LAS float* scr = (LAS float*)(F.lds + RING_OFF + F.wave * 16384);
    const int gw = F.vcu * NWAVES + F.wave, NGW = F.G * NWAVES;
    unsigned char* ws = a.ws;
    constexpr int I_A = 16 * (4224 / 32), I_V = 16, I_B = 16 * (NBW / 32), I_U = 8 * (DM / 32), I_O = 16 * (DM / 32);
    constexpr int I_LAYER = I_A + I_V + I_B + 2 * I_U + I_O;
    for (int it = gw; it < 2 * I_LAYER; it += NGW) {
        const int l = it / I_LAYER; int r = it % I_LAYER;
        const float* w_in = inp(a, 3) + (size_t)l * DM * DIN; const float* g = inp(a, 1) + l * DM;
        bf16* WA = (bf16*)(ws + WS_WA + l * WA_BYTES); bf16* WB = (bf16*)(ws + WS_WB + l * WB_BYTES);
        bf16* WU = (bf16*)(ws + WS_WUP + l * WUP_BYTES); bf16* WO = (bf16*)(ws + WS_WOUT + l * WOUT_BYTES);
        if (r < I_A) { const int kb = r / (4224 / 32), nb = r % (4224 / 32); p0_transpose_item(w_in, DIN, 32 * nb, 64 * kb, g, WA, DM, 32 * nb, scr, F.lane); continue; } r -= I_A;
        if (r < I_V) { if (l == 1) p0_transpose_item(inp(a, 14), 32, 0, 64 * r, g, WA, DM, 4224, scr, F.lane); continue; } r -= I_V;
        if (r < I_B) { const int kb = r / (NBW / 32), nb = r % (NBW / 32); p0_transpose_item(w_in, DIN, 4224 + 32 * nb, 64 * kb, g, WB, DM, 32 * nb, scr, F.lane); continue; } r -= I_B;
        if (r < I_U) { const int kb = r / (DM / 32), nb = r % (DM / 32); p0_transpose_item(inp(a, 18) + (size_t)l * AW * DM, DM, 32 * nb, 64 * kb, nullptr, WU, AW, 32 * nb, scr, F.lane); continue; } r -= I_U;
        if (r < I_U) { const int kb = r / (DM / 32), nb = r % (DM / 32); p0_transpose_item(inp(a, 19) + (size_t)l * AW * DM, DM, 32 * nb, 64 * kb, nullptr, WU + (size_t)DM * AW, AW, 32 * nb, scr, F.lane); continue; } r -= I_U;
        { const int kb = r / (DM / 32), nb = r % (DM / 32); p0_transpose_item(inp(a, 20) + (size_t)l * DM * DM, DM, 32 * nb, 64 * kb, nullptr, WO, DM, 32 * nb, scr, F.lane); }
    }
    {
        const int gt = F.vcu * (NWAVES * 64) + F.tid, NT = F.G * NWAVES * 64;
        const int n0 = 128 * DM * 2 / 16, n1 = 96 * DM * 2 / 16;
        GAS v4u* z0 = (GAS v4u*)(ws + WS_WA + (size_t)4224 * DM * 2); GAS v4u* z1 = (GAS v4u*)(ws + WS_WA + WA_BYTES + (size_t)4256 * DM * 2);
        for (int i = gt; i < n0; i += NT) z0[i] = (v4u){0u, 0u, 0u, 0u};
        for (int i = gt; i < n1; i += NT) z1[i] = (v4u){0u, 0u, 0u, 0u};
    }
    const float* x = inp(a, 0); bf16* XB = (bf16*)(ws + WS_XB); float* rinv = (float*)(ws + WS_RINV);
    for (int m = gw; m < M; m += NGW) row_to_bf16_rinv(x + (size_t)m * DM, XB + (size_t)m * DM, rinv + m, F.lane);
}

__device__ __forceinline__ void kmean_phase(Frame& F, const Args& a) {
    const bf16* K = (const bf16*)(a.ws + WS_K); float* KM = (float*)(a.ws + WS_KMEAN);
    for (int u = F.vcu; u < NB * NBLK; u += F.G) {
        const bf16* kp = K + (size_t)u * BLK * AW + F.tid; float s = 0.f;
        for (int t = 0; t < BLK; ++t) s += bf2f(kp[(size_t)t * AW]);
        KM[(size_t)u * AW + F.tid] = s * (1.0f / BLK);
    }
}

__device__ __forceinline__ void attn_naive_phase(Frame& F, const Args& a) {
    bf16* Q = (bf16*)(a.ws + WS_Q); const bf16* K = (const bf16*)(a.ws + WS_K); const bf16* V = (const bf16*)(a.ws + WS_V); const bf16* AZ = (const bf16*)(a.ws + WS_AZ);
    const float* KM = (const float*)(a.ws + WS_KMEAN);
    const int gw = F.vcu * NWAVES + F.wave, NGW = F.G * NWAVES, lane = F.lane;
    for (int u = gw; u < NB * NH * SEQ; u += NGW) {
        const int bh = u >> 11, q = u & (SEQ - 1), b = bh >> 3, h = bh & 7, qblk = q >> 8;
        const size_t rowq = (size_t)b * SEQ + q;
        float qf[64];
        { const v4u* qp = (const v4u*)(Q + rowq * AW + h * HD);
#pragma unroll
          for (int i = 0; i < 8; ++i) { const v4u w = qp[i]; qf[8 * i + 0] = bf_lo_(w.x); qf[8 * i + 1] = bf_hi_(w.x); qf[8 * i + 2] = bf_lo_(w.y); qf[8 * i + 3] = bf_hi_(w.y);
              qf[8 * i + 4] = bf_lo_(w.z); qf[8 * i + 5] = bf_hi_(w.z); qf[8 * i + 6] = bf_lo_(w.w); qf[8 * i + 7] = bf_hi_(w.w); } }
        float g = 0.f; { const int j = lane & 7; const float* km = KM + ((size_t)(b * NBLK + j)) * AW + h * HD;
#pragma unroll
            for (int d = 0; d < 64; ++d) g += (qf[d] * 0.125f) * km[d];
            if (j >= qblk) g = -1e30f; }
        unsigned selmask = 0u;
        { float gj[8];
#pragma unroll
          for (int i = 0; i < 8; ++i) gj[i] = __shfl(g, i);
#pragma unroll
          for (int j = 0; j < 8; ++j) { int rank = 0;
#pragma unroll
              for (int i = 0; i < 8; ++i) rank += (gj[i] > gj[j] || (gj[i] == gj[j] && i < j)) ? 1 : 0;
              if (rank < TOPK && j < qblk) selmask |= 1u << j; } }
        const float slope = exp2f(-(float)(h + 1));
        float mrun = -1e30f, lrun = 0.f, o = 0.f;
        for (int j = 0; j <= qblk; ++j) {
            const bool own = (j == qblk);
            if (!own && !((selmask >> j) & 1u)) continue;
            for (int tt = 0; tt < 4; ++tt) {
                const int k0 = j * BLK + tt * 64; if (own && k0 > q) break;
                const int key = k0 + lane;
                const v4u* kp = (const v4u*)(K + ((size_t)b * SEQ + key) * AW + h * HD);
                float s = 0.f;
#pragma unroll
                for (int i = 0; i < 8; ++i) { const v4u w = kp[i];
                    s += qf[8 * i + 0] * bf_lo_(w.x) + qf[8 * i + 1] * bf_hi_(w.x) + qf[8 * i + 2] * bf_lo_(w.y) + qf[8 * i + 3] * bf_hi_(w.y)
                       + qf[8 * i + 4] * bf_lo_(w.z) + qf[8 * i + 5] * bf_hi_(w.z) + qf[8 * i + 6] * bf_lo_(w.w) + qf[8 * i + 7] * bf_hi_(w.w); }
                s = s * 0.125f - slope * (float)(q - key);
                if (key > q) s = -1e30f;
                const float tm = wave_max(s), mnew = fmaxf(mrun, tm), sc = __expf(mrun - mnew), p = __expf(s - mnew);
                lrun = lrun * sc + wave_sum(p); o *= sc; mrun = mnew;
                const bf16* vp = V + ((size_t)b * SEQ + k0) * AW + h * HD + lane;
#pragma unroll 8
                for (int kk = 0; kk < 64; ++kk) o += __shfl(p, kk) * bf2f(vp[(size_t)kk * AW]);
            }
        }
        const float az = bf2f(AZ[rowq * AW + h * HD + lane]);
        const float y = (o / lrun) * (az / (1.0f + __expf(-az)));
        Q[rowq * AW + h * HD + lane] = (bf16)f2bf(y);
    }
}

__device__ __forceinline__ void scan_naive_phase(Frame& F, const Args& a, int l) {
    if (F.wave != 0) return;
    const int lane = F.lane;
    const bf16* RW = (const bf16*)(a.ws + WS_RW); bf16* RZ = (bf16*)(a.ws + WS_RZ); const bf16* VD = (const bf16*)(a.ws + WS_VD); bf16* VF = (bf16*)(a.ws + WS_VFIRST);
    LAS float* wup = (LAS float*)(F.lds + RING_OFF);
    LAS float* aup = wup + 4096;
    LAS float* vup = aup + 4096;
    for (int u = F.vcu; u < NB * NH; u += F.G) {
        const int b = u >> 3, h = u & 7, col = h * HD + lane;
        for (int j = 0; j < 64; ++j) { wup[j * 64 + lane] = inp(a, 6)[((size_t)l * 64 + j) * AW + col]; aup[j * 64 + lane] = inp(a, 8)[((size_t)l * 64 + j) * AW + col]; }
        if (l == 1) for (int j = 0; j < 32; ++j) vup[j * 64 + lane] = inp(a, 16)[(size_t)j * AW + col];
        LDS_WAIT();
        const float* mu = inp(a, 4) + (size_t)l * RWS;
        const float mu_r = mu[col], mu_k = mu[512 + col], mu_v = mu[1024 + col], mu_wd = mu[1536 + lane], mu_ad = mu[1600 + lane];
        const float w0 = inp(a, 5)[l * AW + col], a0 = inp(a, 7)[l * AW + col], k_k = inp(a, 9)[l * AW + col], k_a = inp(a, 10)[l * AW + col], r_k = inp(a, 11)[l * AW + col];
        const float ln_g = inp(a, 12)[l * AW + col], ln_b = inp(a, 13)[l * AW + col];
        const float vmu = (l == 1) ? inp(a, 15)[lane & 31] : 0.f, vm0 = (l == 1) ? inp(a, 17)[col] : 0.f;
        float S[64];
#pragma unroll
        for (int k = 0; k < 64; ++k) S[k] = 0.f;
        float p_r = 0.f, p_k = 0.f, p_v = 0.f, p_wd = 0.f, p_ad = 0.f, p_vd = 0.f;
        for (int t = 0; t < SEQ; ++t) {
            const size_t row = (size_t)b * SEQ + t; const bf16* rw = RW + row * RWS;
            const float c_r = bf2f(rw[col]), c_k = bf2f(rw[512 + col]), c_v = bf2f(rw[1024 + col]), c_wd = bf2f(rw[1536 + lane]), c_ad = bf2f(rw[1600 + lane]);
            const float r = c_r + (p_r - c_r) * mu_r, ks = c_k + (p_k - c_k) * mu_k, vs = c_v + (p_v - c_v) * mu_v, wd = c_wd + (p_wd - c_wd) * mu_wd, ad = c_ad + (p_ad - c_ad) * mu_ad;
            p_r = c_r; p_k = c_k; p_v = c_v; p_wd = c_wd; p_ad = c_ad;
            const float twd = tanhf(wd);
            float xw = w0, xa = a0;
#pragma unroll 16
            for (int j = 0; j < 64; ++j) { xw += rl(twd, j) * wup[j * 64 + lane]; xa += rl(ad, j) * aup[j * 64 + lane]; }
            const float z = -xw, sp = fmaxf(z, 0.f) + log1pf(__expf(-fabsf(z)));
            const float wlog = -sp - 0.5f, w = __expf(-__expf(wlog));
            const float av = 1.0f / (1.0f + __expf(-xa));
            float vr = vs;
            if (l == 0) VF[row * AW + col] = (bf16)f2bf(vs);
            else {
                const float c_vd = bf2f(VD[row * 32 + (lane & 31)]); const float vd = c_vd + (p_vd - c_vd) * vmu; p_vd = c_vd;
                float xv = vm0;
#pragma unroll 16
                for (int j = 0; j < 32; ++j) xv += rl(vd, j) * vup[j * 64 + lane];
                const float vf = bf2f(VF[row * AW + col]);
                vr = vs + (vf - vs) * (1.0f / (1.0f + __expf(-xv)));
            }
            const float kkv = ks * k_k; const float nrm = sqrtf(wave_sum(kkv * kkv)); const float kkn = kkv / fmaxf(nrm, 1e-12f);
            const float kmod = ks * (1.0f + (av - 1.0f) * k_a), bb = kkn * av;
            const float cb = wave_sum(r * kmod * r_k);
            float sa = 0.f;
#pragma unroll
            for (int k = 0; k < 64; ++k) sa -= S[k] * rl(kkn, k);
            float o = 0.f;
#pragma unroll
            for (int k = 0; k < 64; ++k) { S[k] = S[k] * rl(w, k) + sa * rl(bb, k) + vr * rl(kmod, k); o += S[k] * rl(r, k); }
            const float mean = wave_sum(o) * (1.0f / 64.0f), d = o - mean, var = wave_sum(d * d) * (1.0f / 64.0f);
            const float on = d * (1.0f / sqrtf(var + GN_EPS)) * ln_g + ln_b;
            const float rz = bf2f(RZ[row * AW + col]);
            RZ[row * AW + col] = (bf16)f2bf((on + cb * vr) * (rz / (1.0f + __expf(-rz))));
        }
    }
}

__device__ __forceinline__ void norm_phase(Frame& F, const Args& a, int l) {
    const int gw = F.vcu * NWAVES + F.wave, NGW = F.G * NWAVES, lane = F.lane;
    const float* Y = (const float*)(a.ws + WS_Y); const float* xold = (l == 0) ? inp(a, 0) : a.out; const float* gp = inp(a, 2) + l * DM;
    bf16* XB = (bf16*)(a.ws + WS_XB); float* rinv = (float*)(a.ws + WS_RINV);
    f32x4 gv[4];
#pragma unroll
    for (int j = 0; j < 4; ++j) gv[j] = ((const f32x4*)gp)[lane + 64 * j];
    for (int m = gw; m < M; m += NGW) {
        const f32x4* yr = (const f32x4*)(Y + (size_t)m * DM) + lane; const f32x4* xr = (const f32x4*)(xold + (size_t)m * DM) + lane;
        f32x4 y[4], x[4]; float s = 0.f;
#pragma unroll
        for (int j = 0; j < 4; ++j) { y[j] = yr[64 * j]; x[j] = xr[64 * j]; s += (y[j].x * y[j].x + y[j].y * y[j].y) + (y[j].z * y[j].z + y[j].w * y[j].w); }
        const float ry = 1.0f / sqrtf(wave_sum(s) * (1.0f / DM) + RMS_EPS); float s2 = 0.f;
#pragma unroll
        for (int j = 0; j < 4; ++j) { x[j] = x[j] + y[j] * ry * gv[j]; s2 += (x[j].x * x[j].x + x[j].y * x[j].y) + (x[j].z * x[j].z + x[j].w * x[j].w); }
        f32x4* orow = (f32x4*)(a.out + (size_t)m * DM) + lane;
#pragma unroll
        for (int j = 0; j < 4; ++j) orow[64 * j] = x[j];
        if (l == 0) {
            s2 = wave_sum(s2);
            GAS unsigned long long* o8 = (GAS unsigned long long*)(XB + (size_t)m * DM) + lane;
#pragma unroll
            for (int j = 0; j < 4; ++j) o8[64 * j] = (unsigned long long)pk2(x[j].x, x[j].y) | ((unsigned long long)pk2(x[j].z, x[j].w) << 32);
            if (lane == 0) rinv[m] = 1.0f / sqrtf(s2 * (1.0f / DM) + RMS_EPS);
        }
    }
}

__global__ void __launch_bounds__(NWAVES * 64, 2) mk_fwd(Args args) {
    extern __shared__ __attribute__((aligned(16))) unsigned char lds[];
    Frame F;
    F.lds = (LAS unsigned char*)lds;
    F.MISC = (volatile LAS unsigned*)(F.lds + MISC_OFF);
    F.tid = threadIdx.x; F.lane = F.tid & 63; F.wave = __builtin_amdgcn_readfirstlane(F.tid >> 6);
    F.G = gridDim.x; { const int bx = blockIdx.x; F.vcu = (F.G % 8 == 0) ? (bx % 8) * (F.G / 8) + bx / 8 : bx; }
    const int vcu0 = F.vcu;
    unsigned char* ws = args.ws;
    F.ctl = (gu32*)(ws + WS_CTL);
    for (int u = F.tid; u < (LDS_BYTES - LDSCTL_OFF) / 4; u += NWAVES * 64) ((LAS unsigned*)(F.lds + LDSCTL_OFF))[u] = 0u;
    __syncthreads();
    XcdBarrier bar; bar.bar = (unsigned*)(F.ctl + CW_BAR); bar.x = 0; bar.st = nullptr;
    const bool use_bar = (args.ph_hi - args.ph_lo) > 1;
    if (use_bar) bar = xcd_barrier_post((unsigned*)(F.ctl + CW_BAR), F.MISC + 8);

    for (int ph_ = args.ph_lo; ph_ < args.ph_hi; ++ph_) {
        int ph = ph_; asm volatile("" : "+s"(ph));
        { int t_ = threadIdx.x; asm volatile("" : "+v"(t_)); F.tid = t_; F.lane = t_ & 63; F.wave = __builtin_amdgcn_readfirstlane(t_ >> 6); int g_ = gridDim.x, v_ = vcu0; asm volatile("" : "+s"(g_), "+s"(v_)); F.G = g_; F.vcu = v_; }
        if (ph == 0) p0_prologue(F, args);
        else {
            const int l = (ph - 1) / NPH_LAYER, sp = (ph - 1) % NPH_LAYER;
            const float* rinv = (const float*)(ws + WS_RINV);
            pg8::bf16_t* XB = (pg8::bf16_t*)(ws + WS_XB);
            if (sp == 0) {
                pg8::Gemm g{XB, (const pg8::bf16_t*)(ws + WS_WA + l * WA_BYTES), M, NA, DM}; pg8::StaticOrder S; S.init(M, NA, F.G, (int)blockIdx.x);
                pg8::EpiProjA E{rinv, (pg8::bf16_t*)(ws + WS_Q)};
                pg8::gemm_phase<pg8::EpiProjA, pg8::StaticOrder, true, true>(F.lds + RING_OFF, g, S, E);
            } else if (sp == 1) kmean_phase(F, args);
            else if (sp == 2) attn_naive_phase(F, args);
            else if (sp == 3) scan_naive_phase(F, args, l);
            else if (sp == 4) {
                pg8::Gemm g{XB, (const pg8::bf16_t*)(ws + WS_WB + l * WB_BYTES), M, NBW, DM}; pg8::StaticOrder S; S.init(M, NBW, F.G, (int)blockIdx.x);
                pg8::EpiProjB E{rinv, (pg8::bf16_t*)(ws + WS_GA), (pg8::bf16_t*)(ws + WS_GR)};
                pg8::gemm_phase<pg8::EpiProjB, pg8::StaticOrder, true, true>(F.lds + RING_OFF, g, S, E);
            } else if (sp == 5) {
                pg8::Gemm g{(const pg8::bf16_t*)(ws + WS_Q), (const pg8::bf16_t*)(ws + WS_WUP + l * WUP_BYTES), M, DM, AW}; pg8::StaticOrder S; S.init(M, DM, F.G, (int)blockIdx.x);
                pg8::EpiUp<false> E{(const pg8::bf16_t*)(ws + WS_GA), (pg8::bf16_t*)(ws + WS_U)};
                pg8::gemm_phase<pg8::EpiUp<false>, pg8::StaticOrder, true, true>(F.lds + RING_OFF, g, S, E);
            } else if (sp == 6) {
                pg8::Gemm g{(const pg8::bf16_t*)(ws + WS_RZ), (const pg8::bf16_t*)(ws + WS_WUP + l * WUP_BYTES + (size_t)DM * AW * 2), M, DM, AW}; pg8::StaticOrder S; S.init(M, DM, F.G, (int)blockIdx.x);
                pg8::EpiUp<true> E{(const pg8::bf16_t*)(ws + WS_GR), (pg8::bf16_t*)(ws + WS_U)};
                pg8::gemm_phase<pg8::EpiUp<true>, pg8::StaticOrder, true, true>(F.lds + RING_OFF, g, S, E);
            } else if (sp == 7) {
                pg8::Gemm g{(const pg8::bf16_t*)(ws + WS_U), (const pg8::bf16_t*)(ws + WS_WOUT + l * WOUT_BYTES), M, DM, DM}; pg8::StaticOrder S; S.init(M, DM, F.G, (int)blockIdx.x);
                pg8::EpiF32 E{(float*)(ws + WS_Y), DM};
                pg8::gemm_phase<pg8::EpiF32, pg8::StaticOrder, true, true>(F.lds + RING_OFF, g, S, E);
            } else norm_phase(F, args, l);
        }
        if (ph_ + 1 < args.ph_hi) xcd_barrier(bar);
    }
}

extern "C" void kernel_launch(void* const* d_in, const int* in_sizes, int n_in, void* d_out, int out_size, void* d_ws, size_t ws_size, hipStream_t stream) {
    static int grid = 0;
    if (grid == 0) {
        if (n_in != 21 || in_sizes[0] != M * DM || out_size != M * DM || ws_size < WS_END) { fprintf(stderr, "kernel_launch: unexpected shapes (n_in %d, in0 %d, out %d, ws %zu); nothing launched\n", n_in, n_in > 0 ? in_sizes[0] : -1, out_size, ws_size); grid = -1; return; }
        int dev = 0, cus = 0;
        if (hipGetDevice(&dev) != hipSuccess || hipDeviceGetAttribute(&cus, hipDeviceAttributeMultiprocessorCount, dev) != hipSuccess) { grid = -1; return; }
        if (hipFuncSetAttribute((const void*)mk_fwd, hipFuncAttributeMaxDynamicSharedMemorySize, LDS_BYTES) != hipSuccess) { fprintf(stderr, "kernel_launch: hipFuncSetAttribute failed\n"); grid = -1; return; }
        (void)hipGetLastError();
        grid = cus;
    }
    if (grid < 0) return;
    if (hipMemsetAsync((char*)d_ws + WS_CTL, 0, CTL_ZERO_BYTES, stream) != hipSuccess) return;
    Args a{};
    for (int i = 0; i < 21; ++i) a.in[i] = (const float*)d_in[i];
    a.out = (float*)d_out; a.ws = (unsigned char*)d_ws;
#if MK_SINGLE
    a.ph_lo = 0; a.ph_hi = NPHASE;
    hipLaunchKernelGGL(mk_fwd, dim3(grid), dim3(NWAVES * 64), LDS_BYTES, stream, a);
#else
    for (int p = 0; p < NPHASE; ++p) { a.ph_lo = p; a.ph_hi = p + 1; hipLaunchKernelGGL(mk_fwd, dim3(grid), dim3(NWAVES * 64), LDS_BYTES, stream, a); }
#endif
}
```

```cpp
#ifndef MK_SINGLE
#define MK_SINGLE 1
#endif
#include <hip/hip_runtime.h>
#include <cstdio>
#include <cstdint>
namespace pg8 {
#define PG8_LAS __attribute__((address_space(3)))
typedef unsigned short bf16_t;
typedef short bf16x8 __attribute__((ext_vector_type(8)));
typedef float f32x4 __attribute__((ext_vector_type(4)));
typedef unsigned u32x4 __attribute__((ext_vector_type(4)));
constexpr int BM = 256, BK = 64, HALF = 128, HTB = HALF * BK * 2  , STAGE_BYTES = 8 * HTB, NXCD = 8, WGM = 8;

__host__ __device__ __forceinline__ int lds_byte(int r, int c) { const int st = (r >> 4) * 2 + (c >> 5), rr = r & 15, cc = c & 31, ob = rr * 64 + cc * 2; return st * 1024 + (ob ^ (((ob >> 9) & 1) << 5)); }
__host__ __device__ __forceinline__ void stage_rc(int b, int& R, int& C) { const int st = b / 1024, sb = b % 1024, swz = sb ^ (((sb >> 9) & 1) << 5); R = (st >> 1) * 16 + swz / 64; C = (st & 1) * 32 + (swz % 64) / 2; }
__host__ __device__ __forceinline__ int perm32(int rho) { const int n = rho >> 4, i = rho & 15; return 8 * (i >> 2) + 4 * n + (i & 3); }

struct Unit { int pm, pn; };
struct Gemm { const bf16_t* A; const bf16_t* Bt; int M, N, K; };

struct StaticOrder {
    int nM, nN, nwg, G, c;
    __host__ __device__ void init(int M, int N, int G_, int c_) { nM = M / BM; nN = N / BM; nwg = nM * nN; G = G_; c = c_; }
    __host__ __device__ bool next(int i, Unit& u) const {
        const long L = (long)i * G + c; if (L >= nwg) return false;
        int wgid = (int)L; { const int q = nwg / NXCD, r = nwg % NXCD, xcd = wgid % NXCD, off = wgid / NXCD; wgid = (xcd < r ? xcd * (q + 1) : r * (q + 1) + (xcd - r) * q) + off; }
        const int nig = WGM * nN, gid = wgid / nig, fm = gid * WGM, gsz = (nM - fm) < WGM ? (nM - fm) : WGM;
        u.pm = fm + ((wgid % nig) % gsz); u.pn = (wgid % nig) / gsz; return true;
    }
    __device__ __forceinline__ void a_ready(const Unit&) const {}
    __device__ __forceinline__ void done(const Unit&) const {}
};


__device__ __forceinline__ unsigned cvt_pk_bf16(float lo, float hi) { unsigned r; asm volatile("v_cvt_pk_bf16_f32 %0, %1, %2" : "=v"(r) : "v"(lo), "v"(hi)); return r; }
__device__ __forceinline__ float bf_lo(unsigned w) { return __builtin_bit_cast(float, w << 16); }
__device__ __forceinline__ float bf_hi(unsigned w) { return __builtin_bit_cast(float, w & 0xffff0000u); }
__device__ __forceinline__ float sigmoidf_(float x) { return 1.0f / (1.0f + __expf(-x)); }

struct EpiProjA {
    static constexpr bool PERM = true, AFTER_DRAIN = false;
    const float* rinv; bf16_t* base0;
    __device__ __forceinline__ void operator()(const f32x4 (&acc)[2][2][4][2], const Unit& u, int wr, int wc, int fr, int fq) const {
        const int row0 = u.pm * BM + wr * 64 + fr;
#pragma unroll
        for (int bj = 0; bj < 2; ++bj) {
            const int colw = u.pn * BM + bj * HALF + wc * 32;
            size_t boff; int ld, c;
            if (colw < 2048) { boff = (size_t)(colw >> 9) * (8u << 20); ld = 512; c = colw & 511; }
            else if (colw < 3712) { boff = (size_t)5 * (8u << 20); ld = 1664; c = colw - 2048; }
            else if (colw < 4224) { boff = (size_t)4 * (8u << 20); ld = 512; c = colw - 3712; }
            else if (colw < 4256) { boff = (size_t)5 * (8u << 20) + (size_t)26 * (1u << 20); ld = 32; c = colw - 4224; }
            else continue;
            bf16_t* base = base0 + boff + c + 8 * fq;
#pragma unroll
            for (int ai = 0; ai < 2; ++ai)
#pragma unroll
                for (int m = 0; m < 4; ++m) {
                    const int row = row0 + ai * HALF + m * 16; const float rs = rinv[row];
                    const f32x4 v0 = acc[ai][bj][m][0] * rs, v1 = acc[ai][bj][m][1] * rs;
                    u32x4 w; w.x = cvt_pk_bf16(v0[0], v0[1]); w.y = cvt_pk_bf16(v0[2], v0[3]); w.z = cvt_pk_bf16(v1[0], v1[1]); w.w = cvt_pk_bf16(v1[2], v1[3]);
                    *(u32x4*)(base + (size_t)row * ld) = w;
                }
        }
    }
};
struct EpiProjB {
    static constexpr bool PERM = true, AFTER_DRAIN = false;
    const float* rinv; bf16_t *GA, *GR;
    __device__ __forceinline__ void operator()(const f32x4 (&acc)[2][2][4][2], const Unit& u, int wr, int wc, int fr, int fq) const {
        const int row0 = u.pm * BM + wr * 64 + fr;
#pragma unroll
        for (int bj = 0; bj < 2; ++bj) {
            const int colw = u.pn * BM + bj * HALF + wc * 32;
            bf16_t* base = (colw < 1024 ? GA : GR) + (colw & 1023) + 8 * fq;
#pragma unroll
            for (int ai = 0; ai < 2; ++ai)
#pragma unroll
                for (int m = 0; m < 4; ++m) {
                    const int row = row0 + ai * HALF + m * 16; const float rs = rinv[row];
                    f32x4 v0 = acc[ai][bj][m][0] * rs, v1 = acc[ai][bj][m][1] * rs;
#pragma unroll
                    for (int e = 0; e < 4; ++e) { v0[e] = sigmoidf_(v0[e]); v1[e] = sigmoidf_(v1[e]); }
                    u32x4 w; w.x = cvt_pk_bf16(v0[0], v0[1]); w.y = cvt_pk_bf16(v0[2], v0[3]); w.z = cvt_pk_bf16(v1[0], v1[1]); w.w = cvt_pk_bf16(v1[2], v1[3]);
                    *(u32x4*)(base + (size_t)row * 1024) = w;
                }
        }
    }
};
template <bool ADD> struct EpiUp {
    static constexpr bool PERM = true, AFTER_DRAIN = false;
    const bf16_t* G; bf16_t* U;
    __device__ __forceinline__ void operator()(const f32x4 (&acc)[2][2][4][2], const Unit& u, int wr, int wc, int fr, int fq) const {
        const int row0 = u.pm * BM + wr * 64 + fr;
#pragma unroll
        for (int bj = 0; bj < 2; ++bj) {
            const int c = u.pn * BM + bj * HALF + wc * 32 + 8 * fq;
#pragma unroll
            for (int ai = 0; ai < 2; ++ai)
#pragma unroll
                for (int m = 0; m < 4; ++m) {
                    const size_t off = (size_t)(row0 + ai * HALF + m * 16) * 1024 + c;
                    const u32x4 g = *(const u32x4*)(G + off);
                    f32x4 v0 = acc[ai][bj][m][0], v1 = acc[ai][bj][m][1];
                    v0[0] *= bf_lo(g.x); v0[1] *= bf_hi(g.x); v0[2] *= bf_lo(g.y); v0[3] *= bf_hi(g.y);
                    v1[0] *= bf_lo(g.z); v1[1] *= bf_hi(g.z); v1[2] *= bf_lo(g.w); v1[3] *= bf_hi(g.w);
                    if (ADD) { const u32x4 p = *(const u32x4*)(U + off);
                        v0[0] += bf_lo(p.x); v0[1] += bf_hi(p.x); v0[2] += bf_lo(p.y); v0[3] += bf_hi(p.y);
                        v1[0] += bf_lo(p.z); v1[1] += bf_hi(p.z); v1[2] += bf_lo(p.w); v1[3] += bf_hi(p.w); }
                    u32x4 w; w.x = cvt_pk_bf16(v0[0], v0[1]); w.y = cvt_pk_bf16(v0[2], v0[3]); w.z = cvt_pk_bf16(v1[0], v1[1]); w.w = cvt_pk_bf16(v1[2], v1[3]);
                    *(u32x4*)(U + off) = w;
                }
        }
    }
};
struct EpiF32 {
    static constexpr bool PERM = false, AFTER_DRAIN = false;
    float* O; int ldc;
    __device__ __forceinline__ void operator()(const f32x4 (&acc)[2][2][4][2], const Unit& u, int wr, int wc, int fr, int fq) const {
        const int row0 = u.pm * BM + wr * 64 + fr, col0 = u.pn * BM + wc * 32 + 4 * fq;
#pragma unroll
        for (int ai = 0; ai < 2; ++ai)
#pragma unroll
            for (int m = 0; m < 4; ++m) { float* rowp = O + (size_t)(row0 + ai * HALF + m * 16) * ldc + col0;
#pragma unroll
                for (int bj = 0; bj < 2; ++bj)
#pragma unroll
                    for (int n = 0; n < 2; ++n) *(f32x4*)(rowp + bj * HALF + n * 16) = acc[ai][bj][m][n]; }
    }
};
template <class Epi, class Sched, bool ALIGN_EPI = false, bool SP2 = false>
__device__ __forceinline__ void gemm_phase(PG8_LAS unsigned char* lds, const Gemm g, const Sched& S, const Epi& E) {
    int tid_o = threadIdx.x; asm volatile("" : "+v"(tid_o));
    const int tid = tid_o, wid = __builtin_amdgcn_readfirstlane(tid >> 6), lane = tid & 63, wr = wid >> 2, wc = wid & 3, fr = lane & 15, fq = lane >> 4;
    const int K = g.K, nt = K / BK;
    unsigned voffA[2], voffB[2];
#pragma unroll
    for (int i = 0; i < 2; ++i) { int R, C; stage_rc(tid * 16 + i * 8192, R, C); const int Rb = Epi::PERM ? ((R & ~31) + perm32(R & 31)) : R;
        voffA[i] = (unsigned)(R * K + C) * 2u; voffB[i] = (unsigned)(Rb * K + C) * 2u; }
    const size_t kstep = (size_t)(BK * 2);
    const size_t hstep = (size_t)HALF * K * 2;
    const size_t tstep = 2 * hstep;
    const unsigned ldsw = (unsigned)wid * 1024u;
    const int aoff = lds_byte(wr * 64 + fr, fq * 8), boff = lds_byte(wc * 32 + fr, fq * 8);
#define PG8_SA(b, h) (((b) * 2 + (h)) * HTB)
#define PG8_SB(b, h) ((4 + (b) * 2 + (h)) * HTB)
#define PG8_STAGE(bufoff, gbase, voff) do { _Pragma("unroll") for (int _i = 0; _i < 2; ++_i) \
        __builtin_amdgcn_global_load_lds((const unsigned*)((const char*)(gbase) + (voff)[_i]), (PG8_LAS unsigned*)(lds + (bufoff) + ldsw + _i * 8192), 16, 0, 0); } while (0)
#define PG8_LDA(dst, b, h) do { _Pragma("unroll") for (int m = 0; m < 4; ++m) _Pragma("unroll") for (int k = 0; k < 2; ++k) dst[m][k] = *(const PG8_LAS bf16x8*)(lds + PG8_SA(b, h) + aoff + m * 2048 + k * 1024); } while (0)
#define PG8_LDB(dst, b, h) do { _Pragma("unroll") for (int n = 0; n < 2; ++n) _Pragma("unroll") for (int k = 0; k < 2; ++k) dst[n][k] = *(const PG8_LAS bf16x8*)(lds + PG8_SB(b, h) + boff + n * 2048 + k * 1024); } while (0)
#define PG8_MMA(ai, bj, At, Bt) do { __builtin_amdgcn_s_setprio(1); _Pragma("unroll") for (int m = 0; m < 4; ++m) _Pragma("unroll") for (int n = 0; n < 2; ++n) _Pragma("unroll") for (int k = 0; k < 2; ++k) \
        acc[ai][bj][m][n] = __builtin_amdgcn_mfma_f32_16x16x32_bf16(Bt[n][k], At[m][k], acc[ai][bj][m][n], 0, 0, 0); __builtin_amdgcn_s_setprio(0); } while (0)
#define PG8_WAIT_V(n) asm volatile("s_waitcnt vmcnt(" #n ")" ::: "memory")
#define PG8_WAIT_L(n) asm volatile("s_waitcnt lgkmcnt(" #n ")" ::: "memory")
#define PG8_BAR __builtin_amdgcn_s_barrier()
#define PG8_SCHED __builtin_amdgcn_sched_barrier(0)
    Unit cur, nxt; int ui = 0;
    if (!S.next(0, cur)) return;
    f32x4 acc[2][2][4][2];
#pragma unroll
    for (int a = 0; a < 2; ++a)
#pragma unroll
        for (int b = 0; b < 2; ++b)
#pragma unroll
            for (int m = 0; m < 4; ++m)
#pragma unroll
                for (int n = 0; n < 2; ++n) acc[a][b][m][n] = (f32x4){0.f, 0.f, 0.f, 0.f};
    bf16x8 At[4][2], B0[2][2], B1[2][2];
    const char* cA = (const char*)g.A + (size_t)cur.pm * tstep; const char* cB = (const char*)g.Bt + (size_t)cur.pn * tstep;
    S.a_ready(cur);
    if constexpr (SP2) {
        PG8_STAGE(PG8_SB(0, 0), cB, voffB); PG8_STAGE(PG8_SB(0, 1), cB + hstep, voffB); PG8_STAGE(PG8_SA(0, 0), cA, voffA); PG8_STAGE(PG8_SA(0, 1), cA + hstep, voffA);
        if (wr == 1) PG8_BAR;
        PG8_WAIT_V(2); PG8_BAR;
        PG8_STAGE(PG8_SB(1, 0), cB + kstep, voffB); PG8_STAGE(PG8_SA(1, 0), cA + kstep, voffA); PG8_STAGE(PG8_SB(1, 1), cB + hstep + kstep, voffB);
        PG8_WAIT_V(6); PG8_BAR;
    } else {
        PG8_STAGE(PG8_SB(0, 0), cB, voffB); PG8_STAGE(PG8_SA(0, 0), cA, voffA); PG8_STAGE(PG8_SB(0, 1), cB + hstep, voffB); PG8_STAGE(PG8_SA(0, 1), cA + hstep, voffA);
        if (wr == 1) PG8_BAR;
        PG8_WAIT_V(4); PG8_BAR;
        PG8_STAGE(PG8_SB(1, 0), cB + kstep, voffB); PG8_STAGE(PG8_SA(1, 0), cA + kstep, voffA); PG8_STAGE(PG8_SB(1, 1), cB + hstep + kstep, voffB);
        PG8_WAIT_V(6); PG8_BAR;
    }
    for (;;) {
        const bool has_next = S.next(ui + 1, nxt);
        const char* nA = has_next ? (const char*)g.A + (size_t)nxt.pm * tstep : cA; const char* nB = has_next ? (const char*)g.Bt + (size_t)nxt.pn * tstep : cB;
        for (int t = 0; t < nt; t += 2) {
            const bool last = (t == nt - 2);
            const char* a1 = cA + (size_t)(t + 1) * kstep;
            const char* a2 = last ? nA : cA + (size_t)(t + 2) * kstep; const char* b2 = last ? nB : cB + (size_t)(t + 2) * kstep;
            const char* a3 = a2 + kstep; const char* b3 = b2 + kstep;
            if (last && has_next) S.a_ready(nxt);
            if constexpr (SP2) {
            PG8_LDB(B0, 0, 0); PG8_LDB(B1, 0, 1); PG8_SCHED; PG8_LDA(At, 0, 0); PG8_STAGE(PG8_SA(1, 1), a1 + hstep, voffA);
            PG8_WAIT_V(8); PG8_WAIT_L(0); PG8_BAR; PG8_MMA(0, 0, At, B0); PG8_MMA(0, 1, At, B1); PG8_BAR; PG8_SCHED;
            PG8_LDA(At, 0, 1); PG8_STAGE(PG8_SB(0, 0), b2, voffB); PG8_STAGE(PG8_SB(0, 1), b2 + hstep, voffB); PG8_STAGE(PG8_SA(0, 0), a2, voffA);
            PG8_WAIT_V(8); PG8_WAIT_L(0); PG8_BAR; PG8_MMA(1, 0, At, B0); PG8_MMA(1, 1, At, B1); PG8_BAR; PG8_SCHED;
            PG8_LDB(B0, 1, 0); PG8_LDB(B1, 1, 1); PG8_SCHED; PG8_LDA(At, 1, 0); PG8_STAGE(PG8_SA(0, 1), a2 + hstep, voffA);
            PG8_WAIT_V(8); PG8_WAIT_L(0); PG8_BAR; PG8_MMA(0, 0, At, B0); PG8_MMA(0, 1, At, B1); PG8_BAR; PG8_SCHED;
            PG8_LDA(At, 1, 1); PG8_STAGE(PG8_SB(1, 0), b3, voffB); PG8_STAGE(PG8_SB(1, 1), b3 + hstep, voffB); PG8_STAGE(PG8_SA(1, 0), a3, voffA);
            PG8_WAIT_V(8); PG8_WAIT_L(0); PG8_BAR; PG8_MMA(1, 0, At, B0); PG8_MMA(1, 1, At, B1); PG8_BAR; PG8_SCHED;
            } else {
            PG8_LDB(B0, 0, 0); PG8_SCHED; PG8_LDA(At, 0, 0); PG8_STAGE(PG8_SA(1, 1), a1 + hstep, voffA);
            PG8_WAIT_L(8); PG8_BAR; PG8_WAIT_L(0); PG8_MMA(0, 0, At, B0); PG8_BAR; PG8_SCHED;
            PG8_LDB(B1, 0, 1); PG8_STAGE(PG8_SB(0, 0), b2, voffB);
            PG8_BAR; PG8_WAIT_L(0); PG8_MMA(0, 1, At, B1); PG8_BAR;
            PG8_LDA(At, 0, 1); PG8_STAGE(PG8_SA(0, 0), a2, voffA);
            PG8_BAR; PG8_WAIT_L(0); PG8_MMA(1, 0, At, B0); PG8_BAR; PG8_SCHED;
            PG8_STAGE(PG8_SB(0, 1), b2 + hstep, voffB);
            PG8_WAIT_V(6); PG8_BAR; PG8_MMA(1, 1, At, B1); PG8_BAR;
            PG8_LDB(B0, 1, 0); PG8_SCHED; PG8_LDA(At, 1, 0); PG8_STAGE(PG8_SA(0, 1), a2 + hstep, voffA);
            PG8_WAIT_L(8); PG8_BAR; PG8_WAIT_L(0); PG8_MMA(0, 0, At, B0); PG8_BAR; PG8_SCHED;
            PG8_LDB(B1, 1, 1); PG8_STAGE(PG8_SB(1, 0), b3, voffB);
            PG8_BAR; PG8_WAIT_L(0); PG8_MMA(0, 1, At, B1); PG8_BAR;
            PG8_LDA(At, 1, 1); PG8_STAGE(PG8_SA(1, 0), a3, voffA);
            PG8_BAR; PG8_WAIT_L(0); PG8_MMA(1, 0, At, B0); PG8_BAR; PG8_SCHED;
            PG8_STAGE(PG8_SB(1, 1), b3 + hstep, voffB);
            PG8_WAIT_V(6); PG8_BAR; PG8_MMA(1, 1, At, B1); PG8_BAR;
            }
        }
        if constexpr (ALIGN_EPI) { if (wr == 0) PG8_BAR; }
        if constexpr (!Epi::AFTER_DRAIN) { E(acc, cur, wr, wc, fr, fq); S.done(cur); }
        if (!has_next) break;
#pragma unroll
        for (int a = 0; a < 2; ++a)
#pragma unroll
            for (int b = 0; b < 2; ++b)
#pragma unroll
                for (int m = 0; m < 4; ++m)
#pragma unroll
                    for (int n = 0; n < 2; ++n) acc[a][b][m][n] = (f32x4){0.f, 0.f, 0.f, 0.f};
        cur = nxt; cA = nA; cB = nB; ++ui;
        if constexpr (ALIGN_EPI) { if (wr == 1) PG8_BAR; }
    }
    PG8_WAIT_V(0);
    if constexpr (!ALIGN_EPI) { if (wr == 0) PG8_BAR; }
    PG8_BAR;
    if constexpr (Epi::AFTER_DRAIN) { E.fused(acc, cur, wr, wc, fr, fq, lds, wid, lane); S.done(cur); }
#undef PG8_SA
#undef PG8_SB
#undef PG8_STAGE
#undef PG8_LDA
#undef PG8_LDB
#undef PG8_MMA
#undef PG8_WAIT_V
#undef PG8_WAIT_L
#undef PG8_BAR
#undef PG8_SCHED
}
}
#define GAS __attribute__((address_space(1)))
#define LAS __attribute__((address_space(3)))
typedef unsigned short bf16;
typedef unsigned v4u __attribute__((ext_vector_type(4)));
typedef float f32x4 __attribute__((ext_vector_type(4)));
typedef short bf16x8 __attribute__((ext_vector_type(8)));
typedef GAS unsigned gu32;
typedef GAS unsigned long long gu64;
#define RLX_AGENT __ATOMIC_RELAXED, __HIP_MEMORY_SCOPE_AGENT
#define LDS_WAIT() asm volatile("s_waitcnt lgkmcnt(0)" ::: "memory")
#define VM_WAIT() asm volatile("s_waitcnt vmcnt(0)" ::: "memory")
__device__ __forceinline__ unsigned long long rt() { return __builtin_amdgcn_s_memrealtime(); }
__device__ __forceinline__ unsigned f2bf(float f) { unsigned u = __builtin_bit_cast(unsigned, f); return (u + 0x7fffu + ((u >> 16) & 1u)) >> 16; }
__device__ __forceinline__ unsigned pk2(float lo, float hi) { return f2bf(lo) | (f2bf(hi) << 16); }

#define XB_TMO      128
#define XB_XCNT(j)  (256  + 64 * (j))
#define XB_XSUB(j)  (1280 + 64 * (j))
#define XB_XGEN(j)  (2304 + 64 * (j))
#define XB_TOP      3328
#define XB_TOPGEN   3392
#define XCD_BAR_WORDS 3456
#define XB_SPIN_CAP (1u << 18)

__device__ __forceinline__ unsigned xb_ld(unsigned* p)              { return __hip_atomic_load(p, __ATOMIC_RELAXED, __HIP_MEMORY_SCOPE_AGENT); }
__device__ __forceinline__ unsigned xb_add(unsigned* p, unsigned v) { return __hip_atomic_fetch_add(p, v, __ATOMIC_RELAXED, __HIP_MEMORY_SCOPE_AGENT); }
__device__ __forceinline__ unsigned xb_xcc_id() { return (unsigned)__builtin_amdgcn_s_getreg((3 << 11) | 20) & 0xFu; }
#define XB_SPIN(cond, bar) do { unsigned _sp = 0; while (cond) { __builtin_amdgcn_s_sleep(1); \
    if ((++_sp & 255u) == 0u) { if (xb_ld(&(bar)[XB_TMO])) break; if (_sp > XB_SPIN_CAP) { atomicAdd(&(bar)[XB_TMO], 1u); break; } } } } while (0)

struct XcdBarrier {
    unsigned* bar; unsigned x;
    volatile LAS unsigned* st;
};

__device__ __forceinline__ XcdBarrier xcd_barrier_post(unsigned* bar, volatile LAS unsigned* st) {
    XcdBarrier b; b.bar = bar; b.x = xb_xcc_id(); b.st = st;
    if (threadIdx.x == 0) (void)xb_add(&bar[XB_XCNT(b.x)], 1u);
    return b;
}
__device__ __forceinline__ void xcd_barrier_complete(unsigned* bar, unsigned x, unsigned& nloc, unsigned& nx) {
    const unsigned G = gridDim.x * gridDim.y * gridDim.z;
    unsigned sum, cnt, mine, sp = 0u;
    for (;;) {
        sum = 0u; cnt = 0u; mine = 0u;
#pragma unroll
        for (unsigned j = 0; j < 16; ++j) { const unsigned c = xb_ld(&bar[XB_XCNT(j)]); sum += c; cnt += (c > 0u) ? 1u : 0u; mine = (j == x) ? c : mine; }
        if (sum == G) break;
        __builtin_amdgcn_s_sleep(1);
        if ((++sp & 255u) == 0u) { if (xb_ld(&bar[XB_TMO])) break; if (sp > XB_SPIN_CAP) { atomicAdd(&bar[XB_TMO], 1u); break; } }
    }
    nloc = mine > 0u ? mine : 1u; nx = cnt > 0u ? cnt : 1u;
}

__device__ __forceinline__ void xcd_barrier(const XcdBarrier& b) {
    asm volatile("s_waitcnt vmcnt(0)" ::: "memory");
    __syncthreads();
    if (threadIdx.x == 0) {
        unsigned* bar = b.bar;
        __builtin_amdgcn_s_waitcnt(0);
        unsigned nloc = b.st[0], nx = b.st[1];
        if (nloc == 0u) { xcd_barrier_complete(bar, b.x, nloc, nx); b.st[0] = nloc; b.st[1] = nx; }
        const unsigned old = xb_add(&bar[XB_XSUB(b.x)], 1u);
        const unsigned gen = old / nloc;
        if (old + 1u == (gen + 1u) * nloc) {
            __builtin_amdgcn_fence(__ATOMIC_RELEASE, "agent");
            asm volatile("s_waitcnt vmcnt(0)" ::: "memory");
            const unsigned og = xb_add(&bar[XB_TOP], 1u);
            const unsigned tg = og / nx;
            if (og + 1u == (tg + 1u) * nx) xb_add(&bar[XB_TOPGEN], 1u);
            else XB_SPIN(xb_ld(&bar[XB_TOPGEN]) == tg, bar);
            __builtin_amdgcn_fence(__ATOMIC_ACQUIRE, "agent");
            xb_add(&bar[XB_XGEN(b.x)], 1u);
            asm volatile("s_waitcnt vmcnt(0)" ::: "memory");
        } else {
            XB_SPIN(xb_ld(&bar[XB_XGEN(b.x)]) == gen, bar);
            __builtin_amdgcn_fence(__ATOMIC_ACQUIRE, "agent");
            asm volatile("s_waitcnt vmcnt(0)" ::: "memory");
        }
    }
    __syncthreads();
}
__device__ __forceinline__ float bf_lo_(unsigned w) { return __builtin_bit_cast(float, w << 16); }
__device__ __forceinline__ float bf_hi_(unsigned w) { return __builtin_bit_cast(float, w & 0xffff0000u); }

constexpr int NWAVES = 8;
constexpr int NB = 8, SEQ = 2048, DM = 1024, M = NB * SEQ;
constexpr int NH = 8, HD = 64, AW = 512;
constexpr int RWS = 1664;
constexpr int DIN = 6272;
constexpr int NA = 4352, NBW = 2048;
constexpr int BLK = 256, NBLK = SEQ / BLK, TOPK = 3;
constexpr float RMS_EPS = 1e-6f, GN_EPS = 64e-5f;
#ifndef MK_SINGLE
#define MK_SINGLE 0
#endif
constexpr int NPH_LAYER = 9, NPHASE = 1 + 2 * NPH_LAYER;

constexpr size_t MiB = 1u << 20;
constexpr size_t WS_CTL = 0, CTL_ZERO_BYTES = 64 * 1024;
constexpr size_t WS_RINV = 1 * MiB, WS_KMEAN = 1 * MiB + 256 * 1024;
constexpr size_t WS_WA = 2 * MiB, WA_BYTES = (size_t)NA * DM * 2;
constexpr size_t WS_WB = 19 * MiB, WB_BYTES = (size_t)NBW * DM * 2;
constexpr size_t WS_WUP = 27 * MiB, WUP_BYTES = 2 * MiB;
constexpr size_t WS_WOUT = 31 * MiB, WOUT_BYTES = 2 * MiB;
constexpr size_t WS_XB = 35 * MiB, WS_VFIRST = 67 * MiB, WS_U = 83 * MiB;
constexpr size_t WS_Q = 115 * MiB, WS_K = 131 * MiB, WS_V = 147 * MiB, WS_AZ = 163 * MiB, WS_RZ = 179 * MiB, WS_RW = 195 * MiB, WS_VD = 247 * MiB;
static_assert(WS_K - WS_Q == 16 * MiB && WS_V - WS_Q == 32 * MiB && WS_AZ - WS_Q == 48 * MiB && WS_RZ - WS_Q == 64 * MiB && WS_RW - WS_Q == 80 * MiB && WS_VD - WS_RW == 52 * MiB, "EpiProjA routing offsets");
constexpr size_t WS_GA = WS_K, WS_GR = WS_RW, WS_Y = WS_Q, WS_END = 248 * MiB;
constexpr int CW_BAR = 1024;

constexpr int RING_OFF = 0, RING_BYTES = 131072;
constexpr int LDSCTL_OFF = RING_BYTES, MISC_OFF = LDSCTL_OFF + 320;
constexpr int LDS_BYTES = 147456;

struct Frame {
    LAS unsigned char* lds;
    volatile LAS unsigned* MISC;
    gu32* ctl;
    int tid, lane, wave, vcu, G;
};
__device__ __forceinline__ float wave_sum(float v) {
#pragma unroll
    for (int o = 1; o < 64; o <<= 1) v += __shfl_xor(v, o);
    return v;
}
__device__ __forceinline__ float wave_max(float v) {
#pragma unroll
    for (int o = 1; o < 64; o <<= 1) v = fmaxf(v, __shfl_xor(v, o));
    return v;
}
__device__ __forceinline__ float bf2f(bf16 v) { return __builtin_bit_cast(float, (unsigned)v << 16); }
__device__ __forceinline__ float rl(float v, int l) { return __builtin_bit_cast(float, __builtin_amdgcn_readlane(__builtin_bit_cast(int, v), l)); }

struct Args { const float* in[21]; float* out; unsigned char* ws; int ph_lo, ph_hi; };
__device__ __forceinline__ const float* inp(const Args& a, int i) { asm volatile("" : "+s"(i)); return a.in[i]; }

__device__ __forceinline__ void p0_transpose_item(const float* W, int ldw, int c0, int k0, const float* g, bf16* WT, int ldk, int n_row0, LAS float* scr, int lane) {
#pragma unroll 8
    for (int i = 0; i < 32; ++i) { const int kk = 2 * i + (lane >> 5); const float s = g ? g[k0 + kk] : 1.0f; scr[kk * 33 + (lane & 31)] = W[(size_t)(k0 + kk) * ldw + c0 + (lane & 31)] * s; }
    LDS_WAIT(); asm volatile("" ::: "memory");
    const int c = lane & 7;
#pragma unroll
    for (int j = 0; j < 4; ++j) { const int n = (lane >> 3) + 8 * j; const LAS float* s = scr + (8 * c) * 33 + n;
        v4u o; o.x = pk2(s[0 * 33], s[1 * 33]); o.y = pk2(s[2 * 33], s[3 * 33]); o.z = pk2(s[4 * 33], s[5 * 33]); o.w = pk2(s[6 * 33], s[7 * 33]);
        *(GAS v4u*)(WT + (size_t)(n_row0 + n) * ldk + k0 + 8 * c) = o; }
    LDS_WAIT(); asm volatile("" ::: "memory");
}
__device__ __forceinline__ void row_to_bf16_rinv(const float* xrow, bf16* orow, float* rinv, int lane) {
    const GAS f32x4* xr = (const GAS f32x4*)xrow + lane;
    f32x4 v[4]; float s = 0.f;
#pragma unroll
    for (int j = 0; j < 4; ++j) { v[j] = xr[64 * j]; s += (v[j].x * v[j].x + v[j].y * v[j].y) + (v[j].z * v[j].z + v[j].w * v[j].w); }
    s = wave_sum(s);
    GAS unsigned long long* o8 = (GAS unsigned long long*)orow + lane;
#pragma unroll
    for (int j = 0; j < 4; ++j) o8[64 * j] = (unsigned long long)pk2(v[j].x, v[j].y) | ((unsigned long long)pk2(v[j].z, v[j].w) << 32);
    if (lane == 0) *rinv = 1.0f / sqrtf(s * (1.0f / DM) + RMS_EPS);
}

__device__ __forceinline__ void p0_prologue(Frame& F, const Args& a) {
    LAS float* scr = (LAS float*)(F.lds + RING_OFF + F.wave * 16384);
    const int gw = F.vcu * NWAVES + F.wave, NGW = F.G * NWAVES;
    unsigned char* ws = a.ws;
    constexpr int I_A = 16 * (4224 / 32), I_V = 16, I_B = 16 * (NBW / 32), I_U = 8 * (DM / 32), I_O = 16 * (DM / 32);
    constexpr int I_LAYER = I_A + I_V + I_B + 2 * I_U + I_O;
    for (int it = gw; it < 2 * I_LAYER; it += NGW) {
        const int l = it / I_LAYER; int r = it % I_LAYER;
        const float* w_in = inp(a, 3) + (size_t)l * DM * DIN; const float* g = inp(a, 1) + l * DM;
        bf16* WA = (bf16*)(ws + WS_WA + l * WA_BYTES); bf16* WB = (bf16*)(ws + WS_WB + l * WB_BYTES);
        bf16* WU = (bf16*)(ws + WS_WUP + l * WUP_BYTES); bf16* WO = (bf16*)(ws + WS_WOUT + l * WOUT_BYTES);
        if (r < I_A) { const int kb = r / (4224 / 32), nb = r % (4224 / 32); p0_transpose_item(w_in, DIN, 32 * nb, 64 * kb, g, WA, DM, 32 * nb, scr, F.lane); continue; } r -= I_A;
        if (r < I_V) { if (l == 1) p0_transpose_item(inp(a, 14), 32, 0, 64 * r, g, WA, DM, 4224, scr, F.lane); continue; } r -= I_V;
        if (r < I_B) { const int kb = r / (NBW / 32), nb = r % (NBW / 32); p0_transpose_item(w_in, DIN, 4224 + 32 * nb, 64 * kb, g, WB, DM, 32 * nb, scr, F.lane); continue; } r -= I_B;
        if (r < I_U) { const int kb = r / (DM / 32), nb = r % (DM / 32); p0_transpose_item(inp(a, 18) + (size_t)l * AW * DM, DM, 32 * nb, 64 * kb, nullptr, WU, AW, 32 * nb, scr, F.lane); continue; } r -= I_U;
        if (r < I_U) { const int kb = r / (DM / 32), nb = r % (DM / 32); p0_transpose_item(inp(a, 19) + (size_t)l * AW * DM, DM, 32 * nb, 64 * kb, nullptr, WU + (size_t)DM * AW, AW, 32 * nb, scr, F.lane); continue; } r -= I_U;
        { const int kb = r / (DM / 32), nb = r % (DM / 32); p0_transpose_item(inp(a, 20) + (size_t)l * DM * DM, DM, 32 * nb, 64 * kb, nullptr, WO, DM, 32 * nb, scr, F.lane); }
    }
    {
        const int gt = F.vcu * (NWAVES * 64) + F.tid, NT = F.G * NWAVES * 64;
        const int n0 = 128 * DM * 2 / 16, n1 = 96 * DM * 2 / 16;
        GAS v4u* z0 = (GAS v4u*)(ws + WS_WA + (size_t)4224 * DM * 2); GAS v4u* z1 = (GAS v4u*)(ws + WS_WA + WA_BYTES + (size_t)4256 * DM * 2);
        for (int i = gt; i < n0; i += NT) z0[i] = (v4u){0u, 0u, 0u, 0u};
        for (int i = gt; i < n1; i += NT) z1[i] = (v4u){0u, 0u, 0u, 0u};
    }
    const float* x = inp(a, 0); bf16* XB = (bf16*)(ws + WS_XB); float* rinv = (float*)(ws + WS_RINV);
    for (int m = gw; m < M; m += NGW) row_to_bf16_rinv(x + (size_t)m * DM, XB + (size_t)m * DM, rinv + m, F.lane);
}

__device__ __forceinline__ void kmean_phase(Frame& F, const Args& a) {
    const bf16* K = (const bf16*)(a.ws + WS_K); float* KM = (float*)(a.ws + WS_KMEAN);
    for (int u = F.vcu; u < NB * NBLK; u += F.G) {
        const bf16* kp = K + (size_t)u * BLK * AW + F.tid; float s = 0.f;
        for (int t = 0; t < BLK; ++t) s += bf2f(kp[(size_t)t * AW]);
        KM[(size_t)u * AW + F.tid] = s * (1.0f / BLK);
    }
}

__device__ __forceinline__ void attn_naive_phase(Frame& F, const Args& a) {
    bf16* Q = (bf16*)(a.ws + WS_Q); const bf16* K = (const bf16*)(a.ws + WS_K); const bf16* V = (const bf16*)(a.ws + WS_V); const bf16* AZ = (const bf16*)(a.ws + WS_AZ);
    const float* KM = (const float*)(a.ws + WS_KMEAN);
    const int gw = F.vcu * NWAVES + F.wave, NGW = F.G * NWAVES, lane = F.lane;
    for (int u = gw; u < NB * NH * SEQ; u += NGW) {
        const int bh = u >> 11, q = u & (SEQ - 1), b = bh >> 3, h = bh & 7, qblk = q >> 8;
        const size_t rowq = (size_t)b * SEQ + q;
        float qf[64];
        { const v4u* qp = (const v4u*)(Q + rowq * AW + h * HD);
#pragma unroll
          for (int i = 0; i < 8; ++i) { const v4u w = qp[i]; qf[8 * i + 0] = bf_lo_(w.x); qf[8 * i + 1] = bf_hi_(w.x); qf[8 * i + 2] = bf_lo_(w.y); qf[8 * i + 3] = bf_hi_(w.y);
              qf[8 * i + 4] = bf_lo_(w.z); qf[8 * i + 5] = bf_hi_(w.z); qf[8 * i + 6] = bf_lo_(w.w); qf[8 * i + 7] = bf_hi_(w.w); } }
        float g = 0.f; { const int j = lane & 7; const float* km = KM + ((size_t)(b * NBLK + j)) * AW + h * HD;
#pragma unroll
            for (int d = 0; d < 64; ++d) g += (qf[d] * 0.125f) * km[d];
            if (j >= qblk) g = -1e30f; }
        unsigned selmask = 0u;
        { float gj[8];
#pragma unroll
          for (int i = 0; i < 8; ++i) gj[i] = __shfl(g, i);
#pragma unroll
          for (int j = 0; j < 8; ++j) { int rank = 0;
#pragma unroll
              for (int i = 0; i < 8; ++i) rank += (gj[i] > gj[j] || (gj[i] == gj[j] && i < j)) ? 1 : 0;
              if (rank < TOPK && j < qblk) selmask |= 1u << j; } }
        const float slope = exp2f(-(float)(h + 1));
        float mrun = -1e30f, lrun = 0.f, o = 0.f;
        for (int j = 0; j <= qblk; ++j) {
            const bool own = (j == qblk);
            if (!own && !((selmask >> j) & 1u)) continue;
            for (int tt = 0; tt < 4; ++tt) {
                const int k0 = j * BLK + tt * 64; if (own && k0 > q) break;
                const int key = k0 + lane;
                const v4u* kp = (const v4u*)(K + ((size_t)b * SEQ + key) * AW + h * HD);
                float s = 0.f;
#pragma unroll
                for (int i = 0; i < 8; ++i) { const v4u w = kp[i];
                    s += qf[8 * i + 0] * bf_lo_(w.x) + qf[8 * i + 1] * bf_hi_(w.x) + qf[8 * i + 2] * bf_lo_(w.y) + qf[8 * i + 3] * bf_hi_(w.y)
                       + qf[8 * i + 4] * bf_lo_(w.z) + qf[8 * i + 5] * bf_hi_(w.z) + qf[8 * i + 6] * bf_lo_(w.w) + qf[8 * i + 7] * bf_hi_(w.w); }
                s = s * 0.125f - slope * (float)(q - key);
                if (key > q) s = -1e30f;
                const float tm = wave_max(s), mnew = fmaxf(mrun, tm), sc = __expf(mrun - mnew), p = __expf(s - mnew);
                lrun = lrun * sc + wave_sum(p); o *= sc; mrun = mnew;
                const bf16* vp = V + ((size_t)b * SEQ + k0) * AW + h * HD + lane;
#pragma unroll 8
                for (int kk = 0; kk < 64; ++kk) o += __shfl(p, kk) * bf2f(vp[(size_t)kk * AW]);
            }
        }
        const float az = bf2f(AZ[rowq * AW + h * HD + lane]);
        const float y = (o / lrun) * (az / (1.0f + __expf(-az)));
        Q[rowq * AW + h * HD + lane] = (bf16)f2bf(y);
    }
}

__device__ __forceinline__ void scan_naive_phase(Frame& F, const Args& a, int l) {
    if (F.wave != 0) return;
    const int lane = F.lane;
    const bf16* RW = (const bf16*)(a.ws + WS_RW); bf16* RZ = (bf16*)(a.ws + WS_RZ); const bf16* VD = (const bf16*)(a.ws + WS_VD); bf16* VF = (bf16*)(a.ws + WS_VFIRST);
    LAS float* wup = (LAS float*)(F.lds + RING_OFF);
    LAS float* aup = wup + 4096;
    LAS float* vup = aup + 4096;
    for (int u = F.vcu; u < NB * NH; u += F.G) {
        const int b = u >> 3, h = u & 7, col = h * HD + lane;
        for (int j = 0; j < 64; ++j) { wup[j * 64 + lane] = inp(a, 6)[((size_t)l * 64 + j) * AW + col]; aup[j * 64 + lane] = inp(a, 8)[((size_t)l * 64 + j) * AW + col]; }
        if (l == 1) for (int j = 0; j < 32; ++j) vup[j * 64 + lane] = inp(a, 16)[(size_t)j * AW + col];
        LDS_WAIT();
        const float* mu = inp(a, 4) + (size_t)l * RWS;
        const float mu_r = mu[col], mu_k = mu[512 + col], mu_v = mu[1024 + col], mu_wd = mu[1536 + lane], mu_ad = mu[1600 + lane];
        const float w0 = inp(a, 5)[l * AW + col], a0 = inp(a, 7)[l * AW + col], k_k = inp(a, 9)[l * AW + col], k_a = inp(a, 10)[l * AW + col], r_k = inp(a, 11)[l * AW + col];
        const float ln_g = inp(a, 12)[l * AW + col], ln_b = inp(a, 13)[l * AW + col];
        const float vmu = (l == 1) ? inp(a, 15)[lane & 31] : 0.f, vm0 = (l == 1) ? inp(a, 17)[col] : 0.f;
        float S[64];
#pragma unroll
        for (int k = 0; k < 64; ++k) S[k] = 0.f;
        float p_r = 0.f, p_k = 0.f, p_v = 0.f, p_wd = 0.f, p_ad = 0.f, p_vd = 0.f;
        for (int t = 0; t < SEQ; ++t) {
            const size_t row = (size_t)b * SEQ + t; const bf16* rw = RW + row * RWS;
            const float c_r = bf2f(rw[col]), c_k = bf2f(rw[512 + col]), c_v = bf2f(rw[1024 + col]), c_wd = bf2f(rw[1536 + lane]), c_ad = bf2f(rw[1600 + lane]);
            const float r = c_r + (p_r - c_r) * mu_r, ks = c_k + (p_k - c_k) * mu_k, vs = c_v + (p_v - c_v) * mu_v, wd = c_wd + (p_wd - c_wd) * mu_wd, ad = c_ad + (p_ad - c_ad) * mu_ad;
            p_r = c_r; p_k = c_k; p_v = c_v; p_wd = c_wd; p_ad = c_ad;
            const float twd = tanhf(wd);
            float xw = w0, xa = a0;
#pragma unroll 16
            for (int j = 0; j < 64; ++j) { xw += rl(twd, j) * wup[j * 64 + lane]; xa += rl(ad, j) * aup[j * 64 + lane]; }
            const float z = -xw, sp = fmaxf(z, 0.f) + log1pf(__expf(-fabsf(z)));
            const float wlog = -sp - 0.5f, w = __expf(-__expf(wlog));
            const float av = 1.0f / (1.0f + __expf(-xa));
            float vr = vs;
            if (l == 0) VF[row * AW + col] = (bf16)f2bf(vs);
            else {
                const float c_vd = bf2f(VD[row * 32 + (lane & 31)]); const float vd = c_vd + (p_vd - c_vd) * vmu; p_vd = c_vd;
                float xv = vm0;
#pragma unroll 16
                for (int j = 0; j < 32; ++j) xv += rl(vd, j) * vup[j * 64 + lane];
                const float vf = bf2f(VF[row * AW + col]);
                vr = vs + (vf - vs) * (1.0f / (1.0f + __expf(-xv)));
            }
            const float kkv = ks * k_k; const float nrm = sqrtf(wave_sum(kkv * kkv)); const float kkn = kkv / fmaxf(nrm, 1e-12f);
            const float kmod = ks * (1.0f + (av - 1.0f) * k_a), bb = kkn * av;
            const float cb = wave_sum(r * kmod * r_k);
            float sa = 0.f;
#pragma unroll
            for (int k = 0; k < 64; ++k) sa -= S[k] * rl(kkn, k);
            float o = 0.f;
#pragma unroll
            for (int k = 0; k < 64; ++k) { S[k] = S[k] * rl(w, k) + sa * rl(bb, k) + vr * rl(kmod, k); o += S[k] * rl(r, k); }
            const float mean = wave_sum(o) * (1.0f / 64.0f), d = o - mean, var = wave_sum(d * d) * (1.0f / 64.0f);
            const float on = d * (1.0f / sqrtf(var + GN_EPS)) * ln_g + ln_b;
            const float rz = bf2f(RZ[row * AW + col]);
            RZ[row * AW + col] = (bf16)f2bf((on + cb * vr) * (rz / (1.0f + __expf(-rz))));
        }
    }
}

__device__ __forceinline__ void norm_phase(Frame& F, const Args& a, int l) {
    const int gw = F.vcu * NWAVES + F.wave, NGW = F.G * NWAVES, lane = F.lane;
    const float* Y = (const float*)(a.ws + WS_Y); const float* xold = (l == 0) ? inp(a, 0) : a.out; const float* gp = inp(a, 2) + l * DM;
    bf16* XB = (bf16*)(a.ws + WS_XB); float* rinv = (float*)(a.ws + WS_RINV);
    f32x4 gv[4];
#pragma unroll
    for (int j = 0; j < 4; ++j) gv[j] = ((const f32x4*)gp)[lane + 64 * j];
    for (int m = gw; m < M; m += NGW) {
        const f32x4* yr = (const f32x4*)(Y + (size_t)m * DM) + lane; const f32x4* xr = (const f32x4*)(xold + (size_t)m * DM) + lane;
        f32x4 y[4], x[4]; float s = 0.f;
#pragma unroll
        for (int j = 0; j < 4; ++j) { y[j] = yr[64 * j]; x[j] = xr[64 * j]; s += (y[j].x * y[j].x + y[j].y * y[j].y) + (y[j].z * y[j].z + y[j].w * y[j].w); }
        const float ry = 1.0f / sqrtf(wave_sum(s) * (1.0f / DM) + RMS_EPS); float s2 = 0.f;
#pragma unroll
        for (int j = 0; j < 4; ++j) { x[j] = x[j] + y[j] * ry * gv[j]; s2 += (x[j].x * x[j].x + x[j].y * x[j].y) + (x[j].z * x[j].z + x[j].w * x[j].w); }
        f32x4* orow = (f32x4*)(a.out + (size_t)m * DM) + lane;
#pragma unroll
        for (int j = 0; j < 4; ++j) orow[64 * j] = x[j];
        if (l == 0) {
            s2 = wave_sum(s2);
            GAS unsigned long long* o8 = (GAS unsigned long long*)(XB + (size_t)m * DM) + lane;
#pragma unroll
            for (int j = 0; j < 4; ++j) o8[64 * j] = (unsigned long long)pk2(x[j].x, x[j].y) | ((unsigned long long)pk2(x[j].z, x[j].w) << 32);
            if (lane == 0) rinv[m] = 1.0f / sqrtf(s2 * (1.0f / DM) + RMS_EPS);
        }
    }
}

__global__ void __launch_bounds__(NWAVES * 64, 2) mk_fwd(Args args) {
    extern __shared__ __attribute__((aligned(16))) unsigned char lds[];
    Frame F;
    F.lds = (LAS unsigned char*)lds;
    F.MISC = (volatile LAS unsigned*)(F.lds + MISC_OFF);
    F.tid = threadIdx.x; F.lane = F.tid & 63; F.wave = __builtin_amdgcn_readfirstlane(F.tid >> 6);
    F.G = gridDim.x; { const int bx = blockIdx.x; F.vcu = (F.G % 8 == 0) ? (bx % 8) * (F.G / 8) + bx / 8 : bx; }
    const int vcu0 = F.vcu;
    unsigned char* ws = args.ws;
    F.ctl = (gu32*)(ws + WS_CTL);
    for (int u = F.tid; u < (LDS_BYTES - LDSCTL_OFF) / 4; u += NWAVES * 64) ((LAS unsigned*)(F.lds + LDSCTL_OFF))[u] = 0u;
    __syncthreads();
    XcdBarrier bar; bar.bar = (unsigned*)(F.ctl + CW_BAR); bar.x = 0; bar.st = nullptr;
    const bool use_bar = (args.ph_hi - args.ph_lo) > 1;
    if (use_bar) bar = xcd_barrier_post((unsigned*)(F.ctl + CW_BAR), F.MISC + 8);

    for (int ph_ = args.ph_lo; ph_ < args.ph_hi; ++ph_) {
        int ph = ph_; asm volatile("" : "+s"(ph));
        { int t_ = threadIdx.x; asm volatile("" : "+v"(t_)); F.tid = t_; F.lane = t_ & 63; F.wave = __builtin_amdgcn_readfirstlane(t_ >> 6); int g_ = gridDim.x, v_ = vcu0; asm volatile("" : "+s"(g_), "+s"(v_)); F.G = g_; F.vcu = v_; }
        if (ph == 0) p0_prologue(F, args);
        else {
            const int l = (ph - 1) / NPH_LAYER, sp = (ph - 1) % NPH_LAYER;
            const float* rinv = (const float*)(ws + WS_RINV);
            pg8::bf16_t* XB = (pg8::bf16_t*)(ws + WS_XB);
            if (sp == 0) {
                pg8::Gemm g{XB, (const pg8::bf16_t*)(ws + WS_WA + l * WA_BYTES), M, NA, DM}; pg8::StaticOrder S; S.init(M, NA, F.G, (int)blockIdx.x);
                pg8::EpiProjA E{rinv, (pg8::bf16_t*)(ws + WS_Q)};
                pg8::gemm_phase<pg8::EpiProjA, pg8::StaticOrder, true, true>(F.lds + RING_OFF, g, S, E);
            } else if (sp == 1) kmean_phase(F, args);
            else if (sp == 2) attn_naive_phase(F, args);
            else if (sp == 3) scan_naive_phase(F, args, l);
            else if (sp == 4) {
                pg8::Gemm g{XB, (const pg8::bf16_t*)(ws + WS_WB + l * WB_BYTES), M, NBW, DM}; pg8::StaticOrder S; S.init(M, NBW, F.G, (int)blockIdx.x);
                pg8::EpiProjB E{rinv, (pg8::bf16_t*)(ws + WS_GA), (pg8::bf16_t*)(ws + WS_GR)};
                pg8::gemm_phase<pg8::EpiProjB, pg8::StaticOrder, true, true>(F.lds + RING_OFF, g, S, E);
            } else if (sp == 5) {
                pg8::Gemm g{(const pg8::bf16_t*)(ws + WS_Q), (const pg8::bf16_t*)(ws + WS_WUP + l * WUP_BYTES), M, DM, AW}; pg8::StaticOrder S; S.init(M, DM, F.G, (int)blockIdx.x);
                pg8::EpiUp<false> E{(const pg8::bf16_t*)(ws + WS_GA), (pg8::bf16_t*)(ws + WS_U)};
                pg8::gemm_phase<pg8::EpiUp<false>, pg8::StaticOrder, true, true>(F.lds + RING_OFF, g, S, E);
            } else if (sp == 6) {
                pg8::Gemm g{(const pg8::bf16_t*)(ws + WS_RZ), (const pg8::bf16_t*)(ws + WS_WUP + l * WUP_BYTES + (size_t)DM * AW * 2), M, DM, AW}; pg8::StaticOrder S; S.init(M, DM, F.G, (int)blockIdx.x);
                pg8::EpiUp<true> E{(const pg8::bf16_t*)(ws + WS_GR), (pg8::bf16_t*)(ws + WS_U)};
                pg8::gemm_phase<pg8::EpiUp<true>, pg8::StaticOrder, true, true>(F.lds + RING_OFF, g, S, E);
            } else if (sp == 7) {
                pg8::Gemm g{(const pg8::bf16_t*)(ws + WS_U), (const pg8::bf16_t*)(ws + WS_WOUT + l * WOUT_BYTES), M, DM, DM}; pg8::StaticOrder S; S.init(M, DM, F.G, (int)blockIdx.x);
                pg8::EpiF32 E{(float*)(ws + WS_Y), DM};
                pg8::gemm_phase<pg8::EpiF32, pg8::StaticOrder, true, true>(F.lds + RING_OFF, g, S, E);
            } else norm_phase(F, args, l);
        }
        if (ph_ + 1 < args.ph_hi) xcd_barrier(bar);
    }
}

extern "C" void kernel_launch(void* const* d_in, const int* in_sizes, int n_in, void* d_out, int out_size, void* d_ws, size_t ws_size, hipStream_t stream) {
    static int grid = 0;
    if (grid == 0) {
        if (n_in != 21 || in_sizes[0] != M * DM || out_size != M * DM || ws_size < WS_END) { fprintf(stderr, "kernel_launch: unexpected shapes (n_in %d, in0 %d, out %d, ws %zu); nothing launched\n", n_in, n_in > 0 ? in_sizes[0] : -1, out_size, ws_size); grid = -1; return; }
        int dev = 0, cus = 0;
        if (hipGetDevice(&dev) != hipSuccess || hipDeviceGetAttribute(&cus, hipDeviceAttributeMultiprocessorCount, dev) != hipSuccess) { grid = -1; return; }
        if (hipFuncSetAttribute((const void*)mk_fwd, hipFuncAttributeMaxDynamicSharedMemorySize, LDS_BYTES) != hipSuccess) { fprintf(stderr, "kernel_launch: hipFuncSetAttribute failed\n"); grid = -1; return; }
        (void)hipGetLastError();
        grid = cus;
    }
    if (grid < 0) return;
    if (hipMemsetAsync((char*)d_ws + WS_CTL, 0, CTL_ZERO_BYTES, stream) != hipSuccess) return;
    Args a{};
    for (int i = 0; i < 21; ++i) a.in[i] = (const float*)d_in[i];
    a.out = (float*)d_out; a.ws = (unsigned char*)d_ws;
#if MK_SINGLE
    a.ph_lo = 0; a.ph_hi = NPHASE;
    hipLaunchKernelGGL(mk_fwd, dim3(grid), dim3(NWAVES * 64), LDS_BYTES, stream, a);
#else
    for (int p = 0; p < NPHASE; ++p) { a.ph_lo = p; a.ph_hi = p + 1; hipLaunchKernelGGL(mk_fwd, dim3(grid), dim3(NWAVES * 64), LDS_BYTES, stream, a); }
#endif
}
```

```cpp
#ifndef MK_SINGLE
#define MK_SINGLE 1
#endif
#include <hip/hip_runtime.h>
#include <cstdio>
#include <cstdint>
namespace pg8 {
#define PG8_LAS __attribute__((address_space(3)))
typedef unsigned short bf16_t;
typedef short bf16x8 __attribute__((ext_vector_type(8)));
typedef float f32x4 __attribute__((ext_vector_type(4)));
typedef unsigned u32x4 __attribute__((ext_vector_type(4)));
constexpr int BM = 256, BK = 64, HALF = 128, HTB = HALF * BK * 2  , STAGE_BYTES = 8 * HTB, NXCD = 8, WGM = 8;

__host__ __device__ __forceinline__ int lds_byte(int r, int c) { const int st = (r >> 4) * 2 + (c >> 5), rr = r & 15, cc = c & 31, ob = rr * 64 + cc * 2; return st * 1024 + (ob ^ (((ob >> 9) & 1) << 5)); }
__host__ __device__ __forceinline__ void stage_rc(int b, int& R, int& C) { const int st = b / 1024, sb = b % 1024, swz = sb ^ (((sb >> 9) & 1) << 5); R = (st >> 1) * 16 + swz / 64; C = (st & 1) * 32 + (swz % 64) / 2; }
__host__ __device__ __forceinline__ int perm32(int rho) { const int n = rho >> 4, i = rho & 15; return 8 * (i >> 2) + 4 * n + (i & 3); }

struct Unit { int pm, pn; };
struct Gemm { const bf16_t* A; const bf16_t* Bt; int M, N, K; };

struct StaticOrder {
    int nM, nN, nwg, G, c;
    __host__ __device__ void init(int M, int N, int G_, int c_) { nM = M / BM; nN = N / BM; nwg = nM * nN; G = G_; c = c_; }
    __host__ __device__ bool next(int i, Unit& u) const {
        const long L = (long)i * G + c; if (L >= nwg) return false;
        int wgid = (int)L; { const int q = nwg / NXCD, r = nwg % NXCD, xcd = wgid % NXCD, off = wgid / NXCD; wgid = (xcd < r ? xcd * (q + 1) : r * (q + 1) + (xcd - r) * q) + off; }
        const int nig = WGM * nN, gid = wgid / nig, fm = gid * WGM, gsz = (nM - fm) < WGM ? (nM - fm) : WGM;
        u.pm = fm + ((wgid % nig) % gsz); u.pn = (wgid % nig) / gsz; return true;
    }
    __device__ __forceinline__ void a_ready(const Unit&) const {}
    __device__ __forceinline__ void done(const Unit&) const {}
};


__device__ __forceinline__ unsigned cvt_pk_bf16(float lo, float hi) { unsigned r; asm volatile("v_cvt_pk_bf16_f32 %0, %1, %2" : "=v"(r) : "v"(lo), "v"(hi)); return r; }
__device__ __forceinline__ float bf_lo(unsigned w) { return __builtin_bit_cast(float, w << 16); }
__device__ __forceinline__ float bf_hi(unsigned w) { return __builtin_bit_cast(float, w & 0xffff0000u); }
__device__ __forceinline__ float sigmoidf_(float x) { return 1.0f / (1.0f + __expf(-x)); }

struct EpiProjA {
    static constexpr bool PERM = true, AFTER_DRAIN = false;
    const float* rinv; bf16_t* base0;
    __device__ __forceinline__ void operator()(const f32x4 (&acc)[2][2][4][2], const Unit& u, int wr, int wc, int fr, int fq) const {
        const int row0 = u.pm * BM + wr * 64 + fr;
#pragma unroll
        for (int bj = 0; bj < 2; ++bj) {
            const int colw = u.pn * BM + bj * HALF + wc * 32;
            size_t boff; int ld, c;
            if (colw < 2048) { boff = (size_t)(colw >> 9) * (8u << 20); ld = 512; c = colw & 511; }
            else if (colw < 3712) { boff = (size_t)5 * (8u << 20); ld = 1664; c = colw - 2048; }
            else if (colw < 4224) { boff = (size_t)4 * (8u << 20); ld = 512; c = colw - 3712; }
            else if (colw < 4256) { boff = (size_t)5 * (8u << 20) + (size_t)26 * (1u << 20); ld = 32; c = colw - 4224; }
            else continue;
            bf16_t* base = base0 + boff + c + 8 * fq;
            const float qs = colw < 512 ? 0.18033688011112042f : 1.0f;
#pragma unroll
            for (int ai = 0; ai < 2; ++ai)
#pragma unroll
                for (int m = 0; m < 4; ++m) {
                    const int row = row0 + ai * HALF + m * 16; const float rs = rinv[row] * qs;
                    const f32x4 v0 = acc[ai][bj][m][0] * rs, v1 = acc[ai][bj][m][1] * rs;
                    u32x4 w; w.x = cvt_pk_bf16(v0[0], v0[1]); w.y = cvt_pk_bf16(v0[2], v0[3]); w.z = cvt_pk_bf16(v1[0], v1[1]); w.w = cvt_pk_bf16(v1[2], v1[3]);
                    *(u32x4*)(base + (size_t)row * ld) = w;
                }
        }
    }
};
struct EpiProjB {
    static constexpr bool PERM = true, AFTER_DRAIN = false;
    const float* rinv; bf16_t *GA, *GR;
    __device__ __forceinline__ void operator()(const f32x4 (&acc)[2][2][4][2], const Unit& u, int wr, int wc, int fr, int fq) const {
        const int row0 = u.pm * BM + wr * 64 + fr;
#pragma unroll
        for (int bj = 0; bj < 2; ++bj) {
            const int colw = u.pn * BM + bj * HALF + wc * 32;
            bf16_t* base = (colw < 1024 ? GA : GR) + (colw & 1023) + 8 * fq;
#pragma unroll
            for (int ai = 0; ai < 2; ++ai)
#pragma unroll
                for (int m = 0; m < 4; ++m) {
                    const int row = row0 + ai * HALF + m * 16; const float rs = rinv[row];
                    f32x4 v0 = acc[ai][bj][m][0] * rs, v1 = acc[ai][bj][m][1] * rs;
#pragma unroll
                    for (int e = 0; e < 4; ++e) { v0[e] = sigmoidf_(v0[e]); v1[e] = sigmoidf_(v1[e]); }
                    u32x4 w; w.x = cvt_pk_bf16(v0[0], v0[1]); w.y = cvt_pk_bf16(v0[2], v0[3]); w.z = cvt_pk_bf16(v1[0], v1[1]); w.w = cvt_pk_bf16(v1[2], v1[3]);
                    *(u32x4*)(base + (size_t)row * 1024) = w;
                }
        }
    }
};
template <bool ADD> struct EpiUp {
    static constexpr bool PERM = true, AFTER_DRAIN = false;
    const bf16_t* G; bf16_t* U;
    __device__ __forceinline__ void operator()(const f32x4 (&acc)[2][2][4][2], const Unit& u, int wr, int wc, int fr, int fq) const {
        const int row0 = u.pm * BM + wr * 64 + fr;
#pragma unroll
        for (int bj = 0; bj < 2; ++bj) {
            const int c = u.pn * BM + bj * HALF + wc * 32 + 8 * fq;
#pragma unroll
            for (int ai = 0; ai < 2; ++ai)
#pragma unroll
                for (int m = 0; m < 4; ++m) {
                    const size_t off = (size_t)(row0 + ai * HALF + m * 16) * 1024 + c;
                    const u32x4 g = *(const u32x4*)(G + off);
                    f32x4 v0 = acc[ai][bj][m][0], v1 = acc[ai][bj][m][1];
                    v0[0] *= bf_lo(g.x); v0[1] *= bf_hi(g.x); v0[2] *= bf_lo(g.y); v0[3] *= bf_hi(g.y);
                    v1[0] *= bf_lo(g.z); v1[1] *= bf_hi(g.z); v1[2] *= bf_lo(g.w); v1[3] *= bf_hi(g.w);
                    if (ADD) { const u32x4 p = *(const u32x4*)(U + off);
                        v0[0] += bf_lo(p.x); v0[1] += bf_hi(p.x); v0[2] += bf_lo(p.y); v0[3] += bf_hi(p.y);
                        v1[0] += bf_lo(p.z); v1[1] += bf_hi(p.z); v1[2] += bf_lo(p.w); v1[3] += bf_hi(p.w); }
                    u32x4 w; w.x = cvt_pk_bf16(v0[0], v0[1]); w.y = cvt_pk_bf16(v0[2], v0[3]); w.z = cvt_pk_bf16(v1[0], v1[1]); w.w = cvt_pk_bf16(v1[2], v1[3]);
                    *(u32x4*)(U + off) = w;
                }
        }
    }
};
struct EpiF32 {
    static constexpr bool PERM = false, AFTER_DRAIN = false;
    float* O; int ldc;
    __device__ __forceinline__ void operator()(const f32x4 (&acc)[2][2][4][2], const Unit& u, int wr, int wc, int fr, int fq) const {
        const int row0 = u.pm * BM + wr * 64 + fr, col0 = u.pn * BM + wc * 32 + 4 * fq;
#pragma unroll
        for (int ai = 0; ai < 2; ++ai)
#pragma unroll
            for (int m = 0; m < 4; ++m) { float* rowp = O + (size_t)(row0 + ai * HALF + m * 16) * ldc + col0;
#pragma unroll
                for (int bj = 0; bj < 2; ++bj)
#pragma unroll
                    for (int n = 0; n < 2; ++n) *(f32x4*)(rowp + bj * HALF + n * 16) = acc[ai][bj][m][n]; }
    }
};
template <class Epi, class Sched, bool ALIGN_EPI = false, bool SP2 = false>
__device__ __forceinline__ void gemm_phase(PG8_LAS unsigned char* lds, const Gemm g, const Sched& S, const Epi& E) {
    int tid_o = threadIdx.x; asm volatile("" : "+v"(tid_o));
    const int tid = tid_o, wid = __builtin_amdgcn_readfirstlane(tid >> 6), lane = tid & 63, wr = wid >> 2, wc = wid & 3, fr = lane & 15, fq = lane >> 4;
    const int K = g.K, nt = K / BK;
    unsigned voffA[2], voffB[2];
#pragma unroll
    for (int i = 0; i < 2; ++i) { int R, C; stage_rc(tid * 16 + i * 8192, R, C); const int Rb = Epi::PERM ? ((R & ~31) + perm32(R & 31)) : R;
        voffA[i] = (unsigned)(R * K + C) * 2u; voffB[i] = (unsigned)(Rb * K + C) * 2u; }
    const size_t kstep = (size_t)(BK * 2);
    const size_t hstep = (size_t)HALF * K * 2;
    const size_t tstep = 2 * hstep;
    const unsigned ldsw = (unsigned)wid * 1024u;
    const int aoff = lds_byte(wr * 64 + fr, fq * 8), boff = lds_byte(wc * 32 + fr, fq * 8);
#define PG8_SA(b, h) (((b) * 2 + (h)) * HTB)
#define PG8_SB(b, h) ((4 + (b) * 2 + (h)) * HTB)
#define PG8_STAGE(bufoff, gbase, voff) do { _Pragma("unroll") for (int _i = 0; _i < 2; ++_i) \
        __builtin_amdgcn_global_load_lds((const unsigned*)((const char*)(gbase) + (voff)[_i]), (PG8_LAS unsigned*)(lds + (bufoff) + ldsw + _i * 8192), 16, 0, 0); } while (0)
#define PG8_LDA(dst, b, h) do { _Pragma("unroll") for (int m = 0; m < 4; ++m) _Pragma("unroll") for (int k = 0; k < 2; ++k) dst[m][k] = *(const PG8_LAS bf16x8*)(lds + PG8_SA(b, h) + aoff + m * 2048 + k * 1024); } while (0)
#define PG8_LDB(dst, b, h) do { _Pragma("unroll") for (int n = 0; n < 2; ++n) _Pragma("unroll") for (int k = 0; k < 2; ++k) dst[n][k] = *(const PG8_LAS bf16x8*)(lds + PG8_SB(b, h) + boff + n * 2048 + k * 1024); } while (0)
#define PG8_MMA(ai, bj, At, Bt) do { __builtin_amdgcn_s_setprio(1); _Pragma("unroll") for (int m = 0; m < 4; ++m) _Pragma("unroll") for (int n = 0; n < 2; ++n) _Pragma("unroll") for (int k = 0; k < 2; ++k) \
        acc[ai][bj][m][n] = __builtin_amdgcn_mfma_f32_16x16x32_bf16(Bt[n][k], At[m][k], acc[ai][bj][m][n], 0, 0, 0); __builtin_amdgcn_s_setprio(0); } while (0)
#define PG8_WAIT_V(n) asm volatile("s_waitcnt vmcnt(" #n ")" ::: "memory")
#define PG8_WAIT_L(n) asm volatile("s_waitcnt lgkmcnt(" #n ")" ::: "memory")
#define PG8_BAR __builtin_amdgcn_s_barrier()
#define PG8_SCHED __builtin_amdgcn_sched_barrier(0)
    Unit cur, nxt; int ui = 0;
    if (!S.next(0, cur)) return;
    f32x4 acc[2][2][4][2];
#pragma unroll
    for (int a = 0; a < 2; ++a)
#pragma unroll
        for (int b = 0; b < 2; ++b)
#pragma unroll
            for (int m = 0; m < 4; ++m)
#pragma unroll
                for (int n = 0; n < 2; ++n) acc[a][b][m][n] = (f32x4){0.f, 0.f, 0.f, 0.f};
    bf16x8 At[4][2], B0[2][2], B1[2][2];
    const char* cA = (const char*)g.A + (size_t)cur.pm * tstep; const char* cB = (const char*)g.Bt + (size_t)cur.pn * tstep;
    S.a_ready(cur);
    if constexpr (SP2) {
        PG8_STAGE(PG8_SB(0, 0), cB, voffB); PG8_STAGE(PG8_SB(0, 1), cB + hstep, voffB); PG8_STAGE(PG8_SA(0, 0), cA, voffA); PG8_STAGE(PG8_SA(0, 1), cA + hstep, voffA);
        if (wr == 1) PG8_BAR;
        PG8_WAIT_V(2); PG8_BAR;
        PG8_STAGE(PG8_SB(1, 0), cB + kstep, voffB); PG8_STAGE(PG8_SA(1, 0), cA + kstep, voffA); PG8_STAGE(PG8_SB(1, 1), cB + hstep + kstep, voffB);
        PG8_WAIT_V(6); PG8_BAR;
    } else {
        PG8_STAGE(PG8_SB(0, 0), cB, voffB); PG8_STAGE(PG8_SA(0, 0), cA, voffA); PG8_STAGE(PG8_SB(0, 1), cB + hstep, voffB); PG8_STAGE(PG8_SA(0, 1), cA + hstep, voffA);
        if (wr == 1) PG8_BAR;
        PG8_WAIT_V(4); PG8_BAR;
        PG8_STAGE(PG8_SB(1, 0), cB + kstep, voffB); PG8_STAGE(PG8_SA(1, 0), cA + kstep, voffA); PG8_STAGE(PG8_SB(1, 1), cB + hstep + kstep, voffB);
        PG8_WAIT_V(6); PG8_BAR;
    }
    for (;;) {
        const bool has_next = S.next(ui + 1, nxt);
        const char* nA = has_next ? (const char*)g.A + (size_t)nxt.pm * tstep : cA; const char* nB = has_next ? (const char*)g.Bt + (size_t)nxt.pn * tstep : cB;
        for (int t = 0; t < nt; t += 2) {
            const bool last = (t == nt - 2);
            const char* a1 = cA + (size_t)(t + 1) * kstep;
            const char* a2 = last ? nA : cA + (size_t)(t + 2) * kstep; const char* b2 = last ? nB : cB + (size_t)(t + 2) * kstep;
            const char* a3 = a2 + kstep; const char* b3 = b2 + kstep;
            if (last && has_next) S.a_ready(nxt);
            if constexpr (SP2) {
            PG8_LDB(B0, 0, 0); PG8_LDB(B1, 0, 1); PG8_SCHED; PG8_LDA(At, 0, 0); PG8_STAGE(PG8_SA(1, 1), a1 + hstep, voffA);
            PG8_WAIT_V(8); PG8_WAIT_L(0); PG8_BAR; PG8_MMA(0, 0, At, B0); PG8_MMA(0, 1, At, B1); PG8_BAR; PG8_SCHED;
            PG8_LDA(At, 0, 1); PG8_STAGE(PG8_SB(0, 0), b2, voffB); PG8_STAGE(PG8_SB(0, 1), b2 + hstep, voffB); PG8_STAGE(PG8_SA(0, 0), a2, voffA);
            PG8_WAIT_V(8); PG8_WAIT_L(0); PG8_BAR; PG8_MMA(1, 0, At, B0); PG8_MMA(1, 1, At, B1); PG8_BAR; PG8_SCHED;
            PG8_LDB(B0, 1, 0); PG8_LDB(B1, 1, 1); PG8_SCHED; PG8_LDA(At, 1, 0); PG8_STAGE(PG8_SA(0, 1), a2 + hstep, voffA);
            PG8_WAIT_V(8); PG8_WAIT_L(0); PG8_BAR; PG8_MMA(0, 0, At, B0); PG8_MMA(0, 1, At, B1); PG8_BAR; PG8_SCHED;
            PG8_LDA(At, 1, 1); PG8_STAGE(PG8_SB(1, 0), b3, voffB); PG8_STAGE(PG8_SB(1, 1), b3 + hstep, voffB); PG8_STAGE(PG8_SA(1, 0), a3, voffA);
            PG8_WAIT_V(8); PG8_WAIT_L(0); PG8_BAR; PG8_MMA(1, 0, At, B0); PG8_MMA(1, 1, At, B1); PG8_BAR; PG8_SCHED;
            } else {
            PG8_LDB(B0, 0, 0); PG8_SCHED; PG8_LDA(At, 0, 0); PG8_STAGE(PG8_SA(1, 1), a1 + hstep, voffA);
            PG8_WAIT_L(8); PG8_BAR; PG8_WAIT_L(0); PG8_MMA(0, 0, At, B0); PG8_BAR; PG8_SCHED;
            PG8_LDB(B1, 0, 1); PG8_STAGE(PG8_SB(0, 0), b2, voffB);
            PG8_BAR; PG8_WAIT_L(0); PG8_MMA(0, 1, At, B1); PG8_BAR;
            PG8_LDA(At, 0, 1); PG8_STAGE(PG8_SA(0, 0), a2, voffA);
            PG8_BAR; PG8_WAIT_L(0); PG8_MMA(1, 0, At, B0); PG8_BAR; PG8_SCHED;
            PG8_STAGE(PG8_SB(0, 1), b2 + hstep, voffB);
            PG8_WAIT_V(6); PG8_BAR; PG8_MMA(1, 1, At, B1); PG8_BAR;
            PG8_LDB(B0, 1, 0); PG8_SCHED; PG8_LDA(At, 1, 0); PG8_STAGE(PG8_SA(0, 1), a2 + hstep, voffA);
            PG8_WAIT_L(8); PG8_BAR; PG8_WAIT_L(0); PG8_MMA(0, 0, At, B0); PG8_BAR; PG8_SCHED;
            PG8_LDB(B1, 1, 1); PG8_STAGE(PG8_SB(1, 0), b3, voffB);
            PG8_BAR; PG8_WAIT_L(0); PG8_MMA(0, 1, At, B1); PG8_BAR;
            PG8_LDA(At, 1, 1); PG8_STAGE(PG8_SA(1, 0), a3, voffA);
            PG8_BAR; PG8_WAIT_L(0); PG8_MMA(1, 0, At, B0); PG8_BAR; PG8_SCHED;
            PG8_STAGE(PG8_SB(1, 1), b3 + hstep, voffB);
            PG8_WAIT_V(6); PG8_BAR; PG8_MMA(1, 1, At, B1); PG8_BAR;
            }
        }
        if constexpr (ALIGN_EPI) { if (wr == 0) PG8_BAR; }
        if constexpr (!Epi::AFTER_DRAIN) { E(acc, cur, wr, wc, fr, fq); S.done(cur); }
        if (!has_next) break;
#pragma unroll
        for (int a = 0; a < 2; ++a)
#pragma unroll
            for (int b = 0; b < 2; ++b)
#pragma unroll
                for (int m = 0; m < 4; ++m)
#pragma unroll
                    for (int n = 0; n < 2; ++n) acc[a][b][m][n] = (f32x4){0.f, 0.f, 0.f, 0.f};
        cur = nxt; cA = nA; cB = nB; ++ui;
        if constexpr (ALIGN_EPI) { if (wr == 1) PG8_BAR; }
    }
    PG8_WAIT_V(0);
    if constexpr (!ALIGN_EPI) { if (wr == 0) PG8_BAR; }
    PG8_BAR;
    if constexpr (Epi::AFTER_DRAIN) { E.fused(acc, cur, wr, wc, fr, fq, lds, wid, lane); S.done(cur); }
#undef PG8_SA
#undef PG8_SB
#undef PG8_STAGE
#undef PG8_LDA
#undef PG8_LDB
#undef PG8_MMA
#undef PG8_WAIT_V
#undef PG8_WAIT_L
#undef PG8_BAR
#undef PG8_SCHED
}
}
#define GAS __attribute__((address_space(1)))
#define LAS __attribute__((address_space(3)))
typedef unsigned short bf16;
typedef unsigned v4u __attribute__((ext_vector_type(4)));
typedef float f32x4 __attribute__((ext_vector_type(4)));
typedef short bf16x8 __attribute__((ext_vector_type(8)));
typedef GAS unsigned gu32;
typedef GAS unsigned long long gu64;
#define RLX_AGENT __ATOMIC_RELAXED, __HIP_MEMORY_SCOPE_AGENT
#define LDS_WAIT() asm volatile("s_waitcnt lgkmcnt(0)" ::: "memory")
#define VM_WAIT() asm volatile("s_waitcnt vmcnt(0)" ::: "memory")
__device__ __forceinline__ unsigned long long rt() { return __builtin_amdgcn_s_memrealtime(); }
__device__ __forceinline__ unsigned f2bf(float f) { unsigned u = __builtin_bit_cast(unsigned, f); return (u + 0x7fffu + ((u >> 16) & 1u)) >> 16; }
__device__ __forceinline__ unsigned pk2(float lo, float hi) { return f2bf(lo) | (f2bf(hi) << 16); }

#define XB_TMO      128
#define XB_XCNT(j)  (256  + 64 * (j))
#define XB_XSUB(j)  (1280 + 64 * (j))
#define XB_XGEN(j)  (2304 + 64 * (j))
#define XB_TOP      3328
#define XB_TOPGEN   3392
#define XCD_BAR_WORDS 3456
#define XB_SPIN_CAP (1u << 18)

__device__ __forceinline__ unsigned xb_ld(unsigned* p)              { return __hip_atomic_load(p, __ATOMIC_RELAXED, __HIP_MEMORY_SCOPE_AGENT); }
__device__ __forceinline__ unsigned xb_add(unsigned* p, unsigned v) { return __hip_atomic_fetch_add(p, v, __ATOMIC_RELAXED, __HIP_MEMORY_SCOPE_AGENT); }
__device__ __forceinline__ unsigned xb_xcc_id() { return (unsigned)__builtin_amdgcn_s_getreg((3 << 11) | 20) & 0xFu; }
#define XB_SPIN(cond, bar) do { unsigned _sp = 0; while (cond) { __builtin_amdgcn_s_sleep(1); \
    if ((++_sp & 255u) == 0u) { if (xb_ld(&(bar)[XB_TMO])) break; if (_sp > XB_SPIN_CAP) { atomicAdd(&(bar)[XB_TMO], 1u); break; } } } } while (0)

struct XcdBarrier {
    unsigned* bar; unsigned x;
    volatile LAS unsigned* st;
};

__device__ __forceinline__ XcdBarrier xcd_barrier_post(unsigned* bar, volatile LAS unsigned* st) {
    XcdBarrier b; b.bar = bar; b.x = xb_xcc_id(); b.st = st;
    if (threadIdx.x == 0) (void)xb_add(&bar[XB_XCNT(b.x)], 1u);
    return b;
}
__device__ __forceinline__ void xcd_barrier_complete(unsigned* bar, unsigned x, unsigned& nloc, unsigned& nx) {
    const unsigned G = gridDim.x * gridDim.y * gridDim.z;
    unsigned sum, cnt, mine, sp = 0u;
    for (;;) {
        sum = 0u; cnt = 0u; mine = 0u;
#pragma unroll
        for (unsigned j = 0; j < 16; ++j) { const unsigned c = xb_ld(&bar[XB_XCNT(j)]); sum += c; cnt += (c > 0u) ? 1u : 0u; mine = (j == x) ? c : mine; }
        if (sum == G) break;
        __builtin_amdgcn_s_sleep(1);
        if ((++sp & 255u) == 0u) { if (xb_ld(&bar[XB_TMO])) break; if (sp > XB_SPIN_CAP) { atomicAdd(&bar[XB_TMO], 1u); break; } }
    }
    nloc = mine > 0u ? mine : 1u; nx = cnt > 0u ? cnt : 1u;
}

__device__ __forceinline__ void xcd_barrier(const XcdBarrier& b) {
    asm volatile("s_waitcnt vmcnt(0)" ::: "memory");
    __syncthreads();
    if (threadIdx.x == 0) {
        unsigned* bar = b.bar;
        __builtin_amdgcn_s_waitcnt(0);
        unsigned nloc = b.st[0], nx = b.st[1];
        if (nloc == 0u) { xcd_barrier_complete(bar, b.x, nloc, nx); b.st[0] = nloc; b.st[1] = nx; }
        const unsigned old = xb_add(&bar[XB_XSUB(b.x)], 1u);
        const unsigned gen = old / nloc;
        if (old + 1u == (gen + 1u) * nloc) {
            __builtin_amdgcn_fence(__ATOMIC_RELEASE, "agent");
            asm volatile("s_waitcnt vmcnt(0)" ::: "memory");
            const unsigned og = xb_add(&bar[XB_TOP], 1u);
            const unsigned tg = og / nx;
            if (og + 1u == (tg + 1u) * nx) xb_add(&bar[XB_TOPGEN], 1u);
            else XB_SPIN(xb_ld(&bar[XB_TOPGEN]) == tg, bar);
            __builtin_amdgcn_fence(__ATOMIC_ACQUIRE, "agent");
            xb_add(&bar[XB_XGEN(b.x)], 1u);
            asm volatile("s_waitcnt vmcnt(0)" ::: "memory");
        } else {
            XB_SPIN(xb_ld(&bar[XB_XGEN(b.x)]) == gen, bar);
            __builtin_amdgcn_fence(__ATOMIC_ACQUIRE, "agent");
            asm volatile("s_waitcnt vmcnt(0)" ::: "memory");
        }
    }
    __syncthreads();
}
__device__ __forceinline__ float bf_lo_(unsigned w) { return __builtin_bit_cast(float, w << 16); }
__device__ __forceinline__ float bf_hi_(unsigned w) { return __builtin_bit_cast(float, w & 0xffff0000u); }

namespace att {
typedef short bf16x8 __attribute__((ext_vector_type(8)));
typedef short s16x4 __attribute__((ext_vector_type(4)));
typedef float f32x16 __attribute__((ext_vector_type(16)));
typedef unsigned u32x4 __attribute__((ext_vector_type(4)));
typedef __attribute__((address_space(3))) const char* lds_cptr;
constexpr int AW_ = 512, SLOTB = 8192;
constexpr int L_K = 0, L_V = 2 * SLOTB, L_WS = 4 * SLOTB, L_OST = L_WS + 8 * 256, L_BYTES = L_OST + 8 * 4096;
constexpr float LOG2E = 1.4426950408889634f, C2 = 0.125f * LOG2E;
__device__ __forceinline__ int crow(int r, int hi) { return (r & 3) + 8 * (r >> 2) + 4 * hi; }
__device__ __forceinline__ void glds16(const void* gsrc, unsigned lds_dst) { unsigned keep;
    asm volatile("s_mov_b32 %0, m0\n\ts_mov_b32 m0, %2\n\ts_nop 0\n\tglobal_load_lds_dwordx4 %1, off\n\ts_mov_b32 m0, %0" : "=&s"(keep) : "v"(gsrc), "s"(lds_dst) : "memory"); }
typedef float f32x2_t __attribute__((ext_vector_type(2))); typedef __bf16 bf16x2_t __attribute__((ext_vector_type(2)));
__device__ __forceinline__ unsigned cvtpk_s(float lo, float hi) { f32x2_t v = {lo, hi}; bf16x2_t b = __builtin_convertvector(v, bf16x2_t); return __builtin_bit_cast(unsigned, b); }
__device__ __forceinline__ void qkt(f32x16& p0, f32x16& p1, lds_cptr Kslot, const bf16x8* qr, int r32, int hi) {
    lds_cptr kb = Kslot + hi * 1024 + r32 * 16;
    const f32x16 z = {};
#pragma unroll
    for (int d0 = 0; d0 < 4; ++d0) {
        const bf16x8 b0 = *(const __attribute__((address_space(3))) bf16x8*)(kb + d0 * 2048);
        const bf16x8 b1 = *(const __attribute__((address_space(3))) bf16x8*)(kb + d0 * 2048 + 512);
        if (d0 == 0) { p0 = __builtin_amdgcn_mfma_f32_32x32x16_bf16(b0, qr[0], z, 0, 0, 0); p1 = __builtin_amdgcn_mfma_f32_32x32x16_bf16(b1, qr[0], z, 0, 0, 0); }
        else { p0 = __builtin_amdgcn_mfma_f32_32x32x16_bf16(b0, qr[d0], p0, 0, 0, 0); p1 = __builtin_amdgcn_mfma_f32_32x32x16_bf16(b1, qr[d0], p1, 0, 0, 0); } }
}
__device__ __forceinline__ void pv(f32x16* o, int vb, bf16x8 pa0, bf16x8 pa1, bf16x8 pa2, bf16x8 pa3) {
#pragma unroll
    for (int d0 = 0; d0 < 2; ++d0) { s16x4 lo[4], hi[4];
#pragma unroll
        for (int ks = 0; ks < 4; ++ks) {
            asm volatile("ds_read_b64_tr_b16 %0,%1 offset:%c2" : "=&v"(lo[ks]) : "v"(vb), "i"(d0 * 4096 + ks * 1024) : "memory");
            asm volatile("ds_read_b64_tr_b16 %0,%1 offset:%c2" : "=&v"(hi[ks]) : "v"(vb), "i"(d0 * 4096 + ks * 1024 + 512) : "memory"); }
        asm volatile("s_waitcnt lgkmcnt(0)" ::: "memory"); __builtin_amdgcn_sched_barrier(0);
#define ATT_PK(k) (bf16x8){lo[k][0], lo[k][1], lo[k][2], lo[k][3], hi[k][0], hi[k][1], hi[k][2], hi[k][3]}
        o[d0] = __builtin_amdgcn_mfma_f32_32x32x16_bf16(pa0, ATT_PK(0), o[d0], 0, 0, 0);
        o[d0] = __builtin_amdgcn_mfma_f32_32x32x16_bf16(pa1, ATT_PK(1), o[d0], 0, 0, 0);
        o[d0] = __builtin_amdgcn_mfma_f32_32x32x16_bf16(pa2, ATT_PK(2), o[d0], 0, 0, 0);
        o[d0] = __builtin_amdgcn_mfma_f32_32x32x16_bf16(pa3, ATT_PK(3), o[d0], 0, 0, 0);
#undef ATT_PK
    }
}
__device__ __forceinline__ float swapmax(float m) { auto rr = __builtin_amdgcn_permlane32_swap(__float_as_uint(m), __float_as_uint(m), false, false); return fmaxf(__uint_as_float(rr[0]), __uint_as_float(rr[1])); }
__device__ __forceinline__ float swapadd(float m) { auto rr = __builtin_amdgcn_permlane32_swap(__float_as_uint(m), __float_as_uint(m), false, false); return __uint_as_float(rr[0]) + __uint_as_float(rr[1]); }

__device__ __forceinline__ void moba_unit(int tid, int b, int h, int qblk, unsigned short* Qb, const unsigned short* Kb, const unsigned short* Vb, const unsigned short* AZb, const float* KM, lds_cptr shm3) {
    const int lane = tid & 63, r32 = lane & 31, hi = lane >> 5; const int wid = __builtin_amdgcn_readfirstlane(tid >> 6);
    const long rowbase = (long)b * 2048; const int q0 = qblk * 256 + wid * 32, qpos = q0 + r32;
    const unsigned short* Qw = Qb + (rowbase + q0) * AW_ + h * 64;
    const unsigned short* Kh = Kb + rowbase * AW_ + h * 64; const unsigned short* Vh = Vb + rowbase * AW_ + h * 64;
    const unsigned lds0 = (unsigned)(size_t)shm3;
    __attribute__((address_space(3))) float* wsf = (__attribute__((address_space(3))) float*)(shm3 + L_WS) + wid * 64;
    const unsigned short* ksrc = Kh + (long)lane * AW_ + wid * 8;
    const unsigned short* vsrc = Vh + (long)(16 * (wid & 3) + (lane >> 2)) * AW_ + (wid >> 2) * 32 + (lane & 3) * 8;
    const unsigned kdst = lds0 + L_K + wid * 1024, vdst = lds0 + L_V + wid * 1024;
    const int vb0 = (int)(lds0 + L_V) + ((lane >> 4) & 1) * 32 + (lane & 3) * 8 + (4 * hi + ((lane & 15) >> 2)) * 64;
    const int NT = 4 * (qblk + 1);
#define ATT_BASE(s) ((s) < 4 ? qblk * 256 + 64 * (s) : (qblk - 1 - (((s) - 4) >> 2)) * 256 + 64 * (((s) - 4) & 3))
    { const int kb0 = ATT_BASE(0); glds16(ksrc + (long)kb0 * AW_, (unsigned)__builtin_amdgcn_readfirstlane(kdst)); glds16(vsrc + (long)kb0 * AW_, (unsigned)__builtin_amdgcn_readfirstlane(vdst)); }
    bf16x8 qr[4];
#pragma unroll
    for (int d0 = 0; d0 < 4; ++d0) qr[d0] = *reinterpret_cast<const bf16x8*>(&Qw[(long)r32 * AW_ + d0 * 16 + hi * 8]);
    unsigned selmask = 0u;
    if (qblk > 0) {
        float g[8];
#pragma unroll
        for (int j = 0; j < 8; ++j) { g[j] = 0.f;
            if (j < qblk) { const float* km = KM + ((long)(b * 8 + j)) * AW_ + h * 64 + hi * 8;
#pragma unroll
                for (int d0 = 0; d0 < 4; ++d0) { const f32x4 a0 = *(const f32x4*)(km + d0 * 16), a1 = *(const f32x4*)(km + d0 * 16 + 4);
#pragma unroll
                    for (int e = 0; e < 4; ++e) { g[j] += __builtin_bit_cast(float, (unsigned)(unsigned short)qr[d0][e] << 16) * a0[e]; g[j] += __builtin_bit_cast(float, (unsigned)(unsigned short)qr[d0][4 + e] << 16) * a1[e]; } }
                g[j] = swapadd(g[j]); }
            else g[j] = -1e30f; }
#pragma unroll
        for (int j = 0; j < 8; ++j) { int rank = 0;
#pragma unroll
            for (int i = 0; i < 8; ++i) rank += (g[i] > g[j] || (g[i] == g[j] && i < j)) ? 1 : 0;
            if (rank < 3 && j < qblk) selmask |= 1u << j; }
    }
    const float cb = exp2f(-(float)(h + 1)) * LOG2E;
    float mrun = -1e30f, l_reg = 0.f; f32x16 o[2]; o[0] = f32x16{}; o[1] = f32x16{};
    for (int s = 0; s < NT; ++s) {
        asm volatile("s_waitcnt vmcnt(0) lgkmcnt(0)\n\ts_barrier" ::: "memory");
        if (s + 1 < NT) { const int kb1 = ATT_BASE(s + 1); const unsigned so = ((s + 1) & 1) * SLOTB;
            glds16(ksrc + (long)kb1 * AW_, (unsigned)__builtin_amdgcn_readfirstlane(kdst + so)); glds16(vsrc + (long)kb1 * AW_, (unsigned)__builtin_amdgcn_readfirstlane(vdst + so)); }
        const int base = ATT_BASE(s); const bool own = s < 4; const int j = own ? qblk : (qblk - 1 - ((s - 4) >> 2));
        const bool mine = own ? true : (((selmask >> j) & 1u) != 0u);
        const bool skip = own ? (base > q0 + 31) : !__any(mine);
        if (skip) continue;
        const int slot = (s & 1) * SLOTB;
        f32x16 p0, p1;
        qkt(p0, p1, shm3 + L_K + slot, qr, r32, hi);
        const float fb = cb * (float)(base + 4 * hi - qpos);
        float rm = -1e30f;
#pragma unroll
        for (int r = 0; r < 16; ++r) { const int ko = (r & 3) + 8 * (r >> 2); const int kv = base + 4 * hi + ko;
            float s0 = p0[r] + (fb + cb * (float)ko), s1 = p1[r] + (fb + cb * (float)(ko + 32));
            if (own) { if (kv > qpos) s0 = -1e30f; if (kv + 32 > qpos) s1 = -1e30f; } else if (!mine) { s0 = -1e30f; s1 = -1e30f; }
            p0[r] = s0; p1[r] = s1; rm = fmaxf(rm, fmaxf(s0, s1)); }
        rm = swapmax(rm);
        const float mnew = fmaxf(mrun, rm), alpha = exp2f(mrun - mnew); mrun = mnew;
        float sacc = 0.f;
#pragma unroll
        for (int r = 0; r < 16; ++r) { p0[r] = exp2f(p0[r] - mnew); p1[r] = exp2f(p1[r] - mnew); sacc += p0[r] + p1[r]; }
        l_reg = l_reg * alpha + sacc;
        if (hi == 0) wsf[r32] = alpha;
        asm volatile("s_waitcnt lgkmcnt(0)" ::: "memory");
#pragma unroll
        for (int r = 0; r < 16; ++r) { const float f = wsf[crow(r, hi)]; o[0][r] *= f; o[1][r] *= f; }
        u32x4 pw0, pw1, pw2, pw3;
        pw0 = (u32x4){cvtpk_s(p0[0], p0[1]), cvtpk_s(p0[2], p0[3]), cvtpk_s(p0[4], p0[5]), cvtpk_s(p0[6], p0[7])};
        pw1 = (u32x4){cvtpk_s(p0[8], p0[9]), cvtpk_s(p0[10], p0[11]), cvtpk_s(p0[12], p0[13]), cvtpk_s(p0[14], p0[15])};
        pw2 = (u32x4){cvtpk_s(p1[0], p1[1]), cvtpk_s(p1[2], p1[3]), cvtpk_s(p1[4], p1[5]), cvtpk_s(p1[6], p1[7])};
        pw3 = (u32x4){cvtpk_s(p1[8], p1[9]), cvtpk_s(p1[10], p1[11]), cvtpk_s(p1[12], p1[13]), cvtpk_s(p1[14], p1[15])};
        __builtin_amdgcn_sched_barrier(0);
        pv(o, vb0 + slot, __builtin_bit_cast(bf16x8, pw0), __builtin_bit_cast(bf16x8, pw1), __builtin_bit_cast(bf16x8, pw2), __builtin_bit_cast(bf16x8, pw3));
    }
#undef ATT_BASE
    l_reg = swapadd(l_reg);
    if (hi == 0) wsf[32 + r32] = l_reg;
    asm volatile("s_waitcnt lgkmcnt(0)" ::: "memory");
    float rli[16];
#pragma unroll
    for (int r = 0; r < 16; ++r) rli[r] = 1.0f / wsf[32 + crow(r, hi)];
    {
        __attribute__((address_space(3))) unsigned short* stg = (__attribute__((address_space(3))) unsigned short*)(shm3 + L_OST) + wid * 2048;
#pragma unroll
        for (int r = 0; r < 16; ++r) { const int orow = crow(r, hi);
#pragma unroll
            for (int d0 = 0; d0 < 2; ++d0) stg[orow * 64 + d0 * 32 + r32] = (unsigned short)(cvtpk_s(o[d0][r] * rli[r], 0.f) & 0xffffu); }
        asm volatile("s_waitcnt lgkmcnt(0)" ::: "memory");
        const unsigned short* AZw = AZb + (rowbase + q0) * AW_ + h * 64; unsigned short* Ow = Qb + (rowbase + q0) * AW_ + h * 64;
#pragma unroll
        for (int i = 0; i < 4; ++i) { const int row = i * 8 + (lane >> 3), ch = lane & 7;
            const u32x4 v = *(const __attribute__((address_space(3))) u32x4*)(stg + row * 64 + ch * 8); const u32x4 z = *(const u32x4*)(AZw + (long)row * AW_ + ch * 8);
            u32x4 w;
#pragma unroll
            for (int e = 0; e < 4; ++e) { const float z0 = __builtin_bit_cast(float, z[e] << 16), z1 = __builtin_bit_cast(float, z[e] & 0xffff0000u);
                const float v0 = __builtin_bit_cast(float, v[e] << 16), v1 = __builtin_bit_cast(float, v[e] & 0xffff0000u);
                w[e] = cvtpk_s(v0 * (z0 / (1.0f + __expf(-z0))), v1 * (z1 / (1.0f + __expf(-z1)))); }
            *(u32x4*)(Ow + (long)row * AW_ + ch * 8) = w; }
    }
    asm volatile("s_waitcnt lgkmcnt(0)" ::: "memory");
}
__device__ __forceinline__ void moba_phase(int tid, int vcu, int G, unsigned short* Qb, const unsigned short* Kb, const unsigned short* Vb, const unsigned short* AZb, const float* KM, lds_cptr shm3) {
    for (int u = vcu; u < 512; u += G) {
        const int v = u & 255, bh = v >> 2, s = v & 3, qblk = (u < 256) ? s : 7 - s;
        moba_unit(tid, bh >> 3, bh & 7, qblk, Qb, Kb, Vb, AZb, KM, shm3);
    }
    asm volatile("s_waitcnt vmcnt(0) lgkmcnt(0)\n\ts_barrier" ::: "memory");
}
}

constexpr int NWAVES = 8;
constexpr int NB = 8, SEQ = 2048, DM = 1024, M = NB * SEQ;
constexpr int NH = 8, HD = 64, AW = 512;
constexpr int RWS = 1664;
constexpr int DIN = 6272;
constexpr int NA = 4352, NBW = 2048;
constexpr int BLK = 256, NBLK = SEQ / BLK, TOPK = 3;
constexpr float RMS_EPS = 1e-6f, GN_EPS = 64e-5f;
#ifndef MK_SINGLE
#define MK_SINGLE 0
#endif
constexpr int NPH_LAYER = 9, NPHASE = 1 + 2 * NPH_LAYER;

constexpr size_t MiB = 1u << 20;
constexpr size_t WS_CTL = 0, CTL_ZERO_BYTES = 64 * 1024;
constexpr size_t WS_RINV = 1 * MiB, WS_KMEAN = 1 * MiB + 256 * 1024;
constexpr size_t WS_WA = 2 * MiB, WA_BYTES = (size_t)NA * DM * 2;
constexpr size_t WS_WB = 19 * MiB, WB_BYTES = (size_t)NBW * DM * 2;
constexpr size_t WS_WUP = 27 * MiB, WUP_BYTES = 2 * MiB;
constexpr size_t WS_WOUT = 31 * MiB, WOUT_BYTES = 2 * MiB;
constexpr size_t WS_XB = 35 * MiB, WS_VFIRST = 67 * MiB, WS_U = 83 * MiB;
constexpr size_t WS_Q = 115 * MiB, WS_K = 131 * MiB, WS_V = 147 * MiB, WS_AZ = 163 * MiB, WS_RZ = 179 * MiB, WS_RW = 195 * MiB, WS_VD = 247 * MiB;
static_assert(WS_K - WS_Q == 16 * MiB && WS_V - WS_Q == 32 * MiB && WS_AZ - WS_Q == 48 * MiB && WS_RZ - WS_Q == 64 * MiB && WS_RW - WS_Q == 80 * MiB && WS_VD - WS_RW == 52 * MiB, "EpiProjA routing offsets");
constexpr size_t WS_GA = WS_K, WS_GR = WS_RW, WS_Y = WS_Q, WS_END = 248 * MiB;
constexpr int CW_BAR = 1024;

constexpr int RING_OFF = 0, RING_BYTES = 131072;
constexpr int LDSCTL_OFF = RING_BYTES, MISC_OFF = LDSCTL_OFF + 320;
constexpr int LDS_BYTES = 147456;

struct Frame {
    LAS unsigned char* lds;
    volatile LAS unsigned* MISC;
    gu32* ctl;
    int tid, lane, wave, vcu, G;
};
__device__ __forceinline__ float wave_sum(float v) {
#pragma unroll
    for (int o = 1; o < 64; o <<= 1) v += __shfl_xor(v, o);
    return v;
}
__device__ __forceinline__ float wave_max(float v) {
#pragma unroll
    for (int o = 1; o < 64; o <<= 1) v = fmaxf(v, __shfl_xor(v, o));
    return v;
}
__device__ __forceinline__ float bf2f(bf16 v) { return __builtin_bit_cast(float, (unsigned)v << 16); }
__device__ __forceinline__ float rl(float v, int l) { return __builtin_bit_cast(float, __builtin_amdgcn_readlane(__builtin_bit_cast(int, v), l)); }

struct Args { const float* in[21]; float* out; unsigned char* ws; int ph_lo, ph_hi; };
__device__ __forceinline__ const float* inp(const Args& a, int i) { asm volatile("" : "+s"(i)); return a.in[i]; }

__device__ __forceinline__ void p0_transpose_item(const float* W, int ldw, int c0, int k0, const float* g, bf16* WT, int ldk, int n_row0, LAS float* scr, int lane) {
#pragma unroll 8
    for (int i = 0; i < 32; ++i) { const int kk = 2 * i + (lane >> 5); const float s = g ? g[k0 + kk] : 1.0f; scr[kk * 33 + (lane & 31)] = W[(size_t)(k0 + kk) * ldw + c0 + (lane & 31)] * s; }
    LDS_WAIT(); asm volatile("" ::: "memory");
    const int c = lane & 7;
#pragma unroll
    for (int j = 0; j < 4; ++j) { const int n = (lane >> 3) + 8 * j; const LAS float* s = scr + (8 * c) * 33 + n;
        v4u o; o.x = pk2(s[0 * 33], s[1 * 33]); o.y = pk2(s[2 * 33], s[3 * 33]); o.z = pk2(s[4 * 33], s[5 * 33]); o.w = pk2(s[6 * 33], s[7 * 33]);
        *(GAS v4u*)(WT + (size_t)(n_row0 + n) * ldk + k0 + 8 * c) = o; }
    LDS_WAIT(); asm volatile("" ::: "memory");
}
__device__ __forceinline__ void row_to_bf16_rinv(const float* xrow, bf16* orow, float* rinv, int lane) {
    const GAS f32x4* xr = (const GAS f32x4*)xrow + lane;
    f32x4 v[4]; float s = 0.f;
#pragma unroll
    for (int j = 0; j < 4; ++j) { v[j] = xr[64 * j]; s += (v[j].x * v[j].x + v[j].y * v[j].y) + (v[j].z * v[j].z + v[j].w * v[j].w); }
    s = wave_sum(s);
    GAS unsigned long long* o8 = (GAS unsigned long long*)orow + lane;
#pragma unroll
    for (int j = 0; j < 4; ++j) o8[64 * j] = (unsigned long long)pk2(v[j].x, v[j].y) | ((unsigned long long)pk2(v[j].z, v[j].w) << 32);
    if (lane == 0) *rinv = 1.0f / sqrtf(s * (1.0f / DM) + RMS_EPS);
}

__device__ __forceinline__ void p0_prologue(Frame& F, const Args& a) {
    LAS float* scr = (LAS float*)(F.lds + RING_OFF + F.wave * 16384);
    const int gw = F.vcu * NWAVES + F.wave, NGW = F.G * NWAVES;
    unsigned char* ws = a.ws;
    constexpr int I_A = 16 * (4224 / 32), I_V = 16, I_B = 16 * (NBW / 32), I_U = 8 * (DM / 32), I_O = 16 * (DM / 32);
    constexpr int I_LAYER = I_A + I_V + I_B + 2 * I_U + I_O;
    for (int it = gw; it < 2 * I_LAYER; it += NGW) {
        const int l = it / I_LAYER; int r = it % I_LAYER;
        const float* w_in = inp(a, 3) + (size_t)l * DM * DIN; const float* g = inp(a, 1) + l * DM;
        bf16* WA = (bf16*)(ws + WS_WA + l * WA_BYTES); bf16* WB = (bf16*)(ws + WS_WB + l * WB_BYTES);
        bf16* WU = (bf16*)(ws + WS_WUP + l * WUP_BYTES); bf16* WO = (bf16*)(ws + WS_WOUT + l * WOUT_BYTES);
        if (r < I_A) { const int kb = r / (4224 / 32), nb = r % (4224 / 32); p0_transpose_item(w_in, DIN, 32 * nb, 64 * kb, g, WA, DM, 32 * nb, scr, F.lane); continue; } r -= I_A;
        if (r < I_V) { if (l == 1) p0_transpose_item(inp(a, 14), 32, 0, 64 * r, g, WA, DM, 4224, scr, F.lane); continue; } r -= I_V;
        if (r < I_B) { const int kb = r / (NBW / 32), nb = r % (NBW / 32); p0_transpose_item(w_in, DIN, 4224 + 32 * nb, 64 * kb, g, WB, DM, 32 * nb, scr, F.lane); continue; } r -= I_B;
        if (r < I_U) { const int kb = r / (DM / 32), nb = r % (DM / 32); p0_transpose_item(inp(a, 18) + (size_t)l * AW * DM, DM, 32 * nb, 64 * kb, nullptr, WU, AW, 32 * nb, scr, F.lane); continue; } r -= I_U;
        if (r < I_U) { const int kb = r / (DM / 32), nb = r % (DM / 32); p0_transpose_item(inp(a, 19) + (size_t)l * AW * DM, DM, 32 * nb, 64 * kb, nullptr, WU + (size_t)DM * AW, AW, 32 * nb, scr, F.lane); continue; } r -= I_U;
        { const int kb = r / (DM / 32), nb = r % (DM / 32); p0_transpose_item(inp(a, 20) + (size_t)l * DM * DM, DM, 32 * nb, 64 * kb, nullptr, WO, DM, 32 * nb, scr, F.lane); }
    }
    {
        const int gt = F.vcu * (NWAVES * 64) + F.tid, NT = F.G * NWAVES * 64;
        const int n0 = 128 * DM * 2 / 16, n1 = 96 * DM * 2 / 16;
        GAS v4u* z0 = (GAS v4u*)(ws + WS_WA + (size_t)4224 * DM * 2); GAS v4u* z1 = (GAS v4u*)(ws + WS_WA + WA_BYTES + (size_t)4256 * DM * 2);
        for (int i = gt; i < n0; i += NT) z0[i] = (v4u){0u, 0u, 0u, 0u};
        for (int i = gt; i < n1; i += NT) z1[i] = (v4u){0u, 0u, 0u, 0u};
    }
    const float* x = inp(a, 0); bf16* XB = (bf16*)(ws + WS_XB); float* rinv = (float*)(ws + WS_RINV);
    for (int m = gw; m < M; m += NGW) row_to_bf16_rinv(x + (size_t)m * DM, XB + (size_t)m * DM, rinv + m, F.lane);
}

__device__ __forceinline__ void kmean_phase(Frame& F, const Args& a) {
    const bf16* K = (const bf16*)(a.ws + WS_K); float* KM = (float*)(a.ws + WS_KMEAN);
    for (int u = F.vcu; u < NB * NBLK; u += F.G) {
        const bf16* kp = K + (size_t)u * BLK * AW + F.tid; float s = 0.f;
        for (int t = 0; t < BLK; ++t) s += bf2f(kp[(size_t)t * AW]);
        KM[(size_t)u * AW + F.tid] = s * (1.0f / BLK);
    }
}

__device__ __forceinline__ void scan_naive_phase(Frame& F, const Args& a, int l) {
    if (F.wave != 0) return;
    const int lane = F.lane;
    const bf16* RW = (const bf16*)(a.ws + WS_RW); bf16* RZ = (bf16*)(a.ws + WS_RZ); const bf16* VD = (const bf16*)(a.ws + WS_VD); bf16* VF = (bf16*)(a.ws + WS_VFIRST);
    LAS float* wup = (LAS float*)(F.lds + RING_OFF);
    LAS float* aup = wup + 4096;
    LAS float* vup = aup + 4096;
    for (int u = F.vcu; u < NB * NH; u += F.G) {
        const int b = u >> 3, h = u & 7, col = h * HD + lane;
        for (int j = 0; j < 64; ++j) { wup[j * 64 + lane] = inp(a, 6)[((size_t)l * 64 + j) * AW + col]; aup[j * 64 + lane] = inp(a, 8)[((size_t)l * 64 + j) * AW + col]; }
        if (l == 1) for (int j = 0; j < 32; ++j) vup[j * 64 + lane] = inp(a, 16)[(size_t)j * AW + col];
        LDS_WAIT();
        const float* mu = inp(a, 4) + (size_t)l * RWS;
        const float mu_r = mu[col], mu_k = mu[512 + col], mu_v = mu[1024 + col], mu_wd = mu[1536 + lane], mu_ad = mu[1600 + lane];
        const float w0 = inp(a, 5)[l * AW + col], a0 = inp(a, 7)[l * AW + col], k_k = inp(a, 9)[l * AW + col], k_a = inp(a, 10)[l * AW + col], r_k = inp(a, 11)[l * AW + col];
        const float ln_g = inp(a, 12)[l * AW + col], ln_b = inp(a, 13)[l * AW + col];
        const float vmu = (l == 1) ? inp(a, 15)[lane & 31] : 0.f, vm0 = (l == 1) ? inp(a, 17)[col] : 0.f;
        float S[64];
#pragma unroll
        for (int k = 0; k < 64; ++k) S[k] = 0.f;
        float p_r = 0.f, p_k = 0.f, p_v = 0.f, p_wd = 0.f, p_ad = 0.f, p_vd = 0.f;
        for (int t = 0; t < SEQ; ++t) {
            const size_t row = (size_t)b * SEQ + t; const bf16* rw = RW + row * RWS;
            const float c_r = bf2f(rw[col]), c_k = bf2f(rw[512 + col]), c_v = bf2f(rw[1024 + col]), c_wd = bf2f(rw[1536 + lane]), c_ad = bf2f(rw[1600 + lane]);
            const float r = c_r + (p_r - c_r) * mu_r, ks = c_k + (p_k - c_k) * mu_k, vs = c_v + (p_v - c_v) * mu_v, wd = c_wd + (p_wd - c_wd) * mu_wd, ad = c_ad + (p_ad - c_ad) * mu_ad;
            p_r = c_r; p_k = c_k; p_v = c_v; p_wd = c_wd; p_ad = c_ad;
            const float twd = tanhf(wd);
            float xw = w0, xa = a0;
#pragma unroll 16
            for (int j = 0; j < 64; ++j) { xw += rl(twd, j) * wup[j * 64 + lane]; xa += rl(ad, j) * aup[j * 64 + lane]; }
            const float z = -xw, sp = fmaxf(z, 0.f) + log1pf(__expf(-fabsf(z)));
            const float wlog = -sp - 0.5f, w = __expf(-__expf(wlog));
            const float av = 1.0f / (1.0f + __expf(-xa));
            float vr = vs;
            if (l == 0) VF[row * AW + col] = (bf16)f2bf(vs);
            else {
                const float c_vd = bf2f(VD[row * 32 + (lane & 31)]); const float vd = c_vd + (p_vd - c_vd) * vmu; p_vd = c_vd;
                float xv = vm0;
#pragma unroll 16
                for (int j = 0; j < 32; ++j) xv += rl(vd, j) * vup[j * 64 + lane];
                const float vf = bf2f(VF[row * AW + col]);
                vr = vs + (vf - vs) * (1.0f / (1.0f + __expf(-xv)));
            }
            const float kkv = ks * k_k; const float nrm = sqrtf(wave_sum(kkv * kkv)); const float kkn = kkv / fmaxf(nrm, 1e-12f);
            const float kmod = ks * (1.0f + (av - 1.0f) * k_a), bb = kkn * av;
            const float cb = wave_sum(r * kmod * r_k);
            float sa = 0.f;
#pragma unroll
            for (int k = 0; k < 64; ++k) sa -= S[k] * rl(kkn, k);
            float o = 0.f;
#pragma unroll
            for (int k = 0; k < 64; ++k) { S[k] = S[k] * rl(w, k) + sa * rl(bb, k) + vr * rl(kmod, k); o += S[k] * rl(r, k); }
            const float mean = wave_sum(o) * (1.0f / 64.0f), d = o - mean, var = wave_sum(d * d) * (1.0f / 64.0f);
            const float on = d * (1.0f / sqrtf(var + GN_EPS)) * ln_g + ln_b;
            const float rz = bf2f(RZ[row * AW + col]);
            RZ[row * AW + col] = (bf16)f2bf((on + cb * vr) * (rz / (1.0f + __expf(-rz))));
        }
    }
}

__device__ __forceinline__ void norm_phase(Frame& F, const Args& a, int l) {
    const int gw = F.vcu * NWAVES + F.wave, NGW = F.G * NWAVES, lane = F.lane;
    const float* Y = (const float*)(a.ws + WS_Y); const float* xold = (l == 0) ? inp(a, 0) : a.out; const float* gp = inp(a, 2) + l * DM;
    bf16* XB = (bf16*)(a.ws + WS_XB); float* rinv = (float*)(a.ws + WS_RINV);
    f32x4 gv[4];
#pragma unroll
    for (int j = 0; j < 4; ++j) gv[j] = ((const f32x4*)gp)[lane + 64 * j];
    for (int m = gw; m < M; m += NGW) {
        const f32x4* yr = (const f32x4*)(Y + (size_t)m * DM) + lane; const f32x4* xr = (const f32x4*)(xold + (size_t)m * DM) + lane;
        f32x4 y[4], x[4]; float s = 0.f;
#pragma unroll
        for (int j = 0; j < 4; ++j) { y[j] = yr[64 * j]; x[j] = xr[64 * j]; s += (y[j].x * y[j].x + y[j].y * y[j].y) + (y[j].z * y[j].z + y[j].w * y[j].w); }
        const float ry = 1.0f / sqrtf(wave_sum(s) * (1.0f / DM) + RMS_EPS); float s2 = 0.f;
#pragma unroll
        for (int j = 0; j < 4; ++j) { x[j] = x[j] + y[j] * ry * gv[j]; s2 += (x[j].x * x[j].x + x[j].y * x[j].y) + (x[j].z * x[j].z + x[j].w * x[j].w); }
        f32x4* orow = (f32x4*)(a.out + (size_t)m * DM) + lane;
#pragma unroll
        for (int j = 0; j < 4; ++j) orow[64 * j] = x[j];
        if (l == 0) {
            s2 = wave_sum(s2);
            GAS unsigned long long* o8 = (GAS unsigned long long*)(XB + (size_t)m * DM) + lane;
#pragma unroll
            for (int j = 0; j < 4; ++j) o8[64 * j] = (unsigned long long)pk2(x[j].x, x[j].y) | ((unsigned long long)pk2(x[j].z, x[j].w) << 32);
            if (lane == 0) rinv[m] = 1.0f / sqrtf(s2 * (1.0f / DM) + RMS_EPS);
        }
    }
}

__global__ void __launch_bounds__(NWAVES * 64, 2) mk_fwd(Args args) {
    extern __shared__ __attribute__((aligned(16))) unsigned char lds[];
    Frame F;
    F.lds = (LAS unsigned char*)lds;
    F.MISC = (volatile LAS unsigned*)(F.lds + MISC_OFF);
    F.tid = threadIdx.x; F.lane = F.tid & 63; F.wave = __builtin_amdgcn_readfirstlane(F.tid >> 6);
    F.G = gridDim.x; { const int bx = blockIdx.x; F.vcu = (F.G % 8 == 0) ? (bx % 8) * (F.G / 8) + bx / 8 : bx; }
    const int vcu0 = F.vcu;
    unsigned char* ws = args.ws;
    F.ctl = (gu32*)(ws + WS_CTL);
    for (int u = F.tid; u < (LDS_BYTES - LDSCTL_OFF) / 4; u += NWAVES * 64) ((LAS unsigned*)(F.lds + LDSCTL_OFF))[u] = 0u;
    __syncthreads();
    XcdBarrier bar; bar.bar = (unsigned*)(F.ctl + CW_BAR); bar.x = 0; bar.st = nullptr;
    const bool use_bar = (args.ph_hi - args.ph_lo) > 1;
    if (use_bar) bar = xcd_barrier_post((unsigned*)(F.ctl + CW_BAR), F.MISC + 8);

    for (int ph_ = args.ph_lo; ph_ < args.ph_hi; ++ph_) {
        int ph = ph_; asm volatile("" : "+s"(ph));
        { int t_ = threadIdx.x; asm volatile("" : "+v"(t_)); F.tid = t_; F.lane = t_ & 63; F.wave = __builtin_amdgcn_readfirstlane(t_ >> 6); int g_ = gridDim.x, v_ = vcu0; asm volatile("" : "+s"(g_), "+s"(v_)); F.G = g_; F.vcu = v_; }
        if (ph == 0) p0_prologue(F, args);
        else {
            const int l = (ph - 1) / NPH_LAYER, sp = (ph - 1) % NPH_LAYER;
            const float* rinv = (const float*)(ws + WS_RINV);
            pg8::bf16_t* XB = (pg8::bf16_t*)(ws + WS_XB);
            if (sp == 0) {
                pg8::Gemm g{XB, (const pg8::bf16_t*)(ws + WS_WA + l * WA_BYTES), M, NA, DM}; pg8::StaticOrder S; S.init(M, NA, F.G, (int)blockIdx.x);
                pg8::EpiProjA E{rinv, (pg8::bf16_t*)(ws + WS_Q)};
                pg8::gemm_phase<pg8::EpiProjA, pg8::StaticOrder, true, true>(F.lds + RING_OFF, g, S, E);
            } else if (sp == 1) kmean_phase(F, args);
            else if (sp == 2) att::moba_phase(F.tid, F.vcu, F.G, (unsigned short*)(ws + WS_Q), (const unsigned short*)(ws + WS_K), (const unsigned short*)(ws + WS_V), (const unsigned short*)(ws + WS_AZ), (const float*)(ws + WS_KMEAN), (att::lds_cptr)(F.lds + RING_OFF));
            else if (sp == 3) scan_naive_phase(F, args, l);
            else if (sp == 4) {
                pg8::Gemm g{XB, (const pg8::bf16_t*)(ws + WS_WB + l * WB_BYTES), M, NBW, DM}; pg8::StaticOrder S; S.init(M, NBW, F.G, (int)blockIdx.x);
                pg8::EpiProjB E{rinv, (pg8::bf16_t*)(ws + WS_GA), (pg8::bf16_t*)(ws + WS_GR)};
                pg8::gemm_phase<pg8::EpiProjB, pg8::StaticOrder, true, true>(F.lds + RING_OFF, g, S, E);
            } else if (sp == 5) {
                pg8::Gemm g{(const pg8::bf16_t*)(ws + WS_Q), (const pg8::bf16_t*)(ws + WS_WUP + l * WUP_BYTES), M, DM, AW}; pg8::StaticOrder S; S.init(M, DM, F.G, (int)blockIdx.x);
                pg8::EpiUp<false> E{(const pg8::bf16_t*)(ws + WS_GA), (pg8::bf16_t*)(ws + WS_U)};
                pg8::gemm_phase<pg8::EpiUp<false>, pg8::StaticOrder, true, true>(F.lds + RING_OFF, g, S, E);
            } else if (sp == 6) {
                pg8::Gemm g{(const pg8::bf16_t*)(ws + WS_RZ), (const pg8::bf16_t*)(ws + WS_WUP + l * WUP_BYTES + (size_t)DM * AW * 2), M, DM, AW}; pg8::StaticOrder S; S.init(M, DM, F.G, (int)blockIdx.x);
                pg8::EpiUp<true> E{(const pg8::bf16_t*)(ws + WS_GR), (pg8::bf16_t*)(ws + WS_U)};
                pg8::gemm_phase<pg8::EpiUp<true>, pg8::StaticOrder, true, true>(F.lds + RING_OFF, g, S, E);
            } else if (sp == 7) {
                pg8::Gemm g{(const pg8::bf16_t*)(ws + WS_U), (const pg8::bf16_t*)(ws + WS_WOUT + l * WOUT_BYTES), M, DM, DM}; pg8::StaticOrder S; S.init(M, DM, F.G, (int)blockIdx.x);
                pg8::EpiF32 E{(float*)(ws + WS_Y), DM};
                pg8::gemm_phase<pg8::EpiF32, pg8::StaticOrder, true, true>(F.lds + RING_OFF, g, S, E);
            } else norm_phase(F, args, l);
        }
        if (ph_ + 1 < args.ph_hi) xcd_barrier(bar);
    }
}

extern "C" void kernel_launch(void* const* d_in, const int* in_sizes, int n_in, void* d_out, int out_size, void* d_ws, size_t ws_size, hipStream_t stream) {
    static int grid = 0;
    if (grid == 0) {
        if (n_in != 21 || in_sizes[0] != M * DM || out_size != M * DM || ws_size < WS_END) { fprintf(stderr, "kernel_launch: unexpected shapes (n_in %d, in0 %d, out %d, ws %zu); nothing launched\n", n_in, n_in > 0 ? in_sizes[0] : -1, out_size, ws_size); grid = -1; return; }
        int dev = 0, cus = 0;
        if (hipGetDevice(&dev) != hipSuccess || hipDeviceGetAttribute(&cus, hipDeviceAttributeMultiprocessorCount, dev) != hipSuccess) { grid = -1; return; }
        if (hipFuncSetAttribute((const void*)mk_fwd, hipFuncAttributeMaxDynamicSharedMemorySize, LDS_BYTES) != hipSuccess) { fprintf(stderr, "kernel_launch: hipFuncSetAttribute failed\n"); grid = -1; return; }
        (void)hipGetLastError();
        grid = cus;
    }
    if (grid < 0) return;
    if (hipMemsetAsync((char*)d_ws + WS_CTL, 0, CTL_ZERO_BYTES, stream) != hipSuccess) return;
    Args a{};
    for (int i = 0; i < 21; ++i) a.in[i] = (const float*)d_in[i];
    a.out = (float*)d_out; a.ws = (unsigned char*)d_ws;
#if MK_SINGLE
    a.ph_lo = 0; a.ph_hi = NPHASE;
    hipLaunchKernelGGL(mk_fwd, dim3(grid), dim3(NWAVES * 64), LDS_BYTES, stream, a);
#else
    for (int p = 0; p < NPHASE; ++p) { a.ph_lo = p; a.ph_hi = p + 1; hipLaunchKernelGGL(mk_fwd, dim3(grid), dim3(NWAVES * 64), LDS_BYTES, stream, a); }
#endif
}
```

```cpp
#ifndef MK_SINGLE
#define MK_SINGLE 1
#endif
#include <hip/hip_runtime.h>
#include <cstdio>
#include <cstdint>
namespace pg8 {
#define PG8_LAS __attribute__((address_space(3)))
typedef unsigned short bf16_t;
typedef short bf16x8 __attribute__((ext_vector_type(8)));
typedef float f32x4 __attribute__((ext_vector_type(4)));
typedef unsigned u32x4 __attribute__((ext_vector_type(4)));
constexpr int BM = 256, BK = 64, HALF = 128, HTB = HALF * BK * 2  , STAGE_BYTES = 8 * HTB, NXCD = 8, WGM = 8;

__host__ __device__ __forceinline__ int lds_byte(int r, int c) { const int st = (r >> 4) * 2 + (c >> 5), rr = r & 15, cc = c & 31, ob = rr * 64 + cc * 2; return st * 1024 + (ob ^ (((ob >> 9) & 1) << 5)); }
__host__ __device__ __forceinline__ void stage_rc(int b, int& R, int& C) { const int st = b / 1024, sb = b % 1024, swz = sb ^ (((sb >> 9) & 1) << 5); R = (st >> 1) * 16 + swz / 64; C = (st & 1) * 32 + (swz % 64) / 2; }
__host__ __device__ __forceinline__ int perm32(int rho) { const int n = rho >> 4, i = rho & 15; return 8 * (i >> 2) + 4 * n + (i & 3); }

struct Unit { int pm, pn; };
struct Gemm { const bf16_t* A; const bf16_t* Bt; int M, N, K; };

struct StaticOrder {
    int nM, nN, nwg, G, c;
    __host__ __device__ void init(int M, int N, int G_, int c_) { nM = M / BM; nN = N / BM; nwg = nM * nN; G = G_; c = c_; }
    __host__ __device__ bool next(int i, Unit& u) const {
        const long L = (long)i * G + c; if (L >= nwg) return false;
        int wgid = (int)L; { const int q = nwg / NXCD, r = nwg % NXCD, xcd = wgid % NXCD, off = wgid / NXCD; wgid = (xcd < r ? xcd * (q + 1) : r * (q + 1) + (xcd - r) * q) + off; }
        const int nig = WGM * nN, gid = wgid / nig, fm = gid * WGM, gsz = (nM - fm) < WGM ? (nM - fm) : WGM;
        u.pm = fm + ((wgid % nig) % gsz); u.pn = (wgid % nig) / gsz; return true;
    }
    __device__ __forceinline__ void a_ready(const Unit&) const {}
    __device__ __forceinline__ void done(const Unit&) const {}
};


__device__ __forceinline__ unsigned cvt_pk_bf16(float lo, float hi) { unsigned r; asm volatile("v_cvt_pk_bf16_f32 %0, %1, %2" : "=v"(r) : "v"(lo), "v"(hi)); return r; }
__device__ __forceinline__ float bf_lo(unsigned w) { return __builtin_bit_cast(float, w << 16); }
__device__ __forceinline__ float bf_hi(unsigned w) { return __builtin_bit_cast(float, w & 0xffff0000u); }
__device__ __forceinline__ float sigmoidf_(float x) { return 1.0f / (1.0f + __expf(-x)); }

struct EpiProjA {
    static constexpr bool PERM = true, AFTER_DRAIN = false;
    const float* rinv; bf16_t* base0;
    __device__ __forceinline__ void operator()(const f32x4 (&acc)[2][2][4][2], const Unit& u, int wr, int wc, int fr, int fq) const {
        const int row0 = u.pm * BM + wr * 64 + fr;
#pragma unroll
        for (int bj = 0; bj < 2; ++bj) {
            const int colw = u.pn * BM + bj * HALF + wc * 32;
            size_t boff; int ld, c;
            if (colw < 2048) { boff = (size_t)(colw >> 9) * (8u << 20); ld = 512; c = colw & 511; }
            else if (colw < 3712) { boff = (size_t)5 * (8u << 20); ld = 1664; c = colw - 2048; }
            else if (colw < 4224) { boff = (size_t)4 * (8u << 20); ld = 512; c = colw - 3712; }
            else if (colw < 4256) { boff = (size_t)5 * (8u << 20) + (size_t)26 * (1u << 20); ld = 32; c = colw - 4224; }
            else continue;
            bf16_t* base = base0 + boff + c + 8 * fq;
            const float qs = colw < 512 ? 0.18033688011112042f : 1.0f;
#pragma unroll
            for (int ai = 0; ai < 2; ++ai)
#pragma unroll
                for (int m = 0; m < 4; ++m) {
                    const int row = row0 + ai * HALF + m * 16; const float rs = rinv[row] * qs;
                    const f32x4 v0 = acc[ai][bj][m][0] * rs, v1 = acc[ai][bj][m][1] * rs;
                    u32x4 w; w.x = cvt_pk_bf16(v0[0], v0[1]); w.y = cvt_pk_bf16(v0[2], v0[3]); w.z = cvt_pk_bf16(v1[0], v1[1]); w.w = cvt_pk_bf16(v1[2], v1[3]);
                    *(u32x4*)(base + (size_t)row * ld) = w;
                }
        }
    }
};
struct EpiProjB {
    static constexpr bool PERM = true, AFTER_DRAIN = false;
    const float* rinv; bf16_t *GA, *GR;
    __device__ __forceinline__ void operator()(const f32x4 (&acc)[2][2][4][2], const Unit& u, int wr, int wc, int fr, int fq) const {
        const int row0 = u.pm * BM + wr * 64 + fr;
#pragma unroll
        for (int bj = 0; bj < 2; ++bj) {
            const int colw = u.pn * BM + bj * HALF + wc * 32;
            bf16_t* base = (colw < 1024 ? GA : GR) + (colw & 1023) + 8 * fq;
#pragma unroll
            for (int ai = 0; ai < 2; ++ai)
#pragma unroll
                for (int m = 0; m < 4; ++m) {
                    const int row = row0 + ai * HALF + m * 16; const float rs = rinv[row];
                    f32x4 v0 = acc[ai][bj][m][0] * rs, v1 = acc[ai][bj][m][1] * rs;
#pragma unroll
                    for (int e = 0; e < 4; ++e) { v0[e] = sigmoidf_(v0[e]); v1[e] = sigmoidf_(v1[e]); }
                    u32x4 w; w.x = cvt_pk_bf16(v0[0], v0[1]); w.y = cvt_pk_bf16(v0[2], v0[3]); w.z = cvt_pk_bf16(v1[0], v1[1]); w.w = cvt_pk_bf16(v1[2], v1[3]);
                    *(u32x4*)(base + (size_t)row * 1024) = w;
                }
        }
    }
};
template <bool ADD> struct EpiUp {
    static constexpr bool PERM = true, AFTER_DRAIN = false;
    const bf16_t* G; bf16_t* U;
    __device__ __forceinline__ void operator()(const f32x4 (&acc)[2][2][4][2], const Unit& u, int wr, int wc, int fr, int fq) const {
        const int row0 = u.pm * BM + wr * 64 + fr;
#pragma unroll
        for (int bj = 0; bj < 2; ++bj) {
            const int c = u.pn * BM + bj * HALF + wc * 32 + 8 * fq;
#pragma unroll
            for (int ai = 0; ai < 2; ++ai)
#pragma unroll
                for (int m = 0; m < 4; ++m) {
                    const size_t off = (size_t)(row0 + ai * HALF + m * 16) * 1024 + c;
                    const u32x4 g = *(const u32x4*)(G + off);
                    f32x4 v0 = acc[ai][bj][m][0], v1 = acc[ai][bj][m][1];
                    v0[0] *= bf_lo(g.x); v0[1] *= bf_hi(g.x); v0[2] *= bf_lo(g.y); v0[3] *= bf_hi(g.y);
                    v1[0] *= bf_lo(g.z); v1[1] *= bf_hi(g.z); v1[2] *= bf_lo(g.w); v1[3] *= bf_hi(g.w);
                    if (ADD) { const u32x4 p = *(const u32x4*)(U + off);
                        v0[0] += bf_lo(p.x); v0[1] += bf_hi(p.x); v0[2] += bf_lo(p.y); v0[3] += bf_hi(p.y);
                        v1[0] += bf_lo(p.z); v1[1] += bf_hi(p.z); v1[2] += bf_lo(p.w); v1[3] += bf_hi(p.w); }
                    u32x4 w; w.x = cvt_pk_bf16(v0[0], v0[1]); w.y = cvt_pk_bf16(v0[2], v0[3]); w.z = cvt_pk_bf16(v1[0], v1[1]); w.w = cvt_pk_bf16(v1[2], v1[3]);
                    *(u32x4*)(U + off) = w;
                }
        }
    }
};
struct EpiF32 {
    static constexpr bool PERM = false, AFTER_DRAIN = false;
    float* O; int ldc;
    __device__ __forceinline__ void operator()(const f32x4 (&acc)[2][2][4][2], const Unit& u, int wr, int wc, int fr, int fq) const {
        const int row0 = u.pm * BM + wr * 64 + fr, col0 = u.pn * BM + wc * 32 + 4 * fq;
#pragma unroll
        for (int ai = 0; ai < 2; ++ai)
#pragma unroll
            for (int m = 0; m < 4; ++m) { float* rowp = O + (size_t)(row0 + ai * HALF + m * 16) * ldc + col0;
#pragma unroll
                for (int bj = 0; bj < 2; ++bj)
#pragma unroll
                    for (int n = 0; n < 2; ++n) *(f32x4*)(rowp + bj * HALF + n * 16) = acc[ai][bj][m][n]; }
    }
};
template <class Epi, class Sched, bool ALIGN_EPI = false, bool SP2 = false>
__device__ __forceinline__ void gemm_phase(PG8_LAS unsigned char* lds, const Gemm g, const Sched& S, const Epi& E) {
    int tid_o = threadIdx.x; asm volatile("" : "+v"(tid_o));
    const int tid = tid_o, wid = __builtin_amdgcn_readfirstlane(tid >> 6), lane = tid & 63, wr = wid >> 2, wc = wid & 3, fr = lane & 15, fq = lane >> 4;
    const int K = g.K, nt = K / BK;
    unsigned voffA[2], voffB[2];
#pragma unroll
    for (int i = 0; i < 2; ++i) { int R, C; stage_rc(tid * 16 + i * 8192, R, C); const int Rb = Epi::PERM ? ((R & ~31) + perm32(R & 31)) : R;
        voffA[i] = (unsigned)(R * K + C) * 2u; voffB[i] = (unsigned)(Rb * K + C) * 2u; }
    const size_t kstep = (size_t)(BK * 2);
    const size_t hstep = (size_t)HALF * K * 2;
    const size_t tstep = 2 * hstep;
    const unsigned ldsw = (unsigned)wid * 1024u;
    const int aoff = lds_byte(wr * 64 + fr, fq * 8), boff = lds_byte(wc * 32 + fr, fq * 8);
#define PG8_SA(b, h) (((b) * 2 + (h)) * HTB)
#define PG8_SB(b, h) ((4 + (b) * 2 + (h)) * HTB)
#define PG8_STAGE(bufoff, gbase, voff) do { _Pragma("unroll") for (int _i = 0; _i < 2; ++_i) \
        __builtin_amdgcn_global_load_lds((const unsigned*)((const char*)(gbase) + (voff)[_i]), (PG8_LAS unsigned*)(lds + (bufoff) + ldsw + _i * 8192), 16, 0, 0); } while (0)
#define PG8_LDA(dst, b, h) do { _Pragma("unroll") for (int m = 0; m < 4; ++m) _Pragma("unroll") for (int k = 0; k < 2; ++k) dst[m][k] = *(const PG8_LAS bf16x8*)(lds + PG8_SA(b, h) + aoff + m * 2048 + k * 1024); } while (0)
#define PG8_LDB(dst, b, h) do { _Pragma("unroll") for (int n = 0; n < 2; ++n) _Pragma("unroll") for (int k = 0; k < 2; ++k) dst[n][k] = *(const PG8_LAS bf16x8*)(lds + PG8_SB(b, h) + boff + n * 2048 + k * 1024); } while (0)
#define PG8_MMA(ai, bj, At, Bt) do { __builtin_amdgcn_s_setprio(1); _Pragma("unroll") for (int m = 0; m < 4; ++m) _Pragma("unroll") for (int n = 0; n < 2; ++n) _Pragma("unroll") for (int k = 0; k < 2; ++k) \
        acc[ai][bj][m][n] = __builtin_amdgcn_mfma_f32_16x16x32_bf16(Bt[n][k], At[m][k], acc[ai][bj][m][n], 0, 0, 0); __builtin_amdgcn_s_setprio(0); } while (0)
#define PG8_WAIT_V(n) asm volatile("s_waitcnt vmcnt(" #n ")" ::: "memory")
#define PG8_WAIT_L(n) asm volatile("s_waitcnt lgkmcnt(" #n ")" ::: "memory")
#define PG8_BAR __builtin_amdgcn_s_barrier()
#define PG8_SCHED __builtin_amdgcn_sched_barrier(0)
    Unit cur, nxt; int ui = 0;
    if (!S.next(0, cur)) return;
    f32x4 acc[2][2][4][2];
#pragma unroll
    for (int a = 0; a < 2; ++a)
#pragma unroll
        for (int b = 0; b < 2; ++b)
#pragma unroll
            for (int m = 0; m < 4; ++m)
#pragma unroll
                for (int n = 0; n < 2; ++n) acc[a][b][m][n] = (f32x4){0.f, 0.f, 0.f, 0.f};
    bf16x8 At[4][2], B0[2][2], B1[2][2];
    const char* cA = (const char*)g.A + (size_t)cur.pm * tstep; const char* cB = (const char*)g.Bt + (size_t)cur.pn * tstep;
    S.a_ready(cur);
    if constexpr (SP2) {
        PG8_STAGE(PG8_SB(0, 0), cB, voffB); PG8_STAGE(PG8_SB(0, 1), cB + hstep, voffB); PG8_STAGE(PG8_SA(0, 0), cA, voffA); PG8_STAGE(PG8_SA(0, 1), cA + hstep, voffA);
        if (wr == 1) PG8_BAR;
        PG8_WAIT_V(2); PG8_BAR;
        PG8_STAGE(PG8_SB(1, 0), cB + kstep, voffB); PG8_STAGE(PG8_SA(1, 0), cA + kstep, voffA); PG8_STAGE(PG8_SB(1, 1), cB + hstep + kstep, voffB);
        PG8_WAIT_V(6); PG8_BAR;
    } else {
        PG8_STAGE(PG8_SB(0, 0), cB, voffB); PG8_STAGE(PG8_SA(0, 0), cA, voffA); PG8_STAGE(PG8_SB(0, 1), cB + hstep, voffB); PG8_STAGE(PG8_SA(0, 1), cA + hstep, voffA);
        if (wr == 1) PG8_BAR;
        PG8_WAIT_V(4); PG8_BAR;
        PG8_STAGE(PG8_SB(1, 0), cB + kstep, voffB); PG8_STAGE(PG8_SA(1, 0), cA + kstep, voffA); PG8_STAGE(PG8_SB(1, 1), cB + hstep + kstep, voffB);
        PG8_WAIT_V(6); PG8_BAR;
    }
    for (;;) {
        const bool has_next = S.next(ui + 1, nxt);
        const char* nA = has_next ? (const char*)g.A + (size_t)nxt.pm * tstep : cA; const char* nB = has_next ? (const char*)g.Bt + (size_t)nxt.pn * tstep : cB;
        for (int t = 0; t < nt; t += 2) {
            const bool last = (t == nt - 2);
            const char* a1 = cA + (size_t)(t + 1) * kstep;
            const char* a2 = last ? nA : cA + (size_t)(t + 2) * kstep; const char* b2 = last ? nB : cB + (size_t)(t + 2) * kstep;
            const char* a3 = a2 + kstep; const char* b3 = b2 + kstep;
            if (last && has_next) S.a_ready(nxt);
            if constexpr (SP2) {
            PG8_LDB(B0, 0, 0); PG8_LDB(B1, 0, 1); PG8_SCHED; PG8_LDA(At, 0, 0); PG8_STAGE(PG8_SA(1, 1), a1 + hstep, voffA);
            PG8_WAIT_V(8); PG8_WAIT_L(0); PG8_BAR; PG8_MMA(0, 0, At, B0); PG8_MMA(0, 1, At, B1); PG8_BAR; PG8_SCHED;
            PG8_LDA(At, 0, 1); PG8_STAGE(PG8_SB(0, 0), b2, voffB); PG8_STAGE(PG8_SB(0, 1), b2 + hstep, voffB); PG8_STAGE(PG8_SA(0, 0), a2, voffA);
            PG8_WAIT_V(8); PG8_WAIT_L(0); PG8_BAR; PG8_MMA(1, 0, At, B0); PG8_MMA(1, 1, At, B1); PG8_BAR; PG8_SCHED;
            PG8_LDB(B0, 1, 0); PG8_LDB(B1, 1, 1); PG8_SCHED; PG8_LDA(At, 1, 0); PG8_STAGE(PG8_SA(0, 1), a2 + hstep, voffA);
            PG8_WAIT_V(8); PG8_WAIT_L(0); PG8_BAR; PG8_MMA(0, 0, At, B0); PG8_MMA(0, 1, At, B1); PG8_BAR; PG8_SCHED;
            PG8_LDA(At, 1, 1); PG8_STAGE(PG8_SB(1, 0), b3, voffB); PG8_STAGE(PG8_SB(1, 1), b3 + hstep, voffB); PG8_STAGE(PG8_SA(1, 0), a3, voffA);
            PG8_WAIT_V(8); PG8_WAIT_L(0); PG8_BAR; PG8_MMA(1, 0, At, B0); PG8_MMA(1, 1, At, B1); PG8_BAR; PG8_SCHED;
            } else {
            PG8_LDB(B0, 0, 0); PG8_SCHED; PG8_LDA(At, 0, 0); PG8_STAGE(PG8_SA(1, 1), a1 + hstep, voffA);
            PG8_WAIT_L(8); PG8_BAR; PG8_WAIT_L(0); PG8_MMA(0, 0, At, B0); PG8_BAR; PG8_SCHED;
            PG8_LDB(B1, 0, 1); PG8_STAGE(PG8_SB(0, 0), b2, voffB);
            PG8_BAR; PG8_WAIT_L(0); PG8_MMA(0, 1, At, B1); PG8_BAR;
            PG8_LDA(At, 0, 1); PG8_STAGE(PG8_SA(0, 0), a2, voffA);
            PG8_BAR; PG8_WAIT_L(0); PG8_MMA(1, 0, At, B0); PG8_BAR; PG8_SCHED;
            PG8_STAGE(PG8_SB(0, 1), b2 + hstep, voffB);
            PG8_WAIT_V(6); PG8_BAR; PG8_MMA(1, 1, At, B1); PG8_BAR;
            PG8_LDB(B0, 1, 0); PG8_SCHED; PG8_LDA(At, 1, 0); PG8_STAGE(PG8_SA(0, 1), a2 + hstep, voffA);
            PG8_WAIT_L(8); PG8_BAR; PG8_WAIT_L(0); PG8_MMA(0, 0, At, B0); PG8_BAR; PG8_SCHED;
            PG8_LDB(B1, 1, 1); PG8_STAGE(PG8_SB(1, 0), b3, voffB);
            PG8_BAR; PG8_WAIT_L(0); PG8_MMA(0, 1, At, B1); PG8_BAR;
            PG8_LDA(At, 1, 1); PG8_STAGE(PG8_SA(1, 0), a3, voffA);
            PG8_BAR; PG8_WAIT_L(0); PG8_MMA(1, 0, At, B0); PG8_BAR; PG8_SCHED;
            PG8_STAGE(PG8_SB(1, 1), b3 + hstep, voffB);
            PG8_WAIT_V(6); PG8_BAR; PG8_MMA(1, 1, At, B1); PG8_BAR;
            }
        }
        if constexpr (ALIGN_EPI) { if (wr == 0) PG8_BAR; }
        if constexpr (!Epi::AFTER_DRAIN) { E(acc, cur, wr, wc, fr, fq); S.done(cur); }
        if (!has_next) break;
#pragma unroll
        for (int a = 0; a < 2; ++a)
#pragma unroll
            for (int b = 0; b < 2; ++b)
#pragma unroll
                for (int m = 0; m < 4; ++m)
#pragma unroll
                    for (int n = 0; n < 2; ++n) acc[a][b][m][n] = (f32x4){0.f, 0.f, 0.f, 0.f};
        cur = nxt; cA = nA; cB = nB; ++ui;
        if constexpr (ALIGN_EPI) { if (wr == 1) PG8_BAR; }
    }
    PG8_WAIT_V(0);
    if constexpr (!ALIGN_EPI) { if (wr == 0) PG8_BAR; }
    PG8_BAR;
    if constexpr (Epi::AFTER_DRAIN) { E.fused(acc, cur, wr, wc, fr, fq, lds, wid, lane); S.done(cur); }
#undef PG8_SA
#undef PG8_SB
#undef PG8_STAGE
#undef PG8_LDA
#undef PG8_LDB
#undef PG8_MMA
#undef PG8_WAIT_V
#undef PG8_WAIT_L
#undef PG8_BAR
#undef PG8_SCHED
}
}
#define GAS __attribute__((address_space(1)))
#define LAS __attribute__((address_space(3)))
typedef unsigned short bf16;
typedef unsigned v4u __attribute__((ext_vector_type(4)));
typedef float f32x4 __attribute__((ext_vector_type(4)));
typedef short bf16x8 __attribute__((ext_vector_type(8)));
typedef GAS unsigned gu32;
typedef GAS unsigned long long gu64;
#define RLX_AGENT __ATOMIC_RELAXED, __HIP_MEMORY_SCOPE_AGENT
#define LDS_WAIT() asm volatile("s_waitcnt lgkmcnt(0)" ::: "memory")
#define VM_WAIT() asm volatile("s_waitcnt vmcnt(0)" ::: "memory")
__device__ __forceinline__ unsigned long long rt() { return __builtin_amdgcn_s_memrealtime(); }
__device__ __forceinline__ unsigned f2bf(float f) { unsigned u = __builtin_bit_cast(unsigned, f); return (u + 0x7fffu + ((u >> 16) & 1u)) >> 16; }
__device__ __forceinline__ unsigned pk2(float lo, float hi) { return f2bf(lo) | (f2bf(hi) << 16); }

#define XB_TMO      128
#define XB_XCNT(j)  (256  + 64 * (j))
#define XB_XSUB(j)  (1280 + 64 * (j))
#define XB_XGEN(j)  (2304 + 64 * (j))
#define XB_TOP      3328
#define XB_TOPGEN   3392
#define XCD_BAR_WORDS 3456
#define XB_SPIN_CAP (1u << 18)

__device__ __forceinline__ unsigned xb_ld(unsigned* p)              { return __hip_atomic_load(p, __ATOMIC_RELAXED, __HIP_MEMORY_SCOPE_AGENT); }
__device__ __forceinline__ unsigned xb_add(unsigned* p, unsigned v) { return __hip_atomic_fetch_add(p, v, __ATOMIC_RELAXED, __HIP_MEMORY_SCOPE_AGENT); }
__device__ __forceinline__ unsigned xb_xcc_id() { return (unsigned)__builtin_amdgcn_s_getreg((3 << 11) | 20) & 0xFu; }
#define XB_SPIN(cond, bar) do { unsigned _sp = 0; while (cond) { __builtin_amdgcn_s_sleep(1); \
    if ((++_sp & 255u) == 0u) { if (xb_ld(&(bar)[XB_TMO])) break; if (_sp > XB_SPIN_CAP) { atomicAdd(&(bar)[XB_TMO], 1u); break; } } } } while (0)

struct XcdBarrier {
    unsigned* bar; unsigned x;
    volatile LAS unsigned* st;
};

__device__ __forceinline__ XcdBarrier xcd_barrier_post(unsigned* bar, volatile LAS unsigned* st) {
    XcdBarrier b; b.bar = bar; b.x = xb_xcc_id(); b.st = st;
    if (threadIdx.x == 0) (void)xb_add(&bar[XB_XCNT(b.x)], 1u);
    return b;
}
__device__ __forceinline__ void xcd_barrier_complete(unsigned* bar, unsigned x, unsigned& nloc, unsigned& nx) {
    const unsigned G = gridDim.x * gridDim.y * gridDim.z;
    unsigned sum, cnt, mine, sp = 0u;
    for (;;) {
        sum = 0u; cnt = 0u; mine = 0u;
#pragma unroll
        for (unsigned j = 0; j < 16; ++j) { const unsigned c = xb_ld(&bar[XB_XCNT(j)]); sum += c; cnt += (c > 0u) ? 1u : 0u; mine = (j == x) ? c : mine; }
        if (sum == G) break;
        __builtin_amdgcn_s_sleep(1);
        if ((++sp & 255u) == 0u) { if (xb_ld(&bar[XB_TMO])) break; if (sp > XB_SPIN_CAP) { atomicAdd(&bar[XB_TMO], 1u); break; } }
    }
    nloc = mine > 0u ? mine : 1u; nx = cnt > 0u ? cnt : 1u;
}

__device__ __forceinline__ void xcd_barrier(const XcdBarrier& b) {
    asm volatile("s_waitcnt vmcnt(0)" ::: "memory");
    __syncthreads();
    if (threadIdx.x == 0) {
        unsigned* bar = b.bar;
        __builtin_amdgcn_s_waitcnt(0);
        unsigned nloc = b.st[0], nx = b.st[1];
        if (nloc == 0u) { xcd_barrier_complete(bar, b.x, nloc, nx); b.st[0] = nloc; b.st[1] = nx; }
        const unsigned old = xb_add(&bar[XB_XSUB(b.x)], 1u);
        const unsigned gen = old / nloc;
        if (old + 1u == (gen + 1u) * nloc) {
            __builtin_amdgcn_fence(__ATOMIC_RELEASE, "agent");
            asm volatile("s_waitcnt vmcnt(0)" ::: "memory");
            const unsigned og = xb_add(&bar[XB_TOP], 1u);
            const unsigned tg = og / nx;
            if (og + 1u == (tg + 1u) * nx) xb_add(&bar[XB_TOPGEN], 1u);
            else XB_SPIN(xb_ld(&bar[XB_TOPGEN]) == tg, bar);
            __builtin_amdgcn_fence(__ATOMIC_ACQUIRE, "agent");
            xb_add(&bar[XB_XGEN(b.x)], 1u);
            asm volatile("s_waitcnt vmcnt(0)" ::: "memory");
        } else {
            XB_SPIN(xb_ld(&bar[XB_XGEN(b.x)]) == gen, bar);
            __builtin_amdgcn_fence(__ATOMIC_ACQUIRE, "agent");
            asm volatile("s_waitcnt vmcnt(0)" ::: "memory");
        }
    }
    __syncthreads();
}
__device__ __forceinline__ float bf_lo_(unsigned w) { return __builtin_bit_cast(float, w << 16); }
__device__ __forceinline__ float bf_hi_(unsigned w) { return __builtin_bit_cast(float, w & 0xffff0000u); }

namespace att {
typedef short bf16x8 __attribute__((ext_vector_type(8)));
typedef short s16x4 __attribute__((ext_vector_type(4)));
typedef float f32x16 __attribute__((ext_vector_type(16)));
typedef unsigned u32x4 __attribute__((ext_vector_type(4)));
typedef __attribute__((address_space(3))) const char* lds_cptr;
constexpr int AW_ = 512, SLOTB = 8192;
constexpr int L_K = 0, L_V = 2 * SLOTB, L_WS = 4 * SLOTB, L_OST = L_WS + 8 * 256, L_BYTES = L_OST + 8 * 4096;
constexpr float LOG2E = 1.4426950408889634f, C2 = 0.125f * LOG2E;
__device__ __forceinline__ int crow(int r, int hi) { return (r & 3) + 8 * (r >> 2) + 4 * hi; }
__device__ __forceinline__ void glds16(const void* gsrc, unsigned lds_dst) { unsigned keep;
    asm volatile("s_mov_b32 %0, m0\n\ts_mov_b32 m0, %2\n\ts_nop 0\n\tglobal_load_lds_dwordx4 %1, off\n\ts_mov_b32 m0, %0" : "=&s"(keep) : "v"(gsrc), "s"(lds_dst) : "memory"); }
typedef float f32x2_t __attribute__((ext_vector_type(2))); typedef __bf16 bf16x2_t __attribute__((ext_vector_type(2)));
__device__ __forceinline__ unsigned cvtpk_s(float lo, float hi) { f32x2_t v = {lo, hi}; bf16x2_t b = __builtin_convertvector(v, bf16x2_t); return __builtin_bit_cast(unsigned, b); }
__device__ __forceinline__ void qkt(f32x16& p0, f32x16& p1, lds_cptr Kslot, const bf16x8* qr, int r32, int hi) {
    lds_cptr kb = Kslot + hi * 1024 + r32 * 16;
    const f32x16 z = {};
#pragma unroll
    for (int d0 = 0; d0 < 4; ++d0) {
        const bf16x8 b0 = *(const __attribute__((address_space(3))) bf16x8*)(kb + d0 * 2048);
        const bf16x8 b1 = *(const __attribute__((address_space(3))) bf16x8*)(kb + d0 * 2048 + 512);
        if (d0 == 0) { p0 = __builtin_amdgcn_mfma_f32_32x32x16_bf16(b0, qr[0], z, 0, 0, 0); p1 = __builtin_amdgcn_mfma_f32_32x32x16_bf16(b1, qr[0], z, 0, 0, 0); }
        else { p0 = __builtin_amdgcn_mfma_f32_32x32x16_bf16(b0, qr[d0], p0, 0, 0, 0); p1 = __builtin_amdgcn_mfma_f32_32x32x16_bf16(b1, qr[d0], p1, 0, 0, 0); } }
}
__device__ __forceinline__ void pv(f32x16* o, int vb, bf16x8 pa0, bf16x8 pa1, bf16x8 pa2, bf16x8 pa3) {
#pragma unroll
    for (int d0 = 0; d0 < 2; ++d0) { s16x4 lo[4], hi[4];
#pragma unroll
        for (int ks = 0; ks < 4; ++ks) {
            asm volatile("ds_read_b64_tr_b16 %0,%1 offset:%c2" : "=&v"(lo[ks]) : "v"(vb), "i"(d0 * 4096 + ks * 1024) : "memory");
            asm volatile("ds_read_b64_tr_b16 %0,%1 offset:%c2" : "=&v"(hi[ks]) : "v"(vb), "i"(d0 * 4096 + ks * 1024 + 512) : "memory"); }
        asm volatile("s_waitcnt lgkmcnt(0)" ::: "memory"); __builtin_amdgcn_sched_barrier(0);
#define ATT_PK(k) (bf16x8){lo[k][0], lo[k][1], lo[k][2], lo[k][3], hi[k][0], hi[k][1], hi[k][2], hi[k][3]}
        o[d0] = __builtin_amdgcn_mfma_f32_32x32x16_bf16(pa0, ATT_PK(0), o[d0], 0, 0, 0);
        o[d0] = __builtin_amdgcn_mfma_f32_32x32x16_bf16(pa1, ATT_PK(1), o[d0], 0, 0, 0);
        o[d0] = __builtin_amdgcn_mfma_f32_32x32x16_bf16(pa2, ATT_PK(2), o[d0], 0, 0, 0);
        o[d0] = __builtin_amdgcn_mfma_f32_32x32x16_bf16(pa3, ATT_PK(3), o[d0], 0, 0, 0);
#undef ATT_PK
    }
}
__device__ __forceinline__ float swapmax(float m) { auto rr = __builtin_amdgcn_permlane32_swap(__float_as_uint(m), __float_as_uint(m), false, false); return fmaxf(__uint_as_float(rr[0]), __uint_as_float(rr[1])); }
__device__ __forceinline__ float swapadd(float m) { auto rr = __builtin_amdgcn_permlane32_swap(__float_as_uint(m), __float_as_uint(m), false, false); return __uint_as_float(rr[0]) + __uint_as_float(rr[1]); }

__device__ __forceinline__ void moba_unit(int tid, int b, int h, int qblk, unsigned short* Qb, const unsigned short* Kb, const unsigned short* Vb, const unsigned short* AZb, const float* KM, lds_cptr shm3) {
    const int lane = tid & 63, r32 = lane & 31, hi = lane >> 5; const int wid = __builtin_amdgcn_readfirstlane(tid >> 6);
    const long rowbase = (long)b * 2048; const int q0 = qblk * 256 + wid * 32, qpos = q0 + r32;
    const unsigned short* Qw = Qb + (rowbase + q0) * AW_ + h * 64;
    const unsigned short* Kh = Kb + rowbase * AW_ + h * 64; const unsigned short* Vh = Vb + rowbase * AW_ + h * 64;
    const unsigned lds0 = (unsigned)(size_t)shm3;
    __attribute__((address_space(3))) float* wsf = (__attribute__((address_space(3))) float*)(shm3 + L_WS) + wid * 64;
    const unsigned short* ksrc = Kh + (long)lane * AW_ + wid * 8;
    const unsigned short* vsrc = Vh + (long)(16 * (wid & 3) + (lane >> 2)) * AW_ + (wid >> 2) * 32 + (lane & 3) * 8;
    const unsigned kdst = lds0 + L_K + wid * 1024, vdst = lds0 + L_V + wid * 1024;
    const int vb0 = (int)(lds0 + L_V) + ((lane >> 4) & 1) * 32 + (lane & 3) * 8 + (4 * hi + ((lane & 15) >> 2)) * 64;
    const int NT = 4 * (qblk + 1);
#define ATT_BASE(s) ((s) < 4 ? qblk * 256 + 64 * (s) : (qblk - 1 - (((s) - 4) >> 2)) * 256 + 64 * (((s) - 4) & 3))
    { const int kb0 = ATT_BASE(0); glds16(ksrc + (long)kb0 * AW_, (unsigned)__builtin_amdgcn_readfirstlane(kdst)); glds16(vsrc + (long)kb0 * AW_, (unsigned)__builtin_amdgcn_readfirstlane(vdst)); }
    bf16x8 qr[4];
#pragma unroll
    for (int d0 = 0; d0 < 4; ++d0) qr[d0] = *reinterpret_cast<const bf16x8*>(&Qw[(long)r32 * AW_ + d0 * 16 + hi * 8]);
    unsigned selmask = 0u;
    if (qblk > 0) {
        float g[8];
#pragma unroll
        for (int j = 0; j < 8; ++j) { g[j] = 0.f;
            if (j < qblk) { const float* km = KM + ((long)(b * 8 + j)) * AW_ + h * 64 + hi * 8;
#pragma unroll
                for (int d0 = 0; d0 < 4; ++d0) { const f32x4 a0 = *(const f32x4*)(km + d0 * 16), a1 = *(const f32x4*)(km + d0 * 16 + 4);
#pragma unroll
                    for (int e = 0; e < 4; ++e) { g[j] += __builtin_bit_cast(float, (unsigned)(unsigned short)qr[d0][e] << 16) * a0[e]; g[j] += __builtin_bit_cast(float, (unsigned)(unsigned short)qr[d0][4 + e] << 16) * a1[e]; } }
                g[j] = swapadd(g[j]); }
            else g[j] = -1e30f; }
#pragma unroll
        for (int j = 0; j < 8; ++j) { int rank = 0;
#pragma unroll
            for (int i = 0; i < 8; ++i) rank += (g[i] > g[j] || (g[i] == g[j] && i < j)) ? 1 : 0;
            if (rank < 3 && j < qblk) selmask |= 1u << j; }
    }
    const float cb = exp2f(-(float)(h + 1)) * LOG2E;
    float mrun = -1e30f, l_reg = 0.f; f32x16 o[2]; o[0] = f32x16{}; o[1] = f32x16{};
    for (int s = 0; s < NT; ++s) {
        asm volatile("s_waitcnt vmcnt(0) lgkmcnt(0)\n\ts_barrier" ::: "memory");
        if (s + 1 < NT) { const int kb1 = ATT_BASE(s + 1); const unsigned so = ((s + 1) & 1) * SLOTB;
            glds16(ksrc + (long)kb1 * AW_, (unsigned)__builtin_amdgcn_readfirstlane(kdst + so)); glds16(vsrc + (long)kb1 * AW_, (unsigned)__builtin_amdgcn_readfirstlane(vdst + so)); }
        const int base = ATT_BASE(s); const bool own = s < 4; const int j = own ? qblk : (qblk - 1 - ((s - 4) >> 2));
        const bool mine = own ? true : (((selmask >> j) & 1u) != 0u);
        const bool skip = own ? (base > q0 + 31) : !__any(mine);
        if (skip) continue;
        const int slot = (s & 1) * SLOTB;
        f32x16 p0, p1;
        qkt(p0, p1, shm3 + L_K + slot, qr, r32, hi);
        const float fb = cb * (float)(base + 4 * hi - qpos);
        float rm = -1e30f;
#pragma unroll
        for (int r = 0; r < 16; ++r) { const int ko = (r & 3) + 8 * (r >> 2); const int kv = base + 4 * hi + ko;
            float s0 = p0[r] + (fb + cb * (float)ko), s1 = p1[r] + (fb + cb * (float)(ko + 32));
            if (own) { if (kv > qpos) s0 = -1e30f; if (kv + 32 > qpos) s1 = -1e30f; } else if (!mine) { s0 = -1e30f; s1 = -1e30f; }
            p0[r] = s0; p1[r] = s1; rm = fmaxf(rm, fmaxf(s0, s1)); }
        rm = swapmax(rm);
        const float mnew = fmaxf(mrun, rm), alpha = exp2f(mrun - mnew); mrun = mnew;
        float sacc = 0.f;
#pragma unroll
        for (int r = 0; r < 16; ++r) { p0[r] = exp2f(p0[r] - mnew); p1[r] = exp2f(p1[r] - mnew); sacc += p0[r] + p1[r]; }
        l_reg = l_reg * alpha + sacc;
        if (hi == 0) wsf[r32] = alpha;
        asm volatile("s_waitcnt lgkmcnt(0)" ::: "memory");
#pragma unroll
        for (int r = 0; r < 16; ++r) { const float f = wsf[crow(r, hi)]; o[0][r] *= f; o[1][r] *= f; }
        u32x4 pw0, pw1, pw2, pw3;
        pw0 = (u32x4){cvtpk_s(p0[0], p0[1]), cvtpk_s(p0[2], p0[3]), cvtpk_s(p0[4], p0[5]), cvtpk_s(p0[6], p0[7])};
        pw1 = (u32x4){cvtpk_s(p0[8], p0[9]), cvtpk_s(p0[10], p0[11]), cvtpk_s(p0[12], p0[13]), cvtpk_s(p0[14], p0[15])};
        pw2 = (u32x4){cvtpk_s(p1[0], p1[1]), cvtpk_s(p1[2], p1[3]), cvtpk_s(p1[4], p1[5]), cvtpk_s(p1[6], p1[7])};
        pw3 = (u32x4){cvtpk_s(p1[8], p1[9]), cvtpk_s(p1[10], p1[11]), cvtpk_s(p1[12], p1[13]), cvtpk_s(p1[14], p1[15])};
        __builtin_amdgcn_sched_barrier(0);
        pv(o, vb0 + slot, __builtin_bit_cast(bf16x8, pw0), __builtin_bit_cast(bf16x8, pw1), __builtin_bit_cast(bf16x8, pw2), __builtin_bit_cast(bf16x8, pw3));
    }
#undef ATT_BASE
    l_reg = swapadd(l_reg);
    if (hi == 0) wsf[32 + r32] = l_reg;
    asm volatile("s_waitcnt lgkmcnt(0)" ::: "memory");
    float rli[16];
#pragma unroll
    for (int r = 0; r < 16; ++r) rli[r] = 1.0f / wsf[32 + crow(r, hi)];
    {
        __attribute__((address_space(3))) unsigned short* stg = (__attribute__((address_space(3))) unsigned short*)(shm3 + L_OST) + wid * 2048;
#pragma unroll
        for (int r = 0; r < 16; ++r) { const int orow = crow(r, hi);
#pragma unroll
            for (int d0 = 0; d0 < 2; ++d0) stg[orow * 64 + d0 * 32 + r32] = (unsigned short)(cvtpk_s(o[d0][r] * rli[r], 0.f) & 0xffffu); }
        asm volatile("s_waitcnt lgkmcnt(0)" ::: "memory");
        const unsigned short* AZw = AZb + (rowbase + q0) * AW_ + h * 64; unsigned short* Ow = Qb + (rowbase + q0) * AW_ + h * 64;
#pragma unroll
        for (int i = 0; i < 4; ++i) { const int row = i * 8 + (lane >> 3), ch = lane & 7;
            const u32x4 v = *(const __attribute__((address_space(3))) u32x4*)(stg + row * 64 + ch * 8); const u32x4 z = *(const u32x4*)(AZw + (long)row * AW_ + ch * 8);
            u32x4 w;
#pragma unroll
            for (int e = 0; e < 4; ++e) { const float z0 = __builtin_bit_cast(float, z[e] << 16), z1 = __builtin_bit_cast(float, z[e] & 0xffff0000u);
                const float v0 = __builtin_bit_cast(float, v[e] << 16), v1 = __builtin_bit_cast(float, v[e] & 0xffff0000u);
                w[e] = cvtpk_s(v0 * (z0 / (1.0f + __expf(-z0))), v1 * (z1 / (1.0f + __expf(-z1)))); }
            *(u32x4*)(Ow + (long)row * AW_ + ch * 8) = w; }
    }
    asm volatile("s_waitcnt lgkmcnt(0)" ::: "memory");
}
__device__ __forceinline__ void moba_phase(int tid, int vcu, int G, unsigned short* Qb, const unsigned short* Kb, const unsigned short* Vb, const unsigned short* AZb, const float* KM, lds_cptr shm3) {
    for (int u = vcu; u < 512; u += G) {
        const int v = u & 255, bh = v >> 2, s = v & 3, qblk = (u < 256) ? s : 7 - s;
        moba_unit(tid, bh >> 3, bh & 7, qblk, Qb, Kb, Vb, AZb, KM, shm3);
    }
    asm volatile("s_waitcnt vmcnt(0) lgkmcnt(0)\n\ts_barrier" ::: "memory");
}
}

namespace rw7 {
typedef short bf16x8 __attribute__((ext_vector_type(8)));
typedef float f32x16 __attribute__((ext_vector_type(16)));
typedef unsigned u32x2 __attribute__((ext_vector_type(2)));
typedef unsigned u32x4 __attribute__((ext_vector_type(4)));
typedef unsigned short u16;
#define RLAS __attribute__((address_space(3)))
typedef RLAS unsigned char* ldsp;
constexpr int PIT = 144, TILE = 64 * PIT;
constexpr int SEQ_ = 2048, AW_ = 512, RWS_ = 1664;
constexpr int F_OFF = 6 * TILE, F_BYTES = 16384;
constexpr int X_OFF = 14 * TILE;
constexpr int GC_OFF = X_OFF, CB_OFF = X_OFF + 256, ST_OFF = X_OFF + 512;
constexpr int PART_OFF = 13 * TILE;
#define SLOT(n) ((n) * TILE)
__device__ __forceinline__ int crow(int r, int hi) { return (r & 3) + 8 * (r >> 2) + 4 * hi; }
__device__ __forceinline__ unsigned cvtpk(float lo, float hi) { typedef float f2 __attribute__((ext_vector_type(2))); typedef __bf16 b2 __attribute__((ext_vector_type(2))); f2 v = {lo, hi}; b2 b = __builtin_convertvector(v, b2); return __builtin_bit_cast(unsigned, b); }
__device__ __forceinline__ u16 tobf(float x) { return (u16)(cvtpk(x, 0.f) & 0xffffu); }
__device__ __forceinline__ float frombf(u16 v) { return __builtin_bit_cast(float, (unsigned)v << 16); }
__device__ __forceinline__ float wsum(float v) {
#pragma unroll
    for (int o = 1; o < 64; o <<= 1) v += __shfl_xor(v, o);
    return v;
}
__device__ __forceinline__ f32x16 mm(f32x16 acc, ldsp A, ldsp B, int ti, int tj, int lane) {
    const int row = lane & 31, h = lane >> 5;
    const RLAS unsigned char* ap = A + (32 * ti + row) * PIT + h * 16; const RLAS unsigned char* bp = B + (32 * tj + row) * PIT + h * 16;
#pragma unroll
    for (int ks = 0; ks < 4; ++ks) { const bf16x8 a = *(const RLAS bf16x8*)(ap + ks * 32), b = *(const RLAS bf16x8*)(bp + ks * 32); acc = __builtin_amdgcn_mfma_f32_32x32x16_bf16(a, b, acc, 0, 0, 0); }
    return acc;
}
__device__ __forceinline__ f32x16 mm_ga(f32x16 acc, const u16* Ag, ldsp B, int ti, int tj, int lane) {
    const int row = lane & 31, h = lane >> 5;
    const u16* ap = Ag + (32 * ti + row) * 64 + h * 8; const RLAS unsigned char* bp = B + (32 * tj + row) * PIT + h * 16;
#pragma unroll
    for (int ks = 0; ks < 4; ++ks) { const bf16x8 a = *(const bf16x8*)(ap + ks * 16), b = *(const RLAS bf16x8*)(bp + ks * 32); acc = __builtin_amdgcn_mfma_f32_32x32x16_bf16(a, b, acc, 0, 0, 0); }
    return acc;
}
__device__ __forceinline__ f32x16 mm_gb(f32x16 acc, ldsp A, const u16* Bg, int ti, int tj, int lane) {
    const int row = lane & 31, h = lane >> 5;
    const RLAS unsigned char* ap = A + (32 * ti + row) * PIT + h * 16; const u16* bp = Bg + (32 * tj + row) * 64 + h * 8;
#pragma unroll
    for (int ks = 0; ks < 4; ++ks) { const bf16x8 a = *(const RLAS bf16x8*)(ap + ks * 32), b = *(const bf16x8*)(bp + ks * 16); acc = __builtin_amdgcn_mfma_f32_32x32x16_bf16(a, b, acc, 0, 0, 0); }
    return acc;
}
__device__ __forceinline__ void wr_n(const f32x16& acc, ldsp O, int ti, int tj, int lane) {
    const int c = lane & 31, hi = lane >> 5;
#pragma unroll
    for (int r = 0; r < 16; ++r) *(RLAS u16*)(O + (32 * ti + crow(r, hi)) * PIT + (32 * tj + c) * 2) = tobf(acc[r]);
}
__device__ __forceinline__ void wr_t(const f32x16& acc, ldsp O, int ti, int tj, int lane) {
    const int c = lane & 31, hi = lane >> 5;
#pragma unroll
    for (int g = 0; g < 4; ++g) { u32x2 w; w.x = cvtpk(acc[4 * g], acc[4 * g + 1]); w.y = cvtpk(acc[4 * g + 2], acc[4 * g + 3]);
        *(RLAS u32x2*)(O + (32 * tj + c) * PIT + (32 * ti + 8 * g + 4 * hi) * 2) = w; }
}
__device__ __forceinline__ void wr_t_glob(const f32x16& acc, u16* Og, int ti, int tj, int lane) {
    const int c = lane & 31, hi = lane >> 5;
#pragma unroll
    for (int g = 0; g < 4; ++g) { u32x2 w; w.x = cvtpk(acc[4 * g], acc[4 * g + 1]); w.y = cvtpk(acc[4 * g + 2], acc[4 * g + 3]);
        *(u32x2*)(Og + (32 * tj + c) * 64 + 32 * ti + 8 * g + 4 * hi) = w; }
}

struct Ctx {
    int tid, lane, wave, vcu, G, layer;
    ldsp lds;
    const u16* RW; u16* RZ; const u16* VD; u16* VF;
    u16 *PT, *QG, *TT, *SG;
    const float *mu, *w0, *w_up, *a0, *a_up, *k_k, *k_a, *r_k, *ln_g, *ln_b, *vmu, *v_up, *v0;
};

__device__ __forceinline__ void load_weights(const Ctx& C, int h) {
    const int k = C.lane, w = C.wave, col = h * 64 + k;
    u32x4 a, b, c;
    float x[8], y[8], z[8];
#pragma unroll
    for (int jj = 0; jj < 8; ++jj) { const int j = 8 * w + jj; x[jj] = C.w_up[(size_t)j * AW_ + col]; y[jj] = C.a_up[(size_t)j * AW_ + col]; z[jj] = (C.layer == 1 && j < 32) ? C.v_up[(size_t)j * AW_ + col] : 0.f; }
    a = (u32x4){cvtpk(x[0], x[1]), cvtpk(x[2], x[3]), cvtpk(x[4], x[5]), cvtpk(x[6], x[7])};
    b = (u32x4){cvtpk(y[0], y[1]), cvtpk(y[2], y[3]), cvtpk(y[4], y[5]), cvtpk(y[6], y[7])};
    c = (u32x4){cvtpk(z[0], z[1]), cvtpk(z[2], z[3]), cvtpk(z[4], z[5]), cvtpk(z[6], z[7])};
    *(RLAS u32x4*)(C.lds + SLOT(0) + k * PIT + w * 16) = a; *(RLAS u32x4*)(C.lds + SLOT(1) + k * PIT + w * 16) = b; *(RLAS u32x4*)(C.lds + SLOT(2) + k * PIT + w * 16) = c;
}

template <bool PASS3> __device__ __forceinline__ void prep(const Ctx& C, int b, int h, int c) {
    const int k = C.lane, w = C.wave, col = h * 64 + k;
    const long row0 = (long)b * SEQ_ + c * 64 + 8 * w;
    const bool seq0 = (c == 0 && w == 0);
    ldsp L = C.lds;
    {
        const float m_wd = C.mu[1536 + k], m_ad = C.mu[1600 + k]; const float m_vd = (C.layer == 1) ? C.vmu[k & 31] : 0.f;
        float pw = seq0 ? 0.f : frombf(C.RW[(row0 - 1) * RWS_ + 1536 + k]), pa = seq0 ? 0.f : frombf(C.RW[(row0 - 1) * RWS_ + 1600 + k]);
        float pv = (C.layer == 1 && !seq0) ? frombf(C.VD[(row0 - 1) * 32 + (k & 31)]) : 0.f;
#pragma unroll
        for (int i = 0; i < 8; ++i) { const long row = row0 + i; const int t = 8 * w + i;
            const float cw = frombf(C.RW[row * RWS_ + 1536 + k]), ca = frombf(C.RW[row * RWS_ + 1600 + k]);
            const float wd = cw + (pw - cw) * m_wd, ad = ca + (pa - ca) * m_ad; pw = cw; pa = ca;
            *(RLAS u16*)(L + SLOT(3) + t * PIT + k * 2) = tobf(tanhf(wd)); *(RLAS u16*)(L + SLOT(4) + t * PIT + k * 2) = tobf(ad);
            if (C.layer == 1) { const float cv = frombf(C.VD[row * 32 + (k & 31)]); const float vd = cv + (pv - cv) * m_vd; pv = cv; *(RLAS u16*)(L + SLOT(5) + t * PIT + k * 2) = (k < 32) ? tobf(vd) : (u16)0; } }
    }
    __syncthreads();
    {
        const int nj = (C.layer == 1) ? 12 : 8;
        for (int job = w; job < nj; job += 8) { const int prod = job >> 2, ti = (job >> 1) & 1, tj = job & 1;
            f32x16 acc = {}; acc = mm(acc, L + SLOT(3 + prod), L + SLOT(prod), ti, tj, C.lane);
            RLAS float* F = (RLAS float*)(L + F_OFF + prod * F_BYTES); const int cc = C.lane & 31, hi = C.lane >> 5;
#pragma unroll
            for (int r = 0; r < 16; ++r) F[(32 * ti + crow(r, hi)) * 64 + 32 * tj + cc] = acc[r]; }
    }
    __syncthreads();
    float lw[8], rr[8], km[8], vr[8], kk[8], be[8];
    {
        const float m_r = C.mu[col], m_k = C.mu[512 + col], m_v = C.mu[1024 + col];
        const float w0 = C.w0[col], a0 = C.a0[col], k_k = C.k_k[col], k_a = C.k_a[col], r_k = C.r_k[col]; const float v0 = (C.layer == 1) ? C.v0[col] : 0.f;
        float pr = seq0 ? 0.f : frombf(C.RW[(row0 - 1) * RWS_ + col]), pk = seq0 ? 0.f : frombf(C.RW[(row0 - 1) * RWS_ + 512 + col]), pv = seq0 ? 0.f : frombf(C.RW[(row0 - 1) * RWS_ + 1024 + col]);
        const RLAS float* F0 = (const RLAS float*)(L + F_OFF); const RLAS float* F1 = F0 + 4096; const RLAS float* F2 = F1 + 4096;
        float sl = 0.f;
#pragma unroll
        for (int i = 0; i < 8; ++i) { const long row = row0 + i; const int t = 8 * w + i;
            const float cr = frombf(C.RW[row * RWS_ + col]), ck = frombf(C.RW[row * RWS_ + 512 + col]), cv = frombf(C.RW[row * RWS_ + 1024 + col]);
            const float r = cr + (pr - cr) * m_r, ks = ck + (pk - ck) * m_k, vs = cv + (pv - cv) * m_v; pr = cr; pk = ck; pv = cv;
            const float z = -(F0[t * 64 + k] + w0), sp = fmaxf(z, 0.f) + __logf(1.0f + __expf(-fabsf(z)));
            lw[i] = -__expf(-sp - 0.5f); sl += lw[i];
            const float a = 1.0f / (1.0f + __expf(-(F1[t * 64 + k] + a0)));
            float v = vs;
            if (C.layer == 1) { const float g = 1.0f / (1.0f + __expf(-(F2[t * 64 + k] + v0))); const float vf = frombf(C.VF[row * AW_ + col]); v = vs + (vf - vs) * g; }
            else if (!PASS3) C.VF[row * AW_ + col] = tobf(vs);
            const float kkv = ks * k_k; const float nrm = sqrtf(wsum(kkv * kkv)); const float kn = kkv / fmaxf(nrm, 1e-12f);
            const float kmod = ks * (1.0f + (a - 1.0f) * k_a);
            if (PASS3) { const float cb = wsum(r * kmod * r_k); if (k == 0) *(RLAS float*)(L + CB_OFF + t * 4) = cb; }
            rr[i] = r; km[i] = kmod; vr[i] = v; kk[i] = kn; be[i] = kn * a; }
        *(RLAS float*)(L + PART_OFF + (w * 64 + k) * 4) = sl;
    }
    __syncthreads();
    {
        float off = 0.f, tot = 0.f;
#pragma unroll
        for (int ww = 0; ww < 8; ++ww) { const float p = *(const RLAS float*)(L + PART_OFF + (ww * 64 + k) * 4); if (ww < w) off += p; tot += p; }
        if (!PASS3 && w == 0) *(RLAS float*)(L + GC_OFF + k * 4) = __expf(tot);
        float ab[8], bb[8], kb[8], rb[8];
        float Lx = off;
#pragma unroll
        for (int i = 0; i < 8; ++i) { const float Li = Lx + lw[i]; const float eLx = __expf(Lx), eN = __expf(-Li);
            ab[i] = -kk[i] * eLx; bb[i] = be[i] * eN; kb[i] = km[i] * eN; rb[i] = PASS3 ? rr[i] * __expf(Li) : 0.f; Lx = Li; }
#pragma unroll
        for (int i = 0; i < 8; ++i) { const int t = 8 * w + i;
            *(RLAS u16*)(L + SLOT(3) + t * PIT + k * 2) = tobf(ab[i]); *(RLAS u16*)(L + SLOT(4) + t * PIT + k * 2) = tobf(bb[i]); *(RLAS u16*)(L + SLOT(5) + t * PIT + k * 2) = tobf(kb[i]);
            if (PASS3) *(RLAS u16*)(L + SLOT(6) + t * PIT + k * 2) = tobf(rb[i]); }
#define RW7_PK8(x) (u32x4){cvtpk(x[0], x[1]), cvtpk(x[2], x[3]), cvtpk(x[4], x[5]), cvtpk(x[6], x[7])}
        if (PASS3) { *(RLAS u32x4*)(L + SLOT(7) + k * PIT + w * 16) = RW7_PK8(vr); }
        else { *(RLAS u32x4*)(L + SLOT(6) + k * PIT + w * 16) = RW7_PK8(ab); *(RLAS u32x4*)(L + SLOT(7) + k * PIT + w * 16) = RW7_PK8(bb);
               *(RLAS u32x4*)(L + SLOT(8) + k * PIT + w * 16) = RW7_PK8(kb); *(RLAS u32x4*)(L + SLOT(9) + k * PIT + w * 16) = RW7_PK8(vr); }
#undef RW7_PK8
    }
    __syncthreads();
}

__device__ __forceinline__ void pass1(const Ctx& C) {
    ldsp L = C.lds; const int lane = C.lane, w = C.wave, half = w >> 2, ti = (w >> 1) & 1, tj = w & 1, cc = lane & 31, hi = lane >> 5;
    int hcur = -1;
    for (int u = C.vcu; u < 2048; u += C.G) {
        const int h = u & 7, n = u >> 3, b = n >> 5, c = n & 31;
        if (h != hcur) { __syncthreads(); load_weights(C, h); hcur = h; }
        prep<false>(C, b, h, c);
        f32x16 acc = {};
        if (half == 0) { acc = mm(acc, L + SLOT(4), L + SLOT(3), ti, tj, lane);
#pragma unroll
            for (int r = 0; r < 16; ++r) { const int s = 32 * ti + crow(r, hi), t = 32 * tj + cc; if (!(s < t)) acc[r] = 0.f; }
            wr_n(acc, L + SLOT(10), ti, tj, lane); wr_t(acc, L + SLOT(11), ti, tj, lane);
#pragma unroll
            for (int r = 0; r < 16; ++r) { const int s = 32 * ti + crow(r, hi), t = 32 * tj + cc; if (s == t) acc[r] += 1.0f; }
            wr_n(acc, L + SLOT(12), ti, tj, lane);
        } else { acc = mm(acc, L + SLOT(5), L + SLOT(3), ti, tj, lane);
#pragma unroll
            for (int r = 0; r < 16; ++r) { const int s = 32 * ti + crow(r, hi), t = 32 * tj + cc; if (!(s < t)) acc[r] = 0.f; }
            wr_t(acc, L + SLOT(13), ti, tj, lane); }
        __syncthreads();
        f32x16 tm = {};
        if (half == 0) { acc = f32x16{}; acc = mm(acc, L + SLOT(10), L + SLOT(11), ti, tj, lane); wr_n(acc, L + SLOT(3), ti, tj, lane); wr_t(acc, L + SLOT(4), ti, tj, lane); }
        else { acc = f32x16{}; acc = mm(acc, L + SLOT(9), L + SLOT(13), ti, tj, lane); wr_n(acc, L + SLOT(5), ti, tj, lane);
#pragma unroll
            for (int r = 0; r < 16; ++r) tm[r] = frombf(*(const RLAS u16*)(L + SLOT(12) + (32 * ti + crow(r, hi)) * PIT + (32 * tj + cc) * 2)); }
        __syncthreads();
#pragma unroll
        for (int lv = 1; lv <= 5; ++lv) {
            const int pwn = (lv & 1) ? 3 : 10, pwt = (lv & 1) ? 4 : 11;
            const int qn = (lv & 1) ? 10 : 3, qt = (lv & 1) ? 11 : 4;
            const int tsrc = (lv & 1) ? 12 : 13, tdst = (lv & 1) ? 13 : 12;
            if (half == 0) { if (lv < 5) { acc = f32x16{}; acc = mm(acc, L + SLOT(pwn), L + SLOT(pwt), ti, tj, lane); wr_n(acc, L + SLOT(qn), ti, tj, lane); wr_t(acc, L + SLOT(qt), ti, tj, lane); } }
            else { tm = mm(tm, L + SLOT(tsrc), L + SLOT(pwt), ti, tj, lane);
                if (lv < 5) wr_n(tm, L + SLOT(tdst), ti, tj, lane);
                else { wr_t(tm, L + SLOT(13), ti, tj, lane); wr_t_glob(tm, C.TT + (size_t)u * 4096, ti, tj, lane); } }
            __syncthreads();
        }
        acc = f32x16{};
        if (half == 0) { acc = mm(acc, L + SLOT(6), L + SLOT(13), ti, tj, lane); wr_n(acc, L + SLOT(10), ti, tj, lane); }
        else { acc = mm(acc, L + SLOT(5), L + SLOT(13), ti, tj, lane); wr_n(acc, L + SLOT(11), ti, tj, lane); }
        __syncthreads();
        acc = f32x16{};
        if (half == 0) { acc = mm(acc, L + SLOT(10), L + SLOT(7), ti, tj, lane);
            const float g = *(const RLAS float*)(L + GC_OFF + (32 * tj + cc) * 4);
#pragma unroll
            for (int r = 0; r < 16; ++r) { const int i = 32 * ti + crow(r, hi), j = 32 * tj + cc; acc[r] = (acc[r] + (i == j ? 1.0f : 0.f)) * g; }
            wr_t_glob(acc, C.PT + (size_t)u * 4096, ti, tj, lane);
        } else { acc = mm(acc, L + SLOT(7), L + SLOT(11), ti, tj, lane); acc = mm(acc, L + SLOT(8), L + SLOT(9), ti, tj, lane);
#pragma unroll
            for (int r = 0; r < 16; ++r) acc[r] *= *(const RLAS float*)(L + GC_OFF + (32 * ti + crow(r, hi)) * 4);
            wr_t_glob(acc, C.QG + (size_t)u * 4096, ti, tj, lane); }
        __syncthreads();
    }
}

__device__ __forceinline__ void pass2(const Ctx& C) {
    ldsp L = C.lds; const int lane = C.lane, w = C.wave, ti = (w >> 1) & 1, tj = w & 1, cc = lane & 31, hi = lane >> 5;
    for (int bh = C.vcu; bh < 64; bh += C.G) {
        const int b = bh >> 3, h = bh & 7;
        f32x16 s = {};
        for (int c = 0; c < 32; ++c) {
            const size_t u = ((size_t)(b * 32 + c) * 8 + h);
            if (w < 4) { wr_t(s, L + SLOT(c & 1), ti, tj, lane); wr_t_glob(s, C.SG + u * 4096, ti, tj, lane); }
            __syncthreads();
            if (w < 4 && c < 31) {
                const u16* q = C.QG + u * 4096 + (32 * tj + cc) * 64 + 32 * ti + 4 * hi;
#pragma unroll
                for (int g = 0; g < 4; ++g) { const u32x2 v = *(const u32x2*)(q + 8 * g); s[4 * g] = __builtin_bit_cast(float, v.x << 16); s[4 * g + 1] = __builtin_bit_cast(float, v.x & 0xffff0000u);
                    s[4 * g + 2] = __builtin_bit_cast(float, v.y << 16); s[4 * g + 3] = __builtin_bit_cast(float, v.y & 0xffff0000u); }
                s = mm_ga(s, C.PT + u * 4096, L + SLOT(c & 1), ti, tj, lane);
            }
        }
        __syncthreads();
    }
}

__device__ __forceinline__ void pass3(const Ctx& C) {
    ldsp L = C.lds; const int lane = C.lane, w = C.wave, half = w >> 2, ti = (w >> 1) & 1, tj = w & 1, cc = lane & 31, hi = lane >> 5;
    int hcur = -1;
    for (int u = C.vcu; u < 2048; u += C.G) {
        const int h = u & 7, n = u >> 3, b = n >> 5, c = n & 31;
        if (h != hcur) { __syncthreads(); load_weights(C, h); hcur = h; }
        prep<true>(C, b, h, c);
        const u16* Sg = C.SG + (size_t)u * 4096; const u16* Tg = C.TT + (size_t)u * 4096;
        f32x16 acc = {}, sa = {};
        if (half == 0) {
            acc = mm(acc, L + SLOT(4), L + SLOT(6), ti, tj, lane);
#pragma unroll
            for (int r = 0; r < 16; ++r) { const int s = 32 * ti + crow(r, hi), t = 32 * tj + cc; if (!(s <= t)) acc[r] = 0.f; }
            wr_t(acc, L + SLOT(8), ti, tj, lane);
            acc = f32x16{}; acc = mm(acc, L + SLOT(5), L + SLOT(6), ti, tj, lane);
#pragma unroll
            for (int r = 0; r < 16; ++r) { const int s = 32 * ti + crow(r, hi), t = 32 * tj + cc; if (!(s <= t)) acc[r] = 0.f; }
            wr_t(acc, L + SLOT(9), ti, tj, lane);
        } else {
            acc = mm(acc, L + SLOT(5), L + SLOT(3), ti, tj, lane);
#pragma unroll
            for (int r = 0; r < 16; ++r) { const int s = 32 * ti + crow(r, hi), t = 32 * tj + cc; if (!(s < t)) acc[r] = 0.f; }
            wr_t(acc, L + SLOT(10), ti, tj, lane);
            sa = mm_ga(sa, Sg, L + SLOT(3), ti, tj, lane);
        }
        __syncthreads();
        if (half == 1) { sa = mm(sa, L + SLOT(7), L + SLOT(10), ti, tj, lane); wr_n(sa, L + SLOT(11), ti, tj, lane); }
        __syncthreads();
        if (half == 1) { acc = f32x16{}; acc = mm_gb(acc, L + SLOT(11), Tg, ti, tj, lane); wr_n(acc, L + SLOT(12), ti, tj, lane); }
        __syncthreads();
        f32x16 o = {};
        if (half == 0) {
            o = mm_ga(o, Sg, L + SLOT(6), ti, tj, lane); o = mm(o, L + SLOT(12), L + SLOT(8), ti, tj, lane); o = mm(o, L + SLOT(7), L + SLOT(9), ti, tj, lane);
            float s1 = 0.f, s2 = 0.f;
#pragma unroll
            for (int r = 0; r < 16; ++r) { s1 += o[r]; s2 += o[r] * o[r]; }
            s1 += __shfl_xor(s1, 32); s2 += __shfl_xor(s2, 32);
            if (hi == 0) { *(RLAS float*)(L + ST_OFF + ((ti * 2 + 0) * 64 + 32 * tj + cc) * 4) = s1; *(RLAS float*)(L + ST_OFF + ((ti * 2 + 1) * 64 + 32 * tj + cc) * 4) = s2; }
        }
        __syncthreads();
        if (half == 0) {
            const int t = 32 * tj + cc; const long row = (long)b * SEQ_ + c * 64 + t;
            const float s1 = *(const RLAS float*)(L + ST_OFF + (0 * 64 + t) * 4) + *(const RLAS float*)(L + ST_OFF + (2 * 64 + t) * 4);
            const float s2 = *(const RLAS float*)(L + ST_OFF + (1 * 64 + t) * 4) + *(const RLAS float*)(L + ST_OFF + (3 * 64 + t) * 4);
            const float mean = s1 * (1.0f / 64.0f), var = fmaxf(s2 * (1.0f / 64.0f) - mean * mean, 0.f), rstd = 1.0f / sqrtf(var + 64e-5f);
            const float cb = *(const RLAS float*)(L + CB_OFF + t * 4);
            u16* rz = C.RZ + row * AW_ + h * 64;
#pragma unroll
            for (int g = 0; g < 4; ++g) { const int v0 = 32 * ti + 8 * g + 4 * hi;
                const u32x2 z = *(const u32x2*)(rz + v0); float zz[4] = {__builtin_bit_cast(float, z.x << 16), __builtin_bit_cast(float, z.x & 0xffff0000u), __builtin_bit_cast(float, z.y << 16), __builtin_bit_cast(float, z.y & 0xffff0000u)};
                float y[4];
#pragma unroll
                for (int e = 0; e < 4; ++e) { const int v = v0 + e; const float vrv = frombf(*(const RLAS u16*)(L + SLOT(7) + v * PIT + t * 2));
                    const float on = (o[4 * g + e] - mean) * rstd * C.ln_g[h * 64 + v] + C.ln_b[h * 64 + v];
                    y[e] = (on + cb * vrv) * (zz[e] / (1.0f + __expf(-zz[e]))); }
                u32x2 wv; wv.x = cvtpk(y[0], y[1]); wv.y = cvtpk(y[2], y[3]); *(u32x2*)(rz + v0) = wv; }
        }
        __syncthreads();
    }
}
#undef SLOT
#undef RLAS
}

constexpr int NWAVES = 8;
constexpr int NB = 8, SEQ = 2048, DM = 1024, M = NB * SEQ;
constexpr int NH = 8, HD = 64, AW = 512;
constexpr int RWS = 1664;
constexpr int DIN = 6272;
constexpr int NA = 4352, NBW = 2048;
constexpr int BLK = 256, NBLK = SEQ / BLK, TOPK = 3;
constexpr float RMS_EPS = 1e-6f, GN_EPS = 64e-5f;
#ifndef MK_SINGLE
#define MK_SINGLE 0
#endif
constexpr int NPH_LAYER = 11, NPHASE = 1 + 2 * NPH_LAYER;

constexpr size_t MiB = 1u << 20;
constexpr size_t WS_CTL = 0, CTL_ZERO_BYTES = 64 * 1024;
constexpr size_t WS_RINV = 1 * MiB, WS_KMEAN = 1 * MiB + 256 * 1024;
constexpr size_t WS_WA = 2 * MiB, WA_BYTES = (size_t)NA * DM * 2;
constexpr size_t WS_WB = 19 * MiB, WB_BYTES = (size_t)NBW * DM * 2;
constexpr size_t WS_WUP = 27 * MiB, WUP_BYTES = 2 * MiB;
constexpr size_t WS_WOUT = 31 * MiB, WOUT_BYTES = 2 * MiB;
constexpr size_t WS_XB = 35 * MiB, WS_VFIRST = 67 * MiB, WS_U = 83 * MiB;
constexpr size_t WS_Q = 115 * MiB, WS_K = 131 * MiB, WS_V = 147 * MiB, WS_AZ = 163 * MiB, WS_RZ = 179 * MiB, WS_RW = 195 * MiB, WS_VD = 247 * MiB;
static_assert(WS_K - WS_Q == 16 * MiB && WS_V - WS_Q == 32 * MiB && WS_AZ - WS_Q == 48 * MiB && WS_RZ - WS_Q == 64 * MiB && WS_RW - WS_Q == 80 * MiB && WS_VD - WS_RW == 52 * MiB, "EpiProjA routing offsets");
constexpr size_t WS_GA = WS_K, WS_GR = WS_RW, WS_Y = WS_Q, WS_END = 248 * MiB;
constexpr int CW_BAR = 1024;

constexpr int RING_OFF = 0, RING_BYTES = 131072;
constexpr int LDSCTL_OFF = RING_BYTES, MISC_OFF = LDSCTL_OFF + 320;
constexpr int LDS_BYTES = 147456;

struct Frame {
    LAS unsigned char* lds;
    volatile LAS unsigned* MISC;
    gu32* ctl;
    int tid, lane, wave, vcu, G;
};
__device__ __forceinline__ float wave_sum(float v) {
#pragma unroll
    for (int o = 1; o < 64; o <<= 1) v += __shfl_xor(v, o);
    return v;
}
__device__ __forceinline__ float wave_max(float v) {
#pragma unroll
    for (int o = 1; o < 64; o <<= 1) v = fmaxf(v, __shfl_xor(v, o));
    return v;
}
__device__ __forceinline__ float bf2f(bf16 v) { return __builtin_bit_cast(float, (unsigned)v << 16); }
__device__ __forceinline__ float rl(float v, int l) { return __builtin_bit_cast(float, __builtin_amdgcn_readlane(__builtin_bit_cast(int, v), l)); }

struct Args { const float* in[21]; float* out; unsigned char* ws; int ph_lo, ph_hi; };
__device__ __forceinline__ const float* inp(const Args& a, int i) { asm volatile("" : "+s"(i)); return a.in[i]; }

__device__ __forceinline__ void p0_transpose_item(const float* W, int ldw, int c0, int k0, const float* g, bf16* WT, int ldk, int n_row0, LAS float* scr, int lane) {
#pragma unroll 8
    for (int i = 0; i < 32; ++i) { const int kk = 2 * i + (lane >> 5); const float s = g ? g[k0 + kk] : 1.0f; scr[kk * 33 + (lane & 31)] = W[(size_t)(k0 + kk) * ldw + c0 + (lane & 31)] * s; }
    LDS_WAIT(); asm volatile("" ::: "memory");
    const int c = lane & 7;
#pragma unroll
    for (int j = 0; j < 4; ++j) { const int n = (lane >> 3) + 8 * j; const LAS float* s = scr + (8 * c) * 33 + n;
        v4u o; o.x = pk2(s[0 * 33], s[1 * 33]); o.y = pk2(s[2 * 33], s[3 * 33]); o.z = pk2(s[4 * 33], s[5 * 33]); o.w = pk2(s[6 * 33], s[7 * 33]);
        *(GAS v4u*)(WT + (size_t)(n_row0 + n) * ldk + k0 + 8 * c) = o; }
    LDS_WAIT(); asm volatile("" ::: "memory");
}
__device__ __forceinline__ void row_to_bf16_rinv(const float* xrow, bf16* orow, float* rinv, int lane) {
    const GAS f32x4* xr = (const GAS f32x4*)xrow + lane;
    f32x4 v[4]; float s = 0.f;
#pragma unroll
    for (int j = 0; j < 4; ++j) { v[j] = xr[64 * j]; s += (v[j].x * v[j].x + v[j].y * v[j].y) + (v[j].z * v[j].z + v[j].w * v[j].w); }
    s = wave_sum(s);
    GAS unsigned long long* o8 = (GAS unsigned long long*)orow + lane;
#pragma unroll
    for (int j = 0; j < 4; ++j) o8[64 * j] = (unsigned long long)pk2(v[j].x, v[j].y) | ((unsigned long long)pk2(v[j].z, v[j].w) << 32);
    if (lane == 0) *rinv = 1.0f / sqrtf(s * (1.0f / DM) + RMS_EPS);
}

__device__ __forceinline__ void p0_prologue(Frame& F, const Args& a) {
    LAS float* scr = (LAS float*)(F.lds + RING_OFF + F.wave * 16384);
    const int gw = F.vcu * NWAVES + F.wave, NGW = F.G * NWAVES;
    unsigned char* ws = a.ws;
    constexpr int I_A = 16 * (4224 / 32), I_V = 16, I_B = 16 * (NBW / 32), I_U = 8 * (DM / 32), I_O = 16 * (DM / 32);
    constexpr int I_LAYER = I_A + I_V + I_B + 2 * I_U + I_O;
    for (int it = gw; it < 2 * I_LAYER; it += NGW) {
        const int l = it / I_LAYER; int r = it % I_LAYER;
        const float* w_in = inp(a, 3) + (size_t)l * DM * DIN; const float* g = inp(a, 1) + l * DM;
        bf16* WA = (bf16*)(ws + WS_WA + l * WA_BYTES); bf16* WB = (bf16*)(ws + WS_WB + l * WB_BYTES);
        bf16* WU = (bf16*)(ws + WS_WUP + l * WUP_BYTES); bf16* WO = (bf16*)(ws + WS_WOUT + l * WOUT_BYTES);
        if (r < I_A) { const int kb = r / (4224 / 32), nb = r % (4224 / 32); p0_transpose_item(w_in, DIN, 32 * nb, 64 * kb, g, WA, DM, 32 * nb, scr, F.lane); continue; } r -= I_A;
        if (r < I_V) { if (l == 1) p0_transpose_item(inp(a, 14), 32, 0, 64 * r, g, WA, DM, 4224, scr, F.lane); continue; } r -= I_V;
        if (r < I_B) { const int kb = r / (NBW / 32), nb = r % (NBW / 32); p0_transpose_item(w_in, DIN, 4224 + 32 * nb, 64 * kb, g, WB, DM, 32 * nb, scr, F.lane); continue; } r -= I_B;
        if (r < I_U) { const int kb = r / (DM / 32), nb = r % (DM / 32); p0_transpose_item(inp(a, 18) + (size_t)l * AW * DM, DM, 32 * nb, 64 * kb, nullptr, WU, AW, 32 * nb, scr, F.lane); continue; } r -= I_U;
        if (r < I_U) { const int kb = r / (DM / 32), nb = r % (DM / 32); p0_transpose_item(inp(a, 19) + (size_t)l * AW * DM, DM, 32 * nb, 64 * kb, nullptr, WU + (size_t)DM * AW, AW, 32 * nb, scr, F.lane); continue; } r -= I_U;
        { const int kb = r / (DM / 32), nb = r % (DM / 32); p0_transpose_item(inp(a, 20) + (size_t)l * DM * DM, DM, 32 * nb, 64 * kb, nullptr, WO, DM, 32 * nb, scr, F.lane); }
    }
    {
        const int gt = F.vcu * (NWAVES * 64) + F.tid, NT = F.G * NWAVES * 64;
        const int n0 = 128 * DM * 2 / 16, n1 = 96 * DM * 2 / 16;
        GAS v4u* z0 = (GAS v4u*)(ws + WS_WA + (size_t)4224 * DM * 2); GAS v4u* z1 = (GAS v4u*)(ws + WS_WA + WA_BYTES + (size_t)4256 * DM * 2);
        for (int i = gt; i < n0; i += NT) z0[i] = (v4u){0u, 0u, 0u, 0u};
        for (int i = gt; i < n1; i += NT) z1[i] = (v4u){0u, 0u, 0u, 0u};
    }
    const float* x = inp(a, 0); bf16* XB = (bf16*)(ws + WS_XB); float* rinv = (float*)(ws + WS_RINV);
    for (int m = gw; m < M; m += NGW) row_to_bf16_rinv(x + (size_t)m * DM, XB + (size_t)m * DM, rinv + m, F.lane);
}

__device__ __forceinline__ void kmean_phase(Frame& F, const Args& a) {
    const bf16* K = (const bf16*)(a.ws + WS_K); float* KM = (float*)(a.ws + WS_KMEAN);
    for (int u = F.vcu; u < NB * NBLK; u += F.G) {
        const bf16* kp = K + (size_t)u * BLK * AW + F.tid; float s = 0.f;
        for (int t = 0; t < BLK; ++t) s += bf2f(kp[(size_t)t * AW]);
        KM[(size_t)u * AW + F.tid] = s * (1.0f / BLK);
    }
}

__device__ __forceinline__ void norm_phase(Frame& F, const Args& a, int l) {
    const int gw = F.vcu * NWAVES + F.wave, NGW = F.G * NWAVES, lane = F.lane;
    const float* Y = (const float*)(a.ws + WS_Y); const float* xold = (l == 0) ? inp(a, 0) : a.out; const float* gp = inp(a, 2) + l * DM;
    bf16* XB = (bf16*)(a.ws + WS_XB); float* rinv = (float*)(a.ws + WS_RINV);
    f32x4 gv[4];
#pragma unroll
    for (int j = 0; j < 4; ++j) gv[j] = ((const f32x4*)gp)[lane + 64 * j];
    for (int m = gw; m < M; m += NGW) {
        const f32x4* yr = (const f32x4*)(Y + (size_t)m * DM) + lane; const f32x4* xr = (const f32x4*)(xold + (size_t)m * DM) + lane;
        f32x4 y[4], x[4]; float s = 0.f;
#pragma unroll
        for (int j = 0; j < 4; ++j) { y[j] = yr[64 * j]; x[j] = xr[64 * j]; s += (y[j].x * y[j].x + y[j].y * y[j].y) + (y[j].z * y[j].z + y[j].w * y[j].w); }
        const float ry = 1.0f / sqrtf(wave_sum(s) * (1.0f / DM) + RMS_EPS); float s2 = 0.f;
#pragma unroll
        for (int j = 0; j < 4; ++j) { x[j] = x[j] + y[j] * ry * gv[j]; s2 += (x[j].x * x[j].x + x[j].y * x[j].y) + (x[j].z * x[j].z + x[j].w * x[j].w); }
        f32x4* orow = (f32x4*)(a.out + (size_t)m * DM) + lane;
#pragma unroll
        for (int j = 0; j < 4; ++j) orow[64 * j] = x[j];
        if (l == 0) {
            s2 = wave_sum(s2);
            GAS unsigned long long* o8 = (GAS unsigned long long*)(XB + (size_t)m * DM) + lane;
#pragma unroll
            for (int j = 0; j < 4; ++j) o8[64 * j] = (unsigned long long)pk2(x[j].x, x[j].y) | ((unsigned long long)pk2(x[j].z, x[j].w) << 32);
            if (lane == 0) rinv[m] = 1.0f / sqrtf(s2 * (1.0f / DM) + RMS_EPS);
        }
    }
}

__global__ void __launch_bounds__(NWAVES * 64, 2) mk_fwd(Args args) {
    extern __shared__ __attribute__((aligned(16))) unsigned char lds[];
    Frame F;
    F.lds = (LAS unsigned char*)lds;
    F.MISC = (volatile LAS unsigned*)(F.lds + MISC_OFF);
    F.tid = threadIdx.x; F.lane = F.tid & 63; F.wave = __builtin_amdgcn_readfirstlane(F.tid >> 6);
    F.G = gridDim.x; { const int bx = blockIdx.x; F.vcu = (F.G % 8 == 0) ? (bx % 8) * (F.G / 8) + bx / 8 : bx; }
    const int vcu0 = F.vcu;
    unsigned char* ws = args.ws;
    F.ctl = (gu32*)(ws + WS_CTL);
    for (int u = F.tid; u < (LDS_BYTES - LDSCTL_OFF) / 4; u += NWAVES * 64) ((LAS unsigned*)(F.lds + LDSCTL_OFF))[u] = 0u;
    __syncthreads();
    XcdBarrier bar; bar.bar = (unsigned*)(F.ctl + CW_BAR); bar.x = 0; bar.st = nullptr;
    const bool use_bar = (args.ph_hi - args.ph_lo) > 1;
    if (use_bar) bar = xcd_barrier_post((unsigned*)(F.ctl + CW_BAR), F.MISC + 8);

    for (int ph_ = args.ph_lo; ph_ < args.ph_hi; ++ph_) {
        int ph = ph_; asm volatile("" : "+s"(ph));
        { int t_ = threadIdx.x; asm volatile("" : "+v"(t_)); F.tid = t_; F.lane = t_ & 63; F.wave = __builtin_amdgcn_readfirstlane(t_ >> 6); int g_ = gridDim.x, v_ = vcu0; asm volatile("" : "+s"(g_), "+s"(v_)); F.G = g_; F.vcu = v_; }
        if (ph == 0) p0_prologue(F, args);
        else {
            const int l = (ph - 1) / NPH_LAYER, sp = (ph - 1) % NPH_LAYER;
            const float* rinv = (const float*)(ws + WS_RINV);
            pg8::bf16_t* XB = (pg8::bf16_t*)(ws + WS_XB);
            if (sp == 0) {
                pg8::Gemm g{XB, (const pg8::bf16_t*)(ws + WS_WA + l * WA_BYTES), M, NA, DM}; pg8::StaticOrder S; S.init(M, NA, F.G, (int)blockIdx.x);
                pg8::EpiProjA E{rinv, (pg8::bf16_t*)(ws + WS_Q)};
                pg8::gemm_phase<pg8::EpiProjA, pg8::StaticOrder, true, true>(F.lds + RING_OFF, g, S, E);
            } else if (sp == 1) kmean_phase(F, args);
            else if (sp == 2) att::moba_phase(F.tid, F.vcu, F.G, (unsigned short*)(ws + WS_Q), (const unsigned short*)(ws + WS_K), (const unsigned short*)(ws + WS_V), (const unsigned short*)(ws + WS_AZ), (const float*)(ws + WS_KMEAN), (att::lds_cptr)(F.lds + RING_OFF));
            else if (sp >= 3 && sp <= 5) {
                rw7::Ctx C; C.tid = F.tid; C.lane = F.lane; C.wave = F.wave; C.vcu = F.vcu; C.G = F.G; C.layer = l; C.lds = (rw7::ldsp)(F.lds + RING_OFF);
                C.RW = (const rw7::u16*)(ws + WS_RW); C.RZ = (rw7::u16*)(ws + WS_RZ); C.VD = (const rw7::u16*)(ws + WS_VD); C.VF = (rw7::u16*)(ws + WS_VFIRST);
                C.PT = (rw7::u16*)(ws + WS_K); C.QG = (rw7::u16*)(ws + WS_V); C.TT = (rw7::u16*)(ws + WS_AZ); C.SG = (rw7::u16*)(ws + WS_U);
                C.mu = inp(args, 4) + l * RWS; C.w0 = inp(args, 5) + l * AW; C.w_up = inp(args, 6) + (size_t)l * 64 * AW; C.a0 = inp(args, 7) + l * AW; C.a_up = inp(args, 8) + (size_t)l * 64 * AW;
                C.k_k = inp(args, 9) + l * AW; C.k_a = inp(args, 10) + l * AW; C.r_k = inp(args, 11) + l * AW; C.ln_g = inp(args, 12) + l * AW; C.ln_b = inp(args, 13) + l * AW;
                C.vmu = inp(args, 15); C.v_up = inp(args, 16); C.v0 = inp(args, 17);
                if (sp == 3) rw7::pass1(C); else if (sp == 4) rw7::pass2(C); else rw7::pass3(C);
            }
            else if (sp == 6) {
                pg8::Gemm g{XB, (const pg8::bf16_t*)(ws + WS_WB + l * WB_BYTES), M, NBW, DM}; pg8::StaticOrder S; S.init(M, NBW, F.G, (int)blockIdx.x);
                pg8::EpiProjB E{rinv, (pg8::bf16_t*)(ws + WS_GA), (pg8::bf16_t*)(ws + WS_GR)};
                pg8::gemm_phase<pg8::EpiProjB, pg8::StaticOrder, true, true>(F.lds + RING_OFF, g, S, E);
            } else if (sp == 7) {
                pg8::Gemm g{(const pg8::bf16_t*)(ws + WS_Q), (const pg8::bf16_t*)(ws + WS_WUP + l * WUP_BYTES), M, DM, AW}; pg8::StaticOrder S; S.init(M, DM, F.G, (int)blockIdx.x);
                pg8::EpiUp<false> E{(const pg8::bf16_t*)(ws + WS_GA), (pg8::bf16_t*)(ws + WS_U)};
                pg8::gemm_phase<pg8::EpiUp<false>, pg8::StaticOrder, true, true>(F.lds + RING_OFF, g, S, E);
            } else if (sp == 8) {
                pg8::Gemm g{(const pg8::bf16_t*)(ws + WS_RZ), (const pg8::bf16_t*)(ws + WS_WUP + l * WUP_BYTES + (size_t)DM * AW * 2), M, DM, AW}; pg8::StaticOrder S; S.init(M, DM, F.G, (int)blockIdx.x);
                pg8::EpiUp<true> E{(const pg8::bf16_t*)(ws + WS_GR), (pg8::bf16_t*)(ws + WS_U)};
                pg8::gemm_phase<pg8::EpiUp<true>, pg8::StaticOrder, true, true>(F.lds + RING_OFF, g, S, E);
            } else if (sp == 9) {
                pg8::Gemm g{(const pg8::bf16_t*)(ws + WS_U), (const pg8::bf16_t*)(ws + WS_WOUT + l * WOUT_BYTES), M, DM, DM}; pg8::StaticOrder S; S.init(M, DM, F.G, (int)blockIdx.x);
                pg8::EpiF32 E{(float*)(ws + WS_Y), DM};
                pg8::gemm_phase<pg8::EpiF32, pg8::StaticOrder, true, true>(F.lds + RING_OFF, g, S, E);
            } else norm_phase(F, args, l);
        }
        if (ph_ + 1 < args.ph_hi) xcd_barrier(bar);
    }
}

extern "C" void kernel_launch(void* const* d_in, const int* in_sizes, int n_in, void* d_out, int out_size, void* d_ws, size_t ws_size, hipStream_t stream) {
    static int grid = 0;
    if (grid == 0) {
        if (n_in != 21 || in_sizes[0] != M * DM || out_size != M * DM || ws_size < WS_END) { fprintf(stderr, "kernel_launch: unexpected shapes (n_in %d, in0 %d, out %d, ws %zu); nothing launched\n", n_in, n_in > 0 ? in_sizes[0] : -1, out_size, ws_size); grid = -1; return; }
        int dev = 0, cus = 0;
        if (hipGetDevice(&dev) != hipSuccess || hipDeviceGetAttribute(&cus, hipDeviceAttributeMultiprocessorCount, dev) != hipSuccess) { grid = -1; return; }
        if (hipFuncSetAttribute((const void*)mk_fwd, hipFuncAttributeMaxDynamicSharedMemorySize, LDS_BYTES) != hipSuccess) { fprintf(stderr, "kernel_launch: hipFuncSetAttribute failed\n"); grid = -1; return; }
        (void)hipGetLastError();
        grid = cus;
    }
    if (grid < 0) return;
    if (hipMemsetAsync((char*)d_ws + WS_CTL, 0, CTL_ZERO_BYTES, stream) != hipSuccess) return;
    Args a{};
    for (int i = 0; i < 21; ++i) a.in[i] = (const float*)d_in[i];
    a.out = (float*)d_out; a.ws = (unsigned char*)d_ws;
#if MK_SINGLE
    a.ph_lo = 0; a.ph_hi = NPHASE;
    hipLaunchKernelGGL(mk_fwd, dim3(grid), dim3(NWAVES * 64), LDS_BYTES, stream, a);
#else
    for (int p = 0; p < NPHASE; ++p) { a.ph_lo = p; a.ph_hi = p + 1; hipLaunchKernelGGL(mk_fwd, dim3(grid), dim3(NWAVES * 64), LDS_BYTES, stream, a); }
#endif
}
```

```cpp
#ifndef MK_SINGLE
#define MK_SINGLE 1
#endif
#include <hip/hip_runtime.h>
#include <cstdio>
#include <cstdint>
namespace pg8 {
#define PG8_LAS __attribute__((address_space(3)))
typedef unsigned short bf16_t;
typedef short bf16x8 __attribute__((ext_vector_type(8)));
typedef float f32x4 __attribute__((ext_vector_type(4)));
typedef unsigned u32x4 __attribute__((ext_vector_type(4)));
constexpr int BM = 256, BK = 64, HALF = 128, HTB = HALF * BK * 2  , STAGE_BYTES = 8 * HTB, NXCD = 8, WGM = 8;

__host__ __device__ __forceinline__ int lds_byte(int r, int c) { const int st = (r >> 4) * 2 + (c >> 5), rr = r & 15, cc = c & 31, ob = rr * 64 + cc * 2; return st * 1024 + (ob ^ (((ob >> 9) & 1) << 5)); }
__host__ __device__ __forceinline__ void stage_rc(int b, int& R, int& C) { const int st = b / 1024, sb = b % 1024, swz = sb ^ (((sb >> 9) & 1) << 5); R = (st >> 1) * 16 + swz / 64; C = (st & 1) * 32 + (swz % 64) / 2; }
__host__ __device__ __forceinline__ int perm32(int rho) { const int n = rho >> 4, i = rho & 15; return 8 * (i >> 2) + 4 * n + (i & 3); }

struct Unit { int pm, pn; };
struct Gemm { const bf16_t* A; const bf16_t* Bt; int M, N, K; };

struct StaticOrder {
    int nM, nN, nwg, G, c;
    __host__ __device__ void init(int M, int N, int G_, int c_) { nM = M / BM; nN = N / BM; nwg = nM * nN; G = G_; c = c_; }
    __host__ __device__ bool next(int i, Unit& u) const {
        const long L = (long)i * G + c; if (L >= nwg) return false;
        int wgid = (int)L; { const int q = nwg / NXCD, r = nwg % NXCD, xcd = wgid % NXCD, off = wgid / NXCD; wgid = (xcd < r ? xcd * (q + 1) : r * (q + 1) + (xcd - r) * q) + off; }
        const int nig = WGM * nN, gid = wgid / nig, fm = gid * WGM, gsz = (nM - fm) < WGM ? (nM - fm) : WGM;
        u.pm = fm + ((wgid % nig) % gsz); u.pn = (wgid % nig) / gsz; return true;
    }
    __device__ __forceinline__ void a_ready(const Unit&) const {}
    __device__ __forceinline__ void done(const Unit&) const {}
};


__device__ __forceinline__ unsigned cvt_pk_bf16(float lo, float hi) { unsigned r; asm volatile("v_cvt_pk_bf16_f32 %0, %1, %2" : "=v"(r) : "v"(lo), "v"(hi)); return r; }
__device__ __forceinline__ float bf_lo(unsigned w) { return __builtin_bit_cast(float, w << 16); }
__device__ __forceinline__ float bf_hi(unsigned w) { return __builtin_bit_cast(float, w & 0xffff0000u); }
__device__ __forceinline__ float sigmoidf_(float x) { return 1.0f / (1.0f + __expf(-x)); }

struct EpiProjA {
    static constexpr bool PERM = true, AFTER_DRAIN = false;
    const float* rinv; bf16_t* base0;
    __device__ __forceinline__ void operator()(const f32x4 (&acc)[2][2][4][2], const Unit& u, int wr, int wc, int fr, int fq) const {
        const int row0 = u.pm * BM + wr * 64 + fr;
#pragma unroll
        for (int bj = 0; bj < 2; ++bj) {
            const int colw = u.pn * BM + bj * HALF + wc * 32;
            size_t boff; int ld, c;
            if (colw < 2048) { boff = (size_t)(colw >> 9) * (8u << 20); ld = 512; c = colw & 511; }
            else if (colw < 3712) { boff = (size_t)5 * (8u << 20); ld = 1664; c = colw - 2048; }
            else if (colw < 4224) { boff = (size_t)4 * (8u << 20); ld = 512; c = colw - 3712; }
            else if (colw < 4256) { boff = (size_t)5 * (8u << 20) + (size_t)26 * (1u << 20); ld = 32; c = colw - 4224; }
            else continue;
            bf16_t* base = base0 + boff + c + 8 * fq;
            const float qs = colw < 512 ? 0.18033688011112042f : 1.0f;
#pragma unroll
            for (int ai = 0; ai < 2; ++ai)
#pragma unroll
                for (int m = 0; m < 4; ++m) {
                    const int row = row0 + ai * HALF + m * 16; const float rs = rinv[row] * qs;
                    const f32x4 v0 = acc[ai][bj][m][0] * rs, v1 = acc[ai][bj][m][1] * rs;
                    u32x4 w; w.x = cvt_pk_bf16(v0[0], v0[1]); w.y = cvt_pk_bf16(v0[2], v0[3]); w.z = cvt_pk_bf16(v1[0], v1[1]); w.w = cvt_pk_bf16(v1[2], v1[3]);
                    *(u32x4*)(base + (size_t)row * ld) = w;
                }
        }
    }
};
struct EpiProjB {
    static constexpr bool PERM = true, AFTER_DRAIN = false;
    const float* rinv; bf16_t *GA, *GR;
    __device__ __forceinline__ void operator()(const f32x4 (&acc)[2][2][4][2], const Unit& u, int wr, int wc, int fr, int fq) const {
        const int row0 = u.pm * BM + wr * 64 + fr;
#pragma unroll
        for (int bj = 0; bj < 2; ++bj) {
            const int colw = u.pn * BM + bj * HALF + wc * 32;
            bf16_t* base = (colw < 1024 ? GA : GR) + (colw & 1023) + 8 * fq;
#pragma unroll
            for (int ai = 0; ai < 2; ++ai)
#pragma unroll
                for (int m = 0; m < 4; ++m) {
                    const int row = row0 + ai * HALF + m * 16; const float rs = rinv[row];
                    f32x4 v0 = acc[ai][bj][m][0] * rs, v1 = acc[ai][bj][m][1] * rs;
#pragma unroll
                    for (int e = 0; e < 4; ++e) { v0[e] = sigmoidf_(v0[e]); v1[e] = sigmoidf_(v1[e]); }
                    u32x4 w; w.x = cvt_pk_bf16(v0[0], v0[1]); w.y = cvt_pk_bf16(v0[2], v0[3]); w.z = cvt_pk_bf16(v1[0], v1[1]); w.w = cvt_pk_bf16(v1[2], v1[3]);
                    *(u32x4*)(base + (size_t)row * 1024) = w;
                }
        }
    }
};
template <bool ADD> struct EpiUp {
    static constexpr bool PERM = true, AFTER_DRAIN = false;
    const bf16_t* G; bf16_t* U;
    __device__ __forceinline__ void operator()(const f32x4 (&acc)[2][2][4][2], const Unit& u, int wr, int wc, int fr, int fq) const {
        const int row0 = u.pm * BM + wr * 64 + fr;
#pragma unroll
        for (int bj = 0; bj < 2; ++bj) {
            const int c = u.pn * BM + bj * HALF + wc * 32 + 8 * fq;
#pragma unroll
            for (int ai = 0; ai < 2; ++ai)
#pragma unroll
                for (int m = 0; m < 4; ++m) {
                    const size_t off = (size_t)(row0 + ai * HALF + m * 16) * 1024 + c;
                    const u32x4 g = *(const u32x4*)(G + off);
                    f32x4 v0 = acc[ai][bj][m][0], v1 = acc[ai][bj][m][1];
                    v0[0] *= bf_lo(g.x); v0[1] *= bf_hi(g.x); v0[2] *= bf_lo(g.y); v0[3] *= bf_hi(g.y);
                    v1[0] *= bf_lo(g.z); v1[1] *= bf_hi(g.z); v1[2] *= bf_lo(g.w); v1[3] *= bf_hi(g.w);
                    if (ADD) { const u32x4 p = *(const u32x4*)(U + off);
                        v0[0] += bf_lo(p.x); v0[1] += bf_hi(p.x); v0[2] += bf_lo(p.y); v0[3] += bf_hi(p.y);
                        v1[0] += bf_lo(p.z); v1[1] += bf_hi(p.z); v1[2] += bf_lo(p.w); v1[3] += bf_hi(p.w); }
                    u32x4 w; w.x = cvt_pk_bf16(v0[0], v0[1]); w.y = cvt_pk_bf16(v0[2], v0[3]); w.z = cvt_pk_bf16(v1[0], v1[1]); w.w = cvt_pk_bf16(v1[2], v1[3]);
                    *(u32x4*)(U + off) = w;
                }
        }
    }
};
struct EpiF32 {
    static constexpr bool PERM = false, AFTER_DRAIN = false;
    float* O; int ldc;
    __device__ __forceinline__ void operator()(const f32x4 (&acc)[2][2][4][2], const Unit& u, int wr, int wc, int fr, int fq) const {
        const int row0 = u.pm * BM + wr * 64 + fr, col0 = u.pn * BM + wc * 32 + 4 * fq;
#pragma unroll
        for (int ai = 0; ai < 2; ++ai)
#pragma unroll
            for (int m = 0; m < 4; ++m) { float* rowp = O + (size_t)(row0 + ai * HALF + m * 16) * ldc + col0;
#pragma unroll
                for (int bj = 0; bj < 2; ++bj)
#pragma unroll
                    for (int n = 0; n < 2; ++n) *(f32x4*)(rowp + bj * HALF + n * 16) = acc[ai][bj][m][n]; }
    }
};
template <class Epi, class Sched, bool ALIGN_EPI = false, bool SP2 = false>
__device__ __forceinline__ void gemm_phase(PG8_LAS unsigned char* lds, const Gemm g, const Sched& S, const Epi& E) {
    int tid_o = threadIdx.x; asm volatile("" : "+v"(tid_o));
    const int tid = tid_o, wid = __builtin_amdgcn_readfirstlane(tid >> 6), lane = tid & 63, wr = wid >> 2, wc = wid & 3, fr = lane & 15, fq = lane >> 4;
    const int K = g.K, nt = K / BK;
    unsigned voffA[2], voffB[2];
#pragma unroll
    for (int i = 0; i < 2; ++i) { int R, C; stage_rc(tid * 16 + i * 8192, R, C); const int Rb = Epi::PERM ? ((R & ~31) + perm32(R & 31)) : R;
        voffA[i] = (unsigned)(R * K + C) * 2u; voffB[i] = (unsigned)(Rb * K + C) * 2u; }
    const size_t kstep = (size_t)(BK * 2);
    const size_t hstep = (size_t)HALF * K * 2;
    const size_t tstep = 2 * hstep;
    const unsigned ldsw = (unsigned)wid * 1024u;
    const int aoff = lds_byte(wr * 64 + fr, fq * 8), boff = lds_byte(wc * 32 + fr, fq * 8);
#define PG8_SA(b, h) (((b) * 2 + (h)) * HTB)
#define PG8_SB(b, h) ((4 + (b) * 2 + (h)) * HTB)
#define PG8_STAGE(bufoff, gbase, voff) do { _Pragma("unroll") for (int _i = 0; _i < 2; ++_i) \
        __builtin_amdgcn_global_load_lds((const unsigned*)((const char*)(gbase) + (voff)[_i]), (PG8_LAS unsigned*)(lds + (bufoff) + ldsw + _i * 8192), 16, 0, 0); } while (0)
#define PG8_LDA(dst, b, h) do { _Pragma("unroll") for (int m = 0; m < 4; ++m) _Pragma("unroll") for (int k = 0; k < 2; ++k) dst[m][k] = *(const PG8_LAS bf16x8*)(lds + PG8_SA(b, h) + aoff + m * 2048 + k * 1024); } while (0)
#define PG8_LDB(dst, b, h) do { _Pragma("unroll") for (int n = 0; n < 2; ++n) _Pragma("unroll") for (int k = 0; k < 2; ++k) dst[n][k] = *(const PG8_LAS bf16x8*)(lds + PG8_SB(b, h) + boff + n * 2048 + k * 1024); } while (0)
#define PG8_MMA(ai, bj, At, Bt) do { __builtin_amdgcn_s_setprio(1); _Pragma("unroll") for (int m = 0; m < 4; ++m) _Pragma("unroll") for (int n = 0; n < 2; ++n) _Pragma("unroll") for (int k = 0; k < 2; ++k) \
        acc[ai][bj][m][n] = __builtin_amdgcn_mfma_f32_16x16x32_bf16(Bt[n][k], At[m][k], acc[ai][bj][m][n], 0, 0, 0); __builtin_amdgcn_s_setprio(0); } while (0)
#define PG8_WAIT_V(n) asm volatile("s_waitcnt vmcnt(" #n ")" ::: "memory")
#define PG8_WAIT_L(n) asm volatile("s_waitcnt lgkmcnt(" #n ")" ::: "memory")
#define PG8_BAR __builtin_amdgcn_s_barrier()
#define PG8_SCHED __builtin_amdgcn_sched_barrier(0)
    Unit cur, nxt; int ui = 0;
    if (!S.next(0, cur)) return;
    f32x4 acc[2][2][4][2];
#pragma unroll
    for (int a = 0; a < 2; ++a)
#pragma unroll
        for (int b = 0; b < 2; ++b)
#pragma unroll
            for (int m = 0; m < 4; ++m)
#pragma unroll
                for (int n = 0; n < 2; ++n) acc[a][b][m][n] = (f32x4){0.f, 0.f, 0.f, 0.f};
    bf16x8 At[4][2], B0[2][2], B1[2][2];
    const char* cA = (const char*)g.A + (size_t)cur.pm * tstep; const char* cB = (const char*)g.Bt + (size_t)cur.pn * tstep;
    S.a_ready(cur);
    if constexpr (SP2) {
        PG8_STAGE(PG8_SB(0, 0), cB, voffB); PG8_STAGE(PG8_SB(0, 1), cB + hstep, voffB); PG8_STAGE(PG8_SA(0, 0), cA, voffA); PG8_STAGE(PG8_SA(0, 1), cA + hstep, voffA);
        if (wr == 1) PG8_BAR;
        PG8_WAIT_V(2); PG8_BAR;
        PG8_STAGE(PG8_SB(1, 0), cB + kstep, voffB); PG8_STAGE(PG8_SA(1, 0), cA + kstep, voffA); PG8_STAGE(PG8_SB(1, 1), cB + hstep + kstep, voffB);
        PG8_WAIT_V(6); PG8_BAR;
    } else {
        PG8_STAGE(PG8_SB(0, 0), cB, voffB); PG8_STAGE(PG8_SA(0, 0), cA, voffA); PG8_STAGE(PG8_SB(0, 1), cB + hstep, voffB); PG8_STAGE(PG8_SA(0, 1), cA + hstep, voffA);
        if (wr == 1) PG8_BAR;
        PG8_WAIT_V(4); PG8_BAR;
        PG8_STAGE(PG8_SB(1, 0), cB + kstep, voffB); PG8_STAGE(PG8_SA(1, 0), cA + kstep, voffA); PG8_STAGE(PG8_SB(1, 1), cB + hstep + kstep, voffB);
        PG8_WAIT_V(6); PG8_BAR;
    }
    for (;;) {
        const bool has_next = S.next(ui + 1, nxt);
        const char* nA = has_next ? (const char*)g.A + (size_t)nxt.pm * tstep : cA; const char* nB = has_next ? (const char*)g.Bt + (size_t)nxt.pn * tstep : cB;
        for (int t = 0; t < nt; t += 2) {
            const bool last = (t == nt - 2);
            const char* a1 = cA + (size_t)(t + 1) * kstep;
            const char* a2 = last ? nA : cA + (size_t)(t + 2) * kstep; const char* b2 = last ? nB : cB + (size_t)(t + 2) * kstep;
            const char* a3 = a2 + kstep; const char* b3 = b2 + kstep;
            if (last && has_next) S.a_ready(nxt);
            if constexpr (SP2) {
            PG8_LDB(B0, 0, 0); PG8_LDB(B1, 0, 1); PG8_SCHED; PG8_LDA(At, 0, 0); PG8_STAGE(PG8_SA(1, 1), a1 + hstep, voffA);
            PG8_WAIT_V(8); PG8_WAIT_L(0); PG8_BAR; PG8_MMA(0, 0, At, B0); PG8_MMA(0, 1, At, B1); PG8_BAR; PG8_SCHED;
            PG8_LDA(At, 0, 1); PG8_STAGE(PG8_SB(0, 0), b2, voffB); PG8_STAGE(PG8_SB(0, 1), b2 + hstep, voffB); PG8_STAGE(PG8_SA(0, 0), a2, voffA);
            PG8_WAIT_V(8); PG8_WAIT_L(0); PG8_BAR; PG8_MMA(1, 0, At, B0); PG8_MMA(1, 1, At, B1); PG8_BAR; PG8_SCHED;
            PG8_LDB(B0, 1, 0); PG8_LDB(B1, 1, 1); PG8_SCHED; PG8_LDA(At, 1, 0); PG8_STAGE(PG8_SA(0, 1), a2 + hstep, voffA);
            PG8_WAIT_V(8); PG8_WAIT_L(0); PG8_BAR; PG8_MMA(0, 0, At, B0); PG8_MMA(0, 1, At, B1); PG8_BAR; PG8_SCHED;
            PG8_LDA(At, 1, 1); PG8_STAGE(PG8_SB(1, 0), b3, voffB); PG8_STAGE(PG8_SB(1, 1), b3 + hstep, voffB); PG8_STAGE(PG8_SA(1, 0), a3, voffA);
            PG8_WAIT_V(8); PG8_WAIT_L(0); PG8_BAR; PG8_MMA(1, 0, At, B0); PG8_MMA(1, 1, At, B1); PG8_BAR; PG8_SCHED;
            } else {
            PG8_LDB(B0, 0, 0); PG8_SCHED; PG8_LDA(At, 0, 0); PG8_STAGE(PG8_SA(1, 1), a1 + hstep, voffA);
            PG8_WAIT_L(8); PG8_BAR; PG8_WAIT_L(0); PG8_MMA(0, 0, At, B0); PG8_BAR; PG8_SCHED;
            PG8_LDB(B1, 0, 1); PG8_STAGE(PG8_SB(0, 0), b2, voffB);
            PG8_BAR; PG8_WAIT_L(0); PG8_MMA(0, 1, At, B1); PG8_BAR;
            PG8_LDA(At, 0, 1); PG8_STAGE(PG8_SA(0, 0), a2, voffA);
            PG8_BAR; PG8_WAIT_L(0); PG8_MMA(1, 0, At, B0); PG8_BAR; PG8_SCHED;
            PG8_STAGE(PG8_SB(0, 1), b2 + hstep, voffB);
            PG8_WAIT_V(6); PG8_BAR; PG8_MMA(1, 1, At, B1); PG8_BAR;
            PG8_LDB(B0, 1, 0); PG8_SCHED; PG8_LDA(At, 1, 0); PG8_STAGE(PG8_SA(0, 1), a2 + hstep, voffA);
            PG8_WAIT_L(8); PG8_BAR; PG8_WAIT_L(0); PG8_MMA(0, 0, At, B0); PG8_BAR; PG8_SCHED;
            PG8_LDB(B1, 1, 1); PG8_STAGE(PG8_SB(1, 0), b3, voffB);
            PG8_BAR; PG8_WAIT_L(0); PG8_MMA(0, 1, At, B1); PG8_BAR;
            PG8_LDA(At, 1, 1); PG8_STAGE(PG8_SA(1, 0), a3, voffA);
            PG8_BAR; PG8_WAIT_L(0); PG8_MMA(1, 0, At, B0); PG8_BAR; PG8_SCHED;
            PG8_STAGE(PG8_SB(1, 1), b3 + hstep, voffB);
            PG8_WAIT_V(6); PG8_BAR; PG8_MMA(1, 1, At, B1); PG8_BAR;
            }
        }
        if constexpr (ALIGN_EPI) { if (wr == 0) PG8_BAR; }
        if constexpr (!Epi::AFTER_DRAIN) { E(acc, cur, wr, wc, fr, fq); S.done(cur); }
        if (!has_next) break;
#pragma unroll
        for (int a = 0; a < 2; ++a)
#pragma unroll
            for (int b = 0; b < 2; ++b)
#pragma unroll
                for (int m = 0; m < 4; ++m)
#pragma unroll
                    for (int n = 0; n < 2; ++n) acc[a][b][m][n] = (f32x4){0.f, 0.f, 0.f, 0.f};
        cur = nxt; cA = nA; cB = nB; ++ui;
        if constexpr (ALIGN_EPI) { if (wr == 1) PG8_BAR; }
    }
    PG8_WAIT_V(0);
    if constexpr (!ALIGN_EPI) { if (wr == 0) PG8_BAR; }
    PG8_BAR;
    if constexpr (Epi::AFTER_DRAIN) { E.fused(acc, cur, wr, wc, fr, fq, lds, wid, lane); S.done(cur); }
#undef PG8_SA
#undef PG8_SB
#undef PG8_STAGE
#undef PG8_LDA
#undef PG8_LDB
#undef PG8_MMA
#undef PG8_WAIT_V
#undef PG8_WAIT_L
#undef PG8_BAR
#undef PG8_SCHED
}
}
#define GAS __attribute__((address_space(1)))
#define LAS __attribute__((address_space(3)))
typedef unsigned short bf16;
typedef unsigned v4u __attribute__((ext_vector_type(4)));
typedef float f32x4 __attribute__((ext_vector_type(4)));
typedef short bf16x8 __attribute__((ext_vector_type(8)));
typedef GAS unsigned gu32;
typedef GAS unsigned long long gu64;
#define RLX_AGENT __ATOMIC_RELAXED, __HIP_MEMORY_SCOPE_AGENT
#define LDS_WAIT() asm volatile("s_waitcnt lgkmcnt(0)" ::: "memory")
#define VM_WAIT() asm volatile("s_waitcnt vmcnt(0)" ::: "memory")
__device__ __forceinline__ unsigned long long rt() { return __builtin_amdgcn_s_memrealtime(); }
__device__ __forceinline__ unsigned f2bf(float f) { unsigned u = __builtin_bit_cast(unsigned, f); return (u + 0x7fffu + ((u >> 16) & 1u)) >> 16; }
__device__ __forceinline__ unsigned pk2(float lo, float hi) { return f2bf(lo) | (f2bf(hi) << 16); }

#define XB_TMO      128
#define XB_XCNT(j)  (256  + 64 * (j))
#define XB_XSUB(j)  (1280 + 64 * (j))
#define XB_XGEN(j)  (2304 + 64 * (j))
#define XB_TOP      3328
#define XB_TOPGEN   3392
#define XCD_BAR_WORDS 3456
#define XB_SPIN_CAP (1u << 18)

__device__ __forceinline__ unsigned xb_ld(unsigned* p)              { return __hip_atomic_load(p, __ATOMIC_RELAXED, __HIP_MEMORY_SCOPE_AGENT); }
__device__ __forceinline__ unsigned xb_add(unsigned* p, unsigned v) { return __hip_atomic_fetch_add(p, v, __ATOMIC_RELAXED, __HIP_MEMORY_SCOPE_AGENT); }
__device__ __forceinline__ unsigned xb_xcc_id() { return (unsigned)__builtin_amdgcn_s_getreg((3 << 11) | 20) & 0xFu; }
#define XB_SPIN(cond, bar) do { unsigned _sp = 0; while (cond) { __builtin_amdgcn_s_sleep(1); \
    if ((++_sp & 255u) == 0u) { if (xb_ld(&(bar)[XB_TMO])) break; if (_sp > XB_SPIN_CAP) { atomicAdd(&(bar)[XB_TMO], 1u); break; } } } } while (0)

struct XcdBarrier {
    unsigned* bar; unsigned x;
    volatile LAS unsigned* st;
};

__device__ __forceinline__ XcdBarrier xcd_barrier_post(unsigned* bar, volatile LAS unsigned* st) {
    XcdBarrier b; b.bar = bar; b.x = xb_xcc_id(); b.st = st;
    if (threadIdx.x == 0) (void)xb_add(&bar[XB_XCNT(b.x)], 1u);
    return b;
}
__device__ __forceinline__ void xcd_barrier_complete(unsigned* bar, unsigned x, unsigned& nloc, unsigned& nx) {
    const unsigned G = gridDim.x * gridDim.y * gridDim.z;
    unsigned sum, cnt, mine, sp = 0u;
    for (;;) {
        sum = 0u; cnt = 0u; mine = 0u;
#pragma unroll
        for (unsigned j = 0; j < 16; ++j) { const unsigned c = xb_ld(&bar[XB_XCNT(j)]); sum += c; cnt += (c > 0u) ? 1u : 0u; mine = (j == x) ? c : mine; }
        if (sum == G) break;
        __builtin_amdgcn_s_sleep(1);
        if ((++sp & 255u) == 0u) { if (xb_ld(&bar[XB_TMO])) break; if (sp > XB_SPIN_CAP) { atomicAdd(&bar[XB_TMO], 1u); break; } }
    }
    nloc = mine > 0u ? mine : 1u; nx = cnt > 0u ? cnt : 1u;
}

__device__ __forceinline__ void xcd_barrier(const XcdBarrier& b) {
    asm volatile("s_waitcnt vmcnt(0)" ::: "memory");
    __syncthreads();
    if (threadIdx.x == 0) {
        unsigned* bar = b.bar; asm volatile("" : "+s"(bar));
        __builtin_amdgcn_s_waitcnt(0);
        unsigned nloc = b.st[0], nx = b.st[1];
        if (nloc == 0u) { xcd_barrier_complete(bar, b.x, nloc, nx); b.st[0] = nloc; b.st[1] = nx; }
        const unsigned old = xb_add(&bar[XB_XSUB(b.x)], 1u);
        const unsigned gen = old / nloc;
        if (old + 1u == (gen + 1u) * nloc) {
            __builtin_amdgcn_fence(__ATOMIC_RELEASE, "agent");
            asm volatile("s_waitcnt vmcnt(0)" ::: "memory");
            const unsigned og = xb_add(&bar[XB_TOP], 1u);
            const unsigned tg = og / nx;
            if (og + 1u == (tg + 1u) * nx) xb_add(&bar[XB_TOPGEN], 1u);
            else XB_SPIN(xb_ld(&bar[XB_TOPGEN]) == tg, bar);
            __builtin_amdgcn_fence(__ATOMIC_ACQUIRE, "agent");
            xb_add(&bar[XB_XGEN(b.x)], 1u);
            asm volatile("s_waitcnt vmcnt(0)" ::: "memory");
        } else {
            XB_SPIN(xb_ld(&bar[XB_XGEN(b.x)]) == gen, bar);
            __builtin_amdgcn_fence(__ATOMIC_ACQUIRE, "agent");
            asm volatile("s_waitcnt vmcnt(0)" ::: "memory");
        }
    }
    __syncthreads();
}
__device__ __forceinline__ float bf_lo_(unsigned w) { return __builtin_bit_cast(float, w << 16); }
__device__ __forceinline__ float bf_hi_(unsigned w) { return __builtin_bit_cast(float, w & 0xffff0000u); }

constexpr int NWAVES = 8;
constexpr int NB = 8, SEQ = 2048, DM = 1024, M = NB * SEQ;
constexpr int NH = 8, HD = 64, AW = 512;
constexpr int RWS = 1664;
constexpr int DIN = 6272;
constexpr int NA = 4352, NBW = 2048;
constexpr int BLK = 256, NBLK = SEQ / BLK, TOPK = 3;
constexpr float RMS_EPS = 1e-6f, GN_EPS = 64e-5f;
#ifndef MK_SINGLE
#define MK_SINGLE 0
#endif
constexpr int NPH_LAYER = 11, NPHASE = 1 + 2 * NPH_LAYER;

constexpr size_t MiB = 1u << 20;
constexpr size_t WS_CTL = 0, CTL_ZERO_BYTES = 64 * 1024;
constexpr size_t WS_RINV = 1 * MiB, WS_KMEAN = 1 * MiB + 256 * 1024;
constexpr size_t WS_WA = 2 * MiB, WA_BYTES = (size_t)NA * DM * 2;
constexpr size_t WS_WB = 19 * MiB, WB_BYTES = (size_t)NBW * DM * 2;
constexpr size_t WS_WUP = 27 * MiB, WUP_BYTES = 2 * MiB;
constexpr size_t WS_WOUT = 31 * MiB, WOUT_BYTES = 2 * MiB;
constexpr size_t WS_XB = 35 * MiB, WS_VFIRST = 67 * MiB, WS_U = 83 * MiB;
constexpr size_t WS_Q = 115 * MiB, WS_K = 131 * MiB, WS_V = 147 * MiB, WS_AZ = 163 * MiB, WS_RZ = 179 * MiB, WS_RW = 195 * MiB, WS_VD = 247 * MiB;
static_assert(WS_K - WS_Q == 16 * MiB && WS_V - WS_Q == 32 * MiB && WS_AZ - WS_Q == 48 * MiB && WS_RZ - WS_Q == 64 * MiB && WS_RW - WS_Q == 80 * MiB && WS_VD - WS_RW == 52 * MiB, "EpiProjA routing offsets");
constexpr size_t WS_GA = WS_K, WS_GR = WS_RW, WS_Y = WS_Q, WS_END = 248 * MiB;
constexpr int CW_BAR = 1024;

constexpr int RING_OFF = 0, RING_BYTES = 158720;
constexpr int LDSCTL_OFF = RING_BYTES, MISC_OFF = LDSCTL_OFF + 320;
constexpr int LDS_BYTES = 163840;

struct Frame {
    LAS unsigned char* lds;
    volatile LAS unsigned* MISC;
    gu32* ctl;
    int tid, lane, wave, vcu, G;
};
__device__ __forceinline__ float wave_sum(float v) {
#pragma unroll
    for (int o = 1; o < 64; o <<= 1) v += __shfl_xor(v, o);
    return v;
}
__device__ __forceinline__ float wave_max(float v) {
#pragma unroll
    for (int o = 1; o < 64; o <<= 1) v = fmaxf(v, __shfl_xor(v, o));
    return v;
}
__device__ __forceinline__ float bf2f(bf16 v) { return __builtin_bit_cast(float, (unsigned)v << 16); }
__device__ __forceinline__ float rl(float v, int l) { return __builtin_bit_cast(float, __builtin_amdgcn_readlane(__builtin_bit_cast(int, v), l)); }

struct Args { const float* in[21]; float* out; unsigned char* ws; int ph_lo, ph_hi; };
__device__ __forceinline__ const float* inp(const Args& a, int i) { asm volatile("" : "+s"(i)); return a.in[i]; }


namespace att {
typedef short bf16x8 __attribute__((ext_vector_type(8)));
typedef short s16x4 __attribute__((ext_vector_type(4)));
typedef float f32x16 __attribute__((ext_vector_type(16)));
typedef unsigned u32x4 __attribute__((ext_vector_type(4)));
typedef __attribute__((address_space(3))) const char* lds_cptr;
constexpr int AW_ = 512, SLOTB = 8192;
constexpr int L_K = 0, L_V = 2 * SLOTB, L_WS = 4 * SLOTB, L_OST = L_WS + 8 * 256, L_BYTES = L_OST + 8 * 4096;
constexpr float LOG2E = 1.4426950408889634f, C2 = 0.125f * LOG2E;
__device__ __forceinline__ int crow(int r, int hi) { return (r & 3) + 8 * (r >> 2) + 4 * hi; }
__device__ __forceinline__ void glds16(const void* gsrc, unsigned lds_dst) { unsigned keep;
    asm volatile("s_mov_b32 %0, m0\n\ts_mov_b32 m0, %2\n\ts_nop 0\n\tglobal_load_lds_dwordx4 %1, off\n\ts_mov_b32 m0, %0" : "=&s"(keep) : "v"(gsrc), "s"(lds_dst) : "memory"); }
typedef float f32x2_t __attribute__((ext_vector_type(2))); typedef __bf16 bf16x2_t __attribute__((ext_vector_type(2)));
__device__ __forceinline__ unsigned cvtpk_s(float lo, float hi) { f32x2_t v = {lo, hi}; bf16x2_t b = __builtin_convertvector(v, bf16x2_t); return __builtin_bit_cast(unsigned, b); }
__device__ __forceinline__ void qkt(f32x16& p0, f32x16& p1, lds_cptr Kslot, const bf16x8* qr, int r32, int hi) {
    lds_cptr kb = Kslot + hi * 1024 + r32 * 16;
    const f32x16 z = {};
#pragma unroll
    for (int d0 = 0; d0 < 4; ++d0) {
        const bf16x8 b0 = *(const __attribute__((address_space(3))) bf16x8*)(kb + d0 * 2048);
        const bf16x8 b1 = *(const __attribute__((address_space(3))) bf16x8*)(kb + d0 * 2048 + 512);
        if (d0 == 0) { p0 = __builtin_amdgcn_mfma_f32_32x32x16_bf16(b0, qr[0], z, 0, 0, 0); p1 = __builtin_amdgcn_mfma_f32_32x32x16_bf16(b1, qr[0], z, 0, 0, 0); }
        else { p0 = __builtin_amdgcn_mfma_f32_32x32x16_bf16(b0, qr[d0], p0, 0, 0, 0); p1 = __builtin_amdgcn_mfma_f32_32x32x16_bf16(b1, qr[d0], p1, 0, 0, 0); } }
}
__device__ __forceinline__ void pv(f32x16* o, int vb, bf16x8 pa0, bf16x8 pa1, bf16x8 pa2, bf16x8 pa3) {
#pragma unroll
    for (int d0 = 0; d0 < 2; ++d0) { s16x4 lo[4], hi[4];
#pragma unroll
        for (int ks = 0; ks < 4; ++ks) {
            asm volatile("ds_read_b64_tr_b16 %0,%1 offset:%c2" : "=&v"(lo[ks]) : "v"(vb), "i"(d0 * 4096 + ks * 1024) : "memory");
            asm volatile("ds_read_b64_tr_b16 %0,%1 offset:%c2" : "=&v"(hi[ks]) : "v"(vb), "i"(d0 * 4096 + ks * 1024 + 512) : "memory"); }
        asm volatile("s_waitcnt lgkmcnt(0)" ::: "memory"); __builtin_amdgcn_sched_barrier(0);
#define ATT_PK(k) (bf16x8){lo[k][0], lo[k][1], lo[k][2], lo[k][3], hi[k][0], hi[k][1], hi[k][2], hi[k][3]}
        o[d0] = __builtin_amdgcn_mfma_f32_32x32x16_bf16(pa0, ATT_PK(0), o[d0], 0, 0, 0);
        o[d0] = __builtin_amdgcn_mfma_f32_32x32x16_bf16(pa1, ATT_PK(1), o[d0], 0, 0, 0);
        o[d0] = __builtin_amdgcn_mfma_f32_32x32x16_bf16(pa2, ATT_PK(2), o[d0], 0, 0, 0);
        o[d0] = __builtin_amdgcn_mfma_f32_32x32x16_bf16(pa3, ATT_PK(3), o[d0], 0, 0, 0);
#undef ATT_PK
    }
}
__device__ __forceinline__ float swapmax(float m) { auto rr = __builtin_amdgcn_permlane32_swap(__float_as_uint(m), __float_as_uint(m), false, false); return fmaxf(__uint_as_float(rr[0]), __uint_as_float(rr[1])); }
__device__ __forceinline__ float swapadd(float m) { auto rr = __builtin_amdgcn_permlane32_swap(__float_as_uint(m), __float_as_uint(m), false, false); return __uint_as_float(rr[0]) + __uint_as_float(rr[1]); }

__device__ __forceinline__ void moba_unit(int tid, int b, int h, int qblk, unsigned short* Qb, const unsigned short* Kb, const unsigned short* Vb, const unsigned short* AZb, const float* KM, lds_cptr shm3, bool dry = false) {
    const int lane = tid & 63, r32 = lane & 31, hi = lane >> 5; const int wid = __builtin_amdgcn_readfirstlane(tid >> 6);
    const long rowbase = (long)b * 2048; const int q0 = qblk * 256 + wid * 32, qpos = q0 + r32;
    const unsigned short* Qw = Qb + (rowbase + q0) * AW_ + h * 64;
    const unsigned short* Kh = Kb + rowbase * AW_ + h * 64; const unsigned short* Vh = Vb + rowbase * AW_ + h * 64;
    const unsigned lds0 = (unsigned)(size_t)shm3;
    __attribute__((address_space(3))) float* wsf = (__attribute__((address_space(3))) float*)(shm3 + L_WS) + wid * 64;
    const unsigned short* ksrc = Kh + (long)lane * AW_ + wid * 8;
    const unsigned short* vsrc = Vh + (long)(16 * (wid & 3) + (lane >> 2)) * AW_ + (wid >> 2) * 32 + (lane & 3) * 8;
    const unsigned kdst = lds0 + L_K + wid * 1024, vdst = lds0 + L_V + wid * 1024;
    const int vb0 = (int)(lds0 + L_V) + ((lane >> 4) & 1) * 32 + (lane & 3) * 8 + (4 * hi + ((lane & 15) >> 2)) * 64;
    const int NT = 4 * (qblk + 1);
#define ATT_BASE(s) ((s) < 4 ? qblk * 256 + 64 * (s) : (qblk - 1 - (((s) - 4) >> 2)) * 256 + 64 * (((s) - 4) & 3))
    { const int kb0 = ATT_BASE(0); glds16(ksrc + (long)kb0 * AW_, (unsigned)__builtin_amdgcn_readfirstlane(kdst)); glds16(vsrc + (long)kb0 * AW_, (unsigned)__builtin_amdgcn_readfirstlane(vdst)); }
    bf16x8 qr[4];
#pragma unroll
    for (int d0 = 0; d0 < 4; ++d0) qr[d0] = *reinterpret_cast<const bf16x8*>(&Qw[(long)r32 * AW_ + d0 * 16 + hi * 8]);
    unsigned selmask = 0u;
    if (qblk > 0) {
        float g[8];
#pragma unroll
        for (int j = 0; j < 8; ++j) { g[j] = 0.f;
            if (j < qblk) { const float* km = KM + ((long)(b * 8 + j)) * AW_ + h * 64 + hi * 8;
#pragma unroll
                for (int d0 = 0; d0 < 4; ++d0) { const f32x4 a0 = *(const f32x4*)(km + d0 * 16), a1 = *(const f32x4*)(km + d0 * 16 + 4);
#pragma unroll
                    for (int e = 0; e < 4; ++e) { g[j] += __builtin_bit_cast(float, (unsigned)(unsigned short)qr[d0][e] << 16) * a0[e]; g[j] += __builtin_bit_cast(float, (unsigned)(unsigned short)qr[d0][4 + e] << 16) * a1[e]; } }
                g[j] = swapadd(g[j]); }
            else g[j] = -1e30f; }
#pragma unroll
        for (int j = 0; j < 8; ++j) { int rank = 0;
#pragma unroll
            for (int i = 0; i < 8; ++i) rank += (g[i] > g[j] || (g[i] == g[j] && i < j)) ? 1 : 0;
            if (rank < 3 && j < qblk) selmask |= 1u << j; }
    }
    const float cb = exp2f(-(float)(h + 1)) * LOG2E;
    float mrun = -1e30f, l_reg = 0.f; f32x16 o[2]; o[0] = f32x16{}; o[1] = f32x16{};
    for (int s = 0; s < NT; ++s) {
        asm volatile("s_waitcnt vmcnt(0) lgkmcnt(0)\n\ts_barrier" ::: "memory");
        if (s + 1 < NT) { const int kb1 = ATT_BASE(s + 1); const unsigned so = ((s + 1) & 1) * SLOTB;
            glds16(ksrc + (long)kb1 * AW_, (unsigned)__builtin_amdgcn_readfirstlane(kdst + so)); glds16(vsrc + (long)kb1 * AW_, (unsigned)__builtin_amdgcn_readfirstlane(vdst + so)); }
        const int base = ATT_BASE(s); const bool own = s < 4; const int j = own ? qblk : (qblk - 1 - ((s - 4) >> 2));
        const bool mine = own ? true : (((selmask >> j) & 1u) != 0u);
        const bool skip = own ? (base > q0 + 31) : !__any(mine);
        if (skip) continue;
        const int slot = (s & 1) * SLOTB;
        f32x16 p0, p1;
        qkt(p0, p1, shm3 + L_K + slot, qr, r32, hi);
        const float fb = cb * (float)(base + 4 * hi - qpos);
        float rm = -1e30f;
#pragma unroll
        for (int r = 0; r < 16; ++r) { const int ko = (r & 3) + 8 * (r >> 2); const int kv = base + 4 * hi + ko;
            float s0 = p0[r] + (fb + cb * (float)ko), s1 = p1[r] + (fb + cb * (float)(ko + 32));
            if (own) { if (kv > qpos) s0 = -1e30f; if (kv + 32 > qpos) s1 = -1e30f; } else if (!mine) { s0 = -1e30f; s1 = -1e30f; }
            p0[r] = s0; p1[r] = s1; rm = fmaxf(rm, fmaxf(s0, s1)); }
        rm = swapmax(rm);
        const float mnew = fmaxf(mrun, rm), alpha = exp2f(mrun - mnew); mrun = mnew;
        float sacc = 0.f;
#pragma unroll
        for (int r = 0; r < 16; ++r) { p0[r] = exp2f(p0[r] - mnew); p1[r] = exp2f(p1[r] - mnew); sacc += p0[r] + p1[r]; }
        l_reg = l_reg * alpha + sacc;
        if (hi == 0) wsf[r32] = alpha;
        asm volatile("s_waitcnt lgkmcnt(0)" ::: "memory");
#pragma unroll
        for (int r = 0; r < 16; ++r) { const float f = wsf[crow(r, hi)]; o[0][r] *= f; o[1][r] *= f; }
        u32x4 pw0, pw1, pw2, pw3;
        pw0 = (u32x4){cvtpk_s(p0[0], p0[1]), cvtpk_s(p0[2], p0[3]), cvtpk_s(p0[4], p0[5]), cvtpk_s(p0[6], p0[7])};
        pw1 = (u32x4){cvtpk_s(p0[8], p0[9]), cvtpk_s(p0[10], p0[11]), cvtpk_s(p0[12], p0[13]), cvtpk_s(p0[14], p0[15])};
        pw2 = (u32x4){cvtpk_s(p1[0], p1[1]), cvtpk_s(p1[2], p1[3]), cvtpk_s(p1[4], p1[5]), cvtpk_s(p1[6], p1[7])};
        pw3 = (u32x4){cvtpk_s(p1[8], p1[9]), cvtpk_s(p1[10], p1[11]), cvtpk_s(p1[12], p1[13]), cvtpk_s(p1[14], p1[15])};
        __builtin_amdgcn_sched_barrier(0);
        pv(o, vb0 + slot, __builtin_bit_cast(bf16x8, pw0), __builtin_bit_cast(bf16x8, pw1), __builtin_bit_cast(bf16x8, pw2), __builtin_bit_cast(bf16x8, pw3));
    }
#undef ATT_BASE
    l_reg = swapadd(l_reg);
    if (hi == 0) wsf[32 + r32] = l_reg;
    asm volatile("s_waitcnt lgkmcnt(0)" ::: "memory");
    float rli[16];
#pragma unroll
    for (int r = 0; r < 16; ++r) rli[r] = 1.0f / wsf[32 + crow(r, hi)];
    {
        __attribute__((address_space(3))) unsigned short* stg = (__attribute__((address_space(3))) unsigned short*)(shm3 + L_OST) + wid * 2048;
#pragma unroll
        for (int r = 0; r < 16; ++r) { const int orow = crow(r, hi);
#pragma unroll
            for (int d0 = 0; d0 < 2; ++d0) stg[orow * 64 + d0 * 32 + r32] = (unsigned short)(cvtpk_s(o[d0][r] * rli[r], 0.f) & 0xffffu); }
        asm volatile("s_waitcnt lgkmcnt(0)" ::: "memory");
        const unsigned short* AZw = AZb + (rowbase + q0) * AW_ + h * 64; unsigned short* Ow = Qb + (rowbase + q0) * AW_ + h * 64;
#pragma unroll
        for (int i = 0; i < 4; ++i) { const int row = i * 8 + (lane >> 3), ch = lane & 7;
            const u32x4 v = *(const __attribute__((address_space(3))) u32x4*)(stg + row * 64 + ch * 8); const u32x4 z = *(const u32x4*)(AZw + (long)row * AW_ + ch * 8);
            u32x4 w;
#pragma unroll
            for (int e = 0; e < 4; ++e) { const float z0 = __builtin_bit_cast(float, z[e] << 16), z1 = __builtin_bit_cast(float, z[e] & 0xffff0000u);
                const float v0 = __builtin_bit_cast(float, v[e] << 16), v1 = __builtin_bit_cast(float, v[e] & 0xffff0000u);
                w[e] = cvtpk_s(v0 * (z0 / (1.0f + __expf(-z0))), v1 * (z1 / (1.0f + __expf(-z1)))); }
            if (!dry) *(u32x4*)(Ow + (long)row * AW_ + ch * 8) = w; }
    }
    asm volatile("s_waitcnt lgkmcnt(0)" ::: "memory");
}
__device__ __forceinline__ void moba_phase(int tid, int vcu, int G, unsigned short* Qb, const unsigned short* Kb, const unsigned short* Vb, const unsigned short* AZb, const float* KM, lds_cptr shm3, bool dry = false) {
    for (int u = vcu; u < 512; u += G) {
        const int v = u & 255, bh = v >> 2, s = v & 3, qblk = (u < 256) ? s : 7 - s;
        moba_unit(tid, bh >> 3, bh & 7, qblk, Qb, Kb, Vb, AZb, KM, shm3, dry);
    }
    asm volatile("s_waitcnt vmcnt(0) lgkmcnt(0)\n\ts_barrier" ::: "memory");
}
}

namespace rw7 {
typedef short bf16x8 __attribute__((ext_vector_type(8)));
typedef float f32x16 __attribute__((ext_vector_type(16)));
typedef unsigned u32x2 __attribute__((ext_vector_type(2)));
typedef unsigned u32x4 __attribute__((ext_vector_type(4)));
typedef unsigned short u16;
#define RLAS __attribute__((address_space(3)))
typedef RLAS unsigned char* ldsp;
constexpr int PIT = 144, TILE = 64 * PIT;
constexpr int SEQ_ = 2048, AW_ = 512, RWS_ = 1664;
constexpr int F_OFF = 6 * TILE, F_BYTES = 16384;
constexpr int NSLOT = 17, X_OFF = NSLOT * TILE;
constexpr int GC_OFF = X_OFF, CB_OFF = X_OFF + 256, ST_OFF = X_OFF + 512;
constexpr int PART_OFF = 16 * TILE;
#define SLOT(n) ((n) * TILE)
__device__ __forceinline__ int crow(int r, int hi) { return (r & 3) + 8 * (r >> 2) + 4 * hi; }
__device__ __forceinline__ unsigned cvtpk(float lo, float hi) { typedef float f2 __attribute__((ext_vector_type(2))); typedef __bf16 b2 __attribute__((ext_vector_type(2))); f2 v = {lo, hi}; b2 b = __builtin_convertvector(v, b2); return __builtin_bit_cast(unsigned, b); }
__device__ __forceinline__ u16 tobf(float x) { return (u16)(cvtpk(x, 0.f) & 0xffffu); }
__device__ __forceinline__ float frombf(u16 v) { return __builtin_bit_cast(float, (unsigned)v << 16); }
#define RW7_DPP(v, ctrl, rmask) __builtin_bit_cast(float, __builtin_amdgcn_update_dpp(0, __builtin_bit_cast(int, v), ctrl, rmask, 0xF, false))
__device__ __forceinline__ float wsum(float v) {
    v += RW7_DPP(v, 0xB1, 0xF); v += RW7_DPP(v, 0x4E, 0xF); v += RW7_DPP(v, 0x124, 0xF); v += RW7_DPP(v, 0x128, 0xF);
    v += RW7_DPP(v, 0x142, 0xA); v += RW7_DPP(v, 0x143, 0xC);
    return __builtin_bit_cast(float, __builtin_amdgcn_readlane(__builtin_bit_cast(int, v), 63));
}
__device__ __forceinline__ float sigm(float x) { return __builtin_amdgcn_rcpf(1.0f + __expf(-x)); }
__device__ __forceinline__ float swapadd(float m) { auto rr = __builtin_amdgcn_permlane32_swap(__float_as_uint(m), __float_as_uint(m), false, false); return __uint_as_float(rr[0]) + __uint_as_float(rr[1]); }
__device__ __forceinline__ f32x16 mm(f32x16 acc, ldsp A, ldsp B, int ti, int tj, int lane) {
    const int row = lane & 31, h = lane >> 5;
    const RLAS unsigned char* ap = A + (32 * ti + row) * PIT + h * 16; const RLAS unsigned char* bp = B + (32 * tj + row) * PIT + h * 16;
#pragma unroll
    for (int ks = 0; ks < 4; ++ks) { const bf16x8 a = *(const RLAS bf16x8*)(ap + ks * 32), b = *(const RLAS bf16x8*)(bp + ks * 32); acc = __builtin_amdgcn_mfma_f32_32x32x16_bf16(a, b, acc, 0, 0, 0); }
    return acc;
}
__device__ __forceinline__ f32x16 mm_ga(f32x16 acc, const u16* Ag, ldsp B, int ti, int tj, int lane) {
    const int row = lane & 31, h = lane >> 5;
    const u16* ap = Ag + (32 * ti + row) * 64 + h * 8; const RLAS unsigned char* bp = B + (32 * tj + row) * PIT + h * 16;
#pragma unroll
    for (int ks = 0; ks < 4; ++ks) { const bf16x8 a = *(const bf16x8*)(ap + ks * 16), b = *(const RLAS bf16x8*)(bp + ks * 32); acc = __builtin_amdgcn_mfma_f32_32x32x16_bf16(a, b, acc, 0, 0, 0); }
    return acc;
}
__device__ __forceinline__ f32x16 mm_gb(f32x16 acc, ldsp A, const u16* Bg, int ti, int tj, int lane) {
    const int row = lane & 31, h = lane >> 5;
    const RLAS unsigned char* ap = A + (32 * ti + row) * PIT + h * 16; const u16* bp = Bg + (32 * tj + row) * 64 + h * 8;
#pragma unroll
    for (int ks = 0; ks < 4; ++ks) { const bf16x8 a = *(const RLAS bf16x8*)(ap + ks * 32), b = *(const bf16x8*)(bp + ks * 16); acc = __builtin_amdgcn_mfma_f32_32x32x16_bf16(a, b, acc, 0, 0, 0); }
    return acc;
}
__device__ __forceinline__ void wr_n(const f32x16& acc, ldsp O, int ti, int tj, int lane) {
    const int c = lane & 31, hi = lane >> 5;
#pragma unroll
    for (int r = 0; r < 16; ++r) *(RLAS u16*)(O + (32 * ti + crow(r, hi)) * PIT + (32 * tj + c) * 2) = tobf(acc[r]);
}
__device__ __forceinline__ void wr_t(const f32x16& acc, ldsp O, int ti, int tj, int lane) {
    const int c = lane & 31, hi = lane >> 5;
#pragma unroll
    for (int g = 0; g < 4; ++g) { u32x2 w; w.x = cvtpk(acc[4 * g], acc[4 * g + 1]); w.y = cvtpk(acc[4 * g + 2], acc[4 * g + 3]);
        *(RLAS u32x2*)(O + (32 * tj + c) * PIT + (32 * ti + 8 * g + 4 * hi) * 2) = w; }
}
__device__ __forceinline__ void wr_t_glob(const f32x16& acc, u16* Og, int ti, int tj, int lane) {
    const int c = lane & 31, hi = lane >> 5;
#pragma unroll
    for (int g = 0; g < 4; ++g) { u32x2 w; w.x = cvtpk(acc[4 * g], acc[4 * g + 1]); w.y = cvtpk(acc[4 * g + 2], acc[4 * g + 3]);
        *(u32x2*)(Og + (32 * tj + c) * 64 + 32 * ti + 8 * g + 4 * hi) = w; }
}

struct Ctx {
    int tid, lane, wave, vcu, G, layer; bool dry;
    ldsp lds; unsigned char* ws; const Args* a;
    __device__ __forceinline__ const u16* RW() const { return (const u16*)(ws + WS_RW); }
    __device__ __forceinline__ u16* RZ() const { return (u16*)(ws + WS_RZ); }
    __device__ __forceinline__ const u16* VD() const { return (const u16*)(ws + WS_VD); }
    __device__ __forceinline__ u16* VF() const { return (u16*)(ws + WS_VFIRST); }
    __device__ __forceinline__ u16* PT() const { return (u16*)(ws + WS_K); }
    __device__ __forceinline__ u16* QG() const { return (u16*)(ws + WS_V); }
    __device__ __forceinline__ u16* W2() const { return (u16*)(ws + WS_AZ); }
    __device__ __forceinline__ u16* O0() const { return (u16*)(ws + WS_U); }
    __device__ __forceinline__ u16* BON() const { return (u16*)(ws + WS_U + 16 * MiB); }
    __device__ __forceinline__ const float* P(int i, int stride) const { return inp(*a, i) + (size_t)layer * stride; }
};

__device__ __forceinline__ void load_weights(const Ctx& C, int h) {
    const int k = C.lane, w = C.wave, col = h * 64 + k;
    u32x4 a, b, c;
    float x[8], y[8], z[8];
    const float* wup = C.P(6, 64 * AW_); const float* aup = C.P(8, 64 * AW_); const float* vup = inp(*C.a, 16);
#pragma unroll
    for (int jj = 0; jj < 8; ++jj) { const int j = 8 * w + jj; x[jj] = wup[(size_t)j * AW_ + col]; y[jj] = aup[(size_t)j * AW_ + col]; z[jj] = (C.layer == 1 && j < 32) ? vup[(size_t)j * AW_ + col] : 0.f; }
    a = (u32x4){cvtpk(x[0], x[1]), cvtpk(x[2], x[3]), cvtpk(x[4], x[5]), cvtpk(x[6], x[7])};
    b = (u32x4){cvtpk(y[0], y[1]), cvtpk(y[2], y[3]), cvtpk(y[4], y[5]), cvtpk(y[6], y[7])};
    c = (u32x4){cvtpk(z[0], z[1]), cvtpk(z[2], z[3]), cvtpk(z[4], z[5]), cvtpk(z[6], z[7])};
    *(RLAS u32x4*)(C.lds + SLOT(0) + k * PIT + w * 16) = a; *(RLAS u32x4*)(C.lds + SLOT(1) + k * PIT + w * 16) = b; *(RLAS u32x4*)(C.lds + SLOT(2) + k * PIT + w * 16) = c;
}

__device__ __forceinline__ void prep(const Ctx& C, int b, int h, int c) {
    const int k = C.lane, w = C.wave, col = h * 64 + k;
    const long row0 = (long)b * SEQ_ + c * 64 + 8 * w;
    const bool seq0 = (c == 0 && w == 0);
    ldsp L = C.lds;
    {
        const float* mu = C.P(4, RWS_); const float m_wd = mu[1536 + k], m_ad = mu[1600 + k]; const float m_vd = (C.layer == 1) ? inp(*C.a, 15)[k & 31] : 0.f;
        float cw[9], ca[9], cv[9];
        cw[0] = seq0 ? 0.f : frombf(C.RW()[(row0 - 1) * RWS_ + 1536 + k]); ca[0] = seq0 ? 0.f : frombf(C.RW()[(row0 - 1) * RWS_ + 1600 + k]);
        cv[0] = (C.layer == 1 && !seq0) ? frombf(C.VD()[(row0 - 1) * 32 + (k & 31)]) : 0.f;
#pragma unroll
        for (int i = 0; i < 8; ++i) { cw[i + 1] = frombf(C.RW()[(row0 + i) * RWS_ + 1536 + k]); ca[i + 1] = frombf(C.RW()[(row0 + i) * RWS_ + 1600 + k]); cv[i + 1] = (C.layer == 1) ? frombf(C.VD()[(row0 + i) * 32 + (k & 31)]) : 0.f; }
#pragma unroll
        for (int i = 0; i < 8; ++i) { const int t = 8 * w + i;
            const float wd = cw[i + 1] + (cw[i] - cw[i + 1]) * m_wd, ad = ca[i + 1] + (ca[i] - ca[i + 1]) * m_ad;
            const float th = 1.0f - 2.0f * __builtin_amdgcn_rcpf(1.0f + __expf(2.0f * wd));
            *(RLAS u16*)(L + SLOT(3) + t * PIT + k * 2) = tobf(th); *(RLAS u16*)(L + SLOT(4) + t * PIT + k * 2) = tobf(ad);
            if (C.layer == 1) { const float vd = cv[i + 1] + (cv[i] - cv[i + 1]) * m_vd; *(RLAS u16*)(L + SLOT(5) + t * PIT + k * 2) = (k < 32) ? tobf(vd) : (u16)0; } }
    }
    float cr[9], ck[9], cvv[9], crz[8], cvf[8];
    cr[0] = seq0 ? 0.f : frombf(C.RW()[(row0 - 1) * RWS_ + col]); ck[0] = seq0 ? 0.f : frombf(C.RW()[(row0 - 1) * RWS_ + 512 + col]); cvv[0] = seq0 ? 0.f : frombf(C.RW()[(row0 - 1) * RWS_ + 1024 + col]);
#pragma unroll
    for (int i = 0; i < 8; ++i) { const long row = row0 + i; cr[i + 1] = frombf(C.RW()[row * RWS_ + col]); ck[i + 1] = frombf(C.RW()[row * RWS_ + 512 + col]); cvv[i + 1] = frombf(C.RW()[row * RWS_ + 1024 + col]);
        crz[i] = frombf(C.RZ()[row * AW_ + col]); cvf[i] = (C.layer == 1) ? frombf(C.VF()[row * AW_ + col]) : 0.f; }
    __syncthreads();
    {
        const int nj = (C.layer == 1) ? 12 : 8;
        for (int job = w; job < nj; job += 8) { const int prod = job >> 2, ti = (job >> 1) & 1, tj = job & 1;
            f32x16 acc = {}; acc = mm(acc, L + SLOT(3 + prod), L + SLOT(prod), ti, tj, C.lane);
            RLAS float* F = (RLAS float*)(L + F_OFF + prod * F_BYTES); const int cc = C.lane & 31, hi = C.lane >> 5;
#pragma unroll
            for (int r = 0; r < 16; ++r) F[(32 * ti + crow(r, hi)) * 64 + 32 * tj + cc] = acc[r]; }
    }
    __syncthreads();
    float lw[8], rr[8], km[8], vr[8], kk[8], be[8];
    {
        const float* mu = C.P(4, RWS_); const float m_r = mu[col], m_k = mu[512 + col], m_v = mu[1024 + col];
        const float w0 = C.P(5, AW_)[col], a0 = C.P(7, AW_)[col], k_k = C.P(9, AW_)[col], k_a = C.P(10, AW_)[col], r_k = C.P(11, AW_)[col]; const float v0 = (C.layer == 1) ? inp(*C.a, 17)[col] : 0.f;
        const RLAS float* F0 = (const RLAS float*)(L + F_OFF); const RLAS float* F1 = F0 + 4096; const RLAS float* F2 = F1 + 4096;
        float sl = 0.f;
#pragma unroll
        for (int i = 0; i < 8; ++i) { const long row = row0 + i; const int t = 8 * w + i;
            const float r = cr[i + 1] + (cr[i] - cr[i + 1]) * m_r, ks = ck[i + 1] + (ck[i] - ck[i + 1]) * m_k, vs = cvv[i + 1] + (cvv[i] - cvv[i + 1]) * m_v;
            lw[i] = -0.60653065971f * sigm(F0[t * 64 + k] + w0); sl += lw[i];
            const float a = sigm(F1[t * 64 + k] + a0);
            float v = vs;
            if (C.layer == 1) v = vs + (cvf[i] - vs) * sigm(F2[t * 64 + k] + v0);
            else if (!C.dry) C.VF()[row * AW_ + col] = tobf(vs);
            const float kkv = ks * k_k; const float kn = kkv * __builtin_amdgcn_rsqf(fmaxf(wsum(kkv * kkv), 1e-24f));
            const float kmod = ks * (1.0f + (a - 1.0f) * k_a);
            const float cb = wsum(r * kmod * r_k), sz = crz[i] * sigm(crz[i]);
            if (!C.dry) { C.RZ()[row * AW_ + col] = tobf(sz); C.BON()[row * AW_ + col] = tobf(cb * v * sz); }
            rr[i] = r; km[i] = kmod; vr[i] = v; kk[i] = kn; be[i] = kn * a; }
        *(RLAS float*)(L + PART_OFF + (w * 64 + k) * 4) = sl;
    }
    __syncthreads();
    {
        float off = 0.f, tot = 0.f;
#pragma unroll
        for (int ww = 0; ww < 8; ++ww) { const float p = *(const RLAS float*)(L + PART_OFF + (ww * 64 + k) * 4); if (ww < w) off += p; tot += p; }
        if (w == 0) *(RLAS float*)(L + GC_OFF + k * 4) = __expf(tot);
        float ab[8], bb[8], kb[8], rb[8];
        float Lx = off;
#pragma unroll
        for (int i = 0; i < 8; ++i) { const float Li = Lx + lw[i]; const float eLx = __expf(Lx), eL = __expf(Li), eN = __builtin_amdgcn_rcpf(eL);
            ab[i] = -kk[i] * eLx; bb[i] = be[i] * eN; kb[i] = km[i] * eN; rb[i] = rr[i] * eL; Lx = Li; }
#pragma unroll
        for (int i = 0; i < 8; ++i) { const int t = 8 * w + i;
            *(RLAS u16*)(L + SLOT(3) + t * PIT + k * 2) = tobf(ab[i]); *(RLAS u16*)(L + SLOT(4) + t * PIT + k * 2) = tobf(bb[i]); *(RLAS u16*)(L + SLOT(5) + t * PIT + k * 2) = tobf(kb[i]);
            *(RLAS u16*)(L + SLOT(6) + t * PIT + k * 2) = tobf(rb[i]); }
#define RW7_PK8(x) (u32x4){cvtpk(x[0], x[1]), cvtpk(x[2], x[3]), cvtpk(x[4], x[5]), cvtpk(x[6], x[7])}
        *(RLAS u32x4*)(L + SLOT(7) + k * PIT + w * 16) = RW7_PK8(ab); *(RLAS u32x4*)(L + SLOT(8) + k * PIT + w * 16) = RW7_PK8(bb);
        *(RLAS u32x4*)(L + SLOT(9) + k * PIT + w * 16) = RW7_PK8(kb); *(RLAS u32x4*)(L + SLOT(10) + k * PIT + w * 16) = RW7_PK8(vr);
#undef RW7_PK8
    }
    __syncthreads();
}

__device__ __forceinline__ void pass1(const Ctx& C) {
    ldsp L = C.lds; const int lane = C.lane, w = C.wave, half = w >> 2, ti = (w >> 1) & 1, tj = w & 1;
    int hcur = -1;
    for (int u = C.vcu; u < 2048; u += C.G) {
        const int h = u & 7, n = u >> 3, b = n >> 5, c = n & 31;
        if (h != hcur) { __syncthreads(); load_weights(C, h); hcur = h; }
        prep(C, b, h, c);
        int lo_ = lane; asm volatile("" : "+v"(lo_)); const int cc = lo_ & 31, hi = lo_ >> 5;
#define RW7_MASK(acc, OP) _Pragma("unroll") for (int r = 0; r < 16; ++r) { const int s_ = 32 * ti + crow(r, hi), t_ = 32 * tj + cc; if (!(s_ OP t_)) acc[r] = 0.f; }
        f32x16 acc = {};
        if (half == 0) { acc = mm(acc, L + SLOT(4), L + SLOT(3), ti, tj, lane);
            RW7_MASK(acc, <)
            wr_n(acc, L + SLOT(11), ti, tj, lane); wr_t(acc, L + SLOT(12), ti, tj, lane);
#pragma unroll
            for (int r = 0; r < 16; ++r) { const int s_ = 32 * ti + crow(r, hi), t_ = 32 * tj + cc; if (s_ == t_) acc[r] += 1.0f; }
            wr_n(acc, L + SLOT(13), ti, tj, lane);
            acc = f32x16{}; acc = mm(acc, L + SLOT(4), L + SLOT(6), ti, tj, lane);
            RW7_MASK(acc, <=)
            wr_t(acc, L + SLOT(15), ti, tj, lane);
        } else { acc = mm(acc, L + SLOT(5), L + SLOT(3), ti, tj, lane);
            RW7_MASK(acc, <)
            wr_t(acc, L + SLOT(14), ti, tj, lane);
            acc = f32x16{}; acc = mm(acc, L + SLOT(5), L + SLOT(6), ti, tj, lane);
            RW7_MASK(acc, <=)
            wr_t(acc, L + SLOT(16), ti, tj, lane); }
        __syncthreads();
        f32x16 tm = {};
        if (half == 0) { acc = f32x16{}; acc = mm(acc, L + SLOT(11), L + SLOT(12), ti, tj, lane); wr_n(acc, L + SLOT(3), ti, tj, lane); wr_t(acc, L + SLOT(4), ti, tj, lane); }
        else { acc = f32x16{}; acc = mm(acc, L + SLOT(10), L + SLOT(14), ti, tj, lane); wr_n(acc, L + SLOT(5), ti, tj, lane);
#pragma unroll
            for (int r = 0; r < 16; ++r) tm[r] = frombf(*(const RLAS u16*)(L + SLOT(13) + (32 * ti + crow(r, hi)) * PIT + (32 * tj + cc) * 2)); }
        __syncthreads();
#pragma unroll
        for (int lv = 1; lv <= 5; ++lv) {
            const int pwn = (lv & 1) ? 3 : 11, pwt = (lv & 1) ? 4 : 12;
            const int qn = (lv & 1) ? 11 : 3, qt = (lv & 1) ? 12 : 4;
            const int tsrc = (lv & 1) ? 13 : 14, tdst = (lv & 1) ? 14 : 13;
            if (half == 0) { if (lv < 5) { acc = f32x16{}; acc = mm(acc, L + SLOT(pwn), L + SLOT(pwt), ti, tj, lane); wr_n(acc, L + SLOT(qn), ti, tj, lane); wr_t(acc, L + SLOT(qt), ti, tj, lane); } }
            else { tm = mm(tm, L + SLOT(tsrc), L + SLOT(pwt), ti, tj, lane);
                if (lv < 5) wr_n(tm, L + SLOT(tdst), ti, tj, lane); else wr_t(tm, L + SLOT(14), ti, tj, lane); }
            __syncthreads();
        }
        acc = f32x16{};
        if (half == 0) { acc = mm(acc, L + SLOT(7), L + SLOT(14), ti, tj, lane); wr_n(acc, L + SLOT(11), ti, tj, lane); }
        else { acc = mm(acc, L + SLOT(5), L + SLOT(14), ti, tj, lane); wr_n(acc, L + SLOT(12), ti, tj, lane); }
        __syncthreads();
        if (half == 0) {
#pragma unroll
            for (int g = 0; g < 4; ++g) { const u32x2 v = *(const RLAS u32x2*)(L + SLOT(6) + (32 * tj + cc) * PIT + (32 * ti + 8 * g + 4 * hi) * 2);
                acc[4 * g] = __builtin_bit_cast(float, v.x << 16); acc[4 * g + 1] = __builtin_bit_cast(float, v.x & 0xffff0000u); acc[4 * g + 2] = __builtin_bit_cast(float, v.y << 16); acc[4 * g + 3] = __builtin_bit_cast(float, v.y & 0xffff0000u); }
            acc = mm(acc, L + SLOT(11), L + SLOT(15), ti, tj, lane);
            wr_t_glob(acc, C.W2() + (size_t)u * 4096, ti, tj, lane);
            acc = f32x16{}; acc = mm(acc, L + SLOT(8), L + SLOT(12), ti, tj, lane); acc = mm(acc, L + SLOT(9), L + SLOT(10), ti, tj, lane);
#pragma unroll
            for (int r = 0; r < 16; ++r) acc[r] *= *(const RLAS float*)(L + GC_OFF + (32 * ti + crow(r, hi)) * 4);
            wr_t_glob(acc, C.QG() + (size_t)u * 4096, ti, tj, lane);
        } else {
            acc = f32x16{}; acc = mm(acc, L + SLOT(12), L + SLOT(15), ti, tj, lane); acc = mm(acc, L + SLOT(10), L + SLOT(16), ti, tj, lane);
            wr_t_glob(acc, C.O0() + (size_t)u * 4096, ti, tj, lane);
            acc = f32x16{}; acc = mm(acc, L + SLOT(11), L + SLOT(8), ti, tj, lane);
            const float g = *(const RLAS float*)(L + GC_OFF + (32 * tj + cc) * 4);
#pragma unroll
            for (int r = 0; r < 16; ++r) { const int i_ = 32 * ti + crow(r, hi), j_ = 32 * tj + cc; acc[r] = (acc[r] + (i_ == j_ ? 1.0f : 0.f)) * g; }
            wr_t_glob(acc, C.PT() + (size_t)u * 4096, ti, tj, lane);
        }
#undef RW7_MASK
        __syncthreads();
    }
}

__device__ __forceinline__ void pass2(const Ctx& C) {
    ldsp L = C.lds; const int lane = C.lane, w = C.wave, ti = (w >> 1) & 1, tj = w & 1, cc = lane & 31, hi = lane >> 5, row = lane & 31;
    for (int bh = C.vcu; bh < 64; bh += C.G) {
        const int b = bh >> 3, h = bh & 7;
        f32x16 s = {};
        bf16x8 pa[4], pn[4]; u32x2 qv[4], qn[4];
        const size_t u0 = ((size_t)(b * 32) * 8 + h);
        if (w < 4) {
            const u16* q = C.QG() + u0 * 4096 + (32 * tj + cc) * 64 + 32 * ti + 4 * hi;
#pragma unroll
            for (int g = 0; g < 4; ++g) qv[g] = *(const u32x2*)(q + 8 * g);
            const u16* p = C.PT() + (u0 + 8) * 4096 + (32 * ti + row) * 64 + hi * 8; const u16* q1 = q + 8 * 4096;
#pragma unroll
            for (int ks = 0; ks < 4; ++ks) pn[ks] = *(const bf16x8*)(p + ks * 16);
#pragma unroll
            for (int g = 0; g < 4; ++g) qn[g] = *(const u32x2*)(q1 + 8 * g);
#pragma unroll
            for (int g = 0; g < 4; ++g) { s[4 * g] = __builtin_bit_cast(float, qv[g].x << 16); s[4 * g + 1] = __builtin_bit_cast(float, qv[g].x & 0xffff0000u); s[4 * g + 2] = __builtin_bit_cast(float, qv[g].y << 16); s[4 * g + 3] = __builtin_bit_cast(float, qv[g].y & 0xffff0000u); }
        }
        for (int c = 1; c < 31; ++c) {
            const size_t u = u0 + (size_t)c * 8;
            if (w < 4) wr_t(s, L + SLOT(c & 1), ti, tj, lane);
            __syncthreads();
            if (w < 4) {
#pragma unroll
                for (int ks = 0; ks < 4; ++ks) pa[ks] = pn[ks];
#pragma unroll
                for (int g = 0; g < 4; ++g) qv[g] = qn[g];
                if (c < 30) { const u16* p = C.PT() + (u + 8) * 4096 + (32 * ti + row) * 64 + hi * 8; const u16* q1 = C.QG() + (u + 8) * 4096 + (32 * tj + cc) * 64 + 32 * ti + 4 * hi;
#pragma unroll
                    for (int ks = 0; ks < 4; ++ks) pn[ks] = *(const bf16x8*)(p + ks * 16);
#pragma unroll
                    for (int g = 0; g < 4; ++g) qn[g] = *(const u32x2*)(q1 + 8 * g); }
#pragma unroll
                for (int g = 0; g < 4; ++g) { s[4 * g] = __builtin_bit_cast(float, qv[g].x << 16); s[4 * g + 1] = __builtin_bit_cast(float, qv[g].x & 0xffff0000u); s[4 * g + 2] = __builtin_bit_cast(float, qv[g].y << 16); s[4 * g + 3] = __builtin_bit_cast(float, qv[g].y & 0xffff0000u); }
                const RLAS unsigned char* bp = L + SLOT(c & 1) + (32 * tj + row) * PIT + hi * 16;
#pragma unroll
                for (int ks = 0; ks < 4; ++ks) { const bf16x8 bb = *(const RLAS bf16x8*)(bp + ks * 32); s = __builtin_amdgcn_mfma_f32_32x32x16_bf16(pa[ks], bb, s, 0, 0, 0); }
                wr_t_glob(s, C.QG() + u * 4096, ti, tj, lane);
            }
        }
        __syncthreads();
    }
}

__device__ __forceinline__ void pass3(const Ctx& C) {
    const int lane = C.lane, cc = lane & 31, hi = lane >> 5, row = lane & 31;
    const int gw = C.vcu * 8 + C.wave, NGW = C.G * 8;
    const float* lng = C.P(12, AW_); const float* lnb = C.P(13, AW_);
    for (int job = gw; job < 4096; job += NGW) {
        const int u = job >> 1, tj = job & 1; const int h = u & 7, n = u >> 3, b = n >> 5, c = n & 31;
        const u16* W2 = C.W2() + (size_t)u * 4096; const u16* O0 = C.O0() + (size_t)u * 4096; const u16* S = C.QG() + (size_t)(u - 8) * 4096;
        f32x16 o[2];
#pragma unroll
        for (int ti = 0; ti < 2; ++ti) {
            const u16* q = O0 + (32 * tj + cc) * 64 + 32 * ti + 4 * hi;
#pragma unroll
            for (int g = 0; g < 4; ++g) { const u32x2 v = *(const u32x2*)(q + 8 * g); o[ti][4 * g] = __builtin_bit_cast(float, v.x << 16); o[ti][4 * g + 1] = __builtin_bit_cast(float, v.x & 0xffff0000u);
                o[ti][4 * g + 2] = __builtin_bit_cast(float, v.y << 16); o[ti][4 * g + 3] = __builtin_bit_cast(float, v.y & 0xffff0000u); }
            if (c > 0) {
                const u16* ap = S + (32 * ti + row) * 64 + hi * 8; const u16* bp = W2 + (32 * tj + row) * 64 + hi * 8;
#pragma unroll
                for (int ks = 0; ks < 4; ++ks) { const bf16x8 a = *(const bf16x8*)(ap + ks * 16), bb = *(const bf16x8*)(bp + ks * 16); o[ti] = __builtin_amdgcn_mfma_f32_32x32x16_bf16(a, bb, o[ti], 0, 0, 0); }
            }
        }
        float s1 = 0.f, s2 = 0.f;
#pragma unroll
        for (int ti = 0; ti < 2; ++ti)
#pragma unroll
            for (int r = 0; r < 16; ++r) { s1 += o[ti][r]; s2 += o[ti][r] * o[ti][r]; }
        s1 = swapadd(s1); s2 = swapadd(s2);
        float i64 = 0.015625f; asm volatile("" : "+v"(i64));
        const float mean = s1 * i64, var = fmaxf(s2 * i64 - mean * mean, 0.f), rstd = __builtin_amdgcn_rsqf(var + 64e-5f);
        const int t = 32 * tj + cc; const long grow = (long)b * SEQ_ + c * 64 + t;
        u16* rz = C.RZ() + grow * AW_ + h * 64; const u16* bo = C.BON() + grow * AW_ + h * 64;
#pragma unroll
        for (int ti = 0; ti < 2; ++ti)
#pragma unroll
            for (int g = 0; g < 4; ++g) { const int v0 = 32 * ti + 8 * g + 4 * hi;
                const u32x2 z = *(const u32x2*)(rz + v0), bz = *(const u32x2*)(bo + v0);
                const float zz[4] = {__builtin_bit_cast(float, z.x << 16), __builtin_bit_cast(float, z.x & 0xffff0000u), __builtin_bit_cast(float, z.y << 16), __builtin_bit_cast(float, z.y & 0xffff0000u)};
                const float bb[4] = {__builtin_bit_cast(float, bz.x << 16), __builtin_bit_cast(float, bz.x & 0xffff0000u), __builtin_bit_cast(float, bz.y << 16), __builtin_bit_cast(float, bz.y & 0xffff0000u)};
                const f32x4 gg = *(const f32x4*)(lng + h * 64 + v0), gb = *(const f32x4*)(lnb + h * 64 + v0);
                float y[4];
#pragma unroll
                for (int e = 0; e < 4; ++e) y[e] = ((o[ti][4 * g + e] - mean) * rstd * gg[e] + gb[e]) * zz[e] + bb[e];
                u32x2 wv; wv.x = cvtpk(y[0], y[1]); wv.y = cvtpk(y[2], y[3]); if (!C.dry) *(u32x2*)(rz + v0) = wv; }
    }
}
#undef SLOT
#undef RLAS
}
__device__ __forceinline__ void p0_transpose_item(const float* W, int ldw, int c0, int k0, const float* g, bf16* WT, int ldk, int n_row0, LAS float* scr, int lane) {
#pragma unroll 8
    for (int i = 0; i < 32; ++i) { const int kk = 2 * i + (lane >> 5); const float s = g ? g[k0 + kk] : 1.0f; scr[kk * 33 + (lane & 31)] = W[(size_t)(k0 + kk) * ldw + c0 + (lane & 31)] * s; }
    LDS_WAIT(); asm volatile("" ::: "memory");
    const int c = lane & 7;
#pragma unroll
    for (int j = 0; j < 4; ++j) { const int n = (lane >> 3) + 8 * j; const LAS float* s = scr + (8 * c) * 33 + n;
        v4u o; o.x = pk2(s[0 * 33], s[1 * 33]); o.y = pk2(s[2 * 33], s[3 * 33]); o.z = pk2(s[4 * 33], s[5 * 33]); o.w = pk2(s[6 * 33], s[7 * 33]);
        *(GAS v4u*)(WT + (size_t)(n_row0 + n) * ldk + k0 + 8 * c) = o; }
    LDS_WAIT(); asm volatile("" ::: "memory");
}
__device__ __forceinline__ void row_to_bf16_rinv(const float* xrow, bf16* orow, float* rinv, int lane) {
    const GAS f32x4* xr = (const GAS f32x4*)xrow + lane;
    f32x4 v[4]; float s = 0.f;
#pragma unroll
    for (int j = 0; j < 4; ++j) { v[j] = xr[64 * j]; s += (v[j].x * v[j].x + v[j].y * v[j].y) + (v[j].z * v[j].z + v[j].w * v[j].w); }
    s = wave_sum(s);
    GAS unsigned long long* o8 = (GAS unsigned long long*)orow + lane;
#pragma unroll
    for (int j = 0; j < 4; ++j) o8[64 * j] = (unsigned long long)pk2(v[j].x, v[j].y) | ((unsigned long long)pk2(v[j].z, v[j].w) << 32);
    if (lane == 0) *rinv = 1.0f / sqrtf(s * (1.0f / DM) + RMS_EPS);
}

__device__ __forceinline__ void p0_prologue(Frame& F, const Args& a) {
    LAS float* scr = (LAS float*)(F.lds + RING_OFF + F.wave * 16384);
    const int gw = F.vcu * NWAVES + F.wave, NGW = F.G * NWAVES;
    unsigned char* ws = a.ws;
    constexpr int I_A = 16 * (4224 / 32), I_V = 16, I_B = 16 * (NBW / 32), I_U = 8 * (DM / 32), I_O = 16 * (DM / 32);
    constexpr int I_LAYER = I_A + I_V + I_B + 2 * I_U + I_O;
    for (int it = gw; it < 2 * I_LAYER; it += NGW) {
        const int l = it / I_LAYER; int r = it % I_LAYER;
        const float* w_in = inp(a, 3) + (size_t)l * DM * DIN; const float* g = inp(a, 1) + l * DM;
        bf16* WA = (bf16*)(ws + WS_WA + l * WA_BYTES); bf16* WB = (bf16*)(ws + WS_WB + l * WB_BYTES);
        bf16* WU = (bf16*)(ws + WS_WUP + l * WUP_BYTES); bf16* WO = (bf16*)(ws + WS_WOUT + l * WOUT_BYTES);
        if (r < I_A) { const int kb = r / (4224 / 32), nb = r % (4224 / 32); p0_transpose_item(w_in, DIN, 32 * nb, 64 * kb, g, WA, DM, 32 * nb, scr, F.lane); continue; } r -= I_A;
        if (r < I_V) { if (l == 1) p0_transpose_item(inp(a, 14), 32, 0, 64 * r, g, WA, DM, 4224, scr, F.lane); continue; } r -= I_V;
        if (r < I_B) { const int kb = r / (NBW / 32), nb = r % (NBW / 32); p0_transpose_item(w_in, DIN, 4224 + 32 * nb, 64 * kb, g, WB, DM, 32 * nb, scr, F.lane); continue; } r -= I_B;
        if (r < I_U) { const int kb = r / (DM / 32), nb = r % (DM / 32); p0_transpose_item(inp(a, 18) + (size_t)l * AW * DM, DM, 32 * nb, 64 * kb, nullptr, WU, AW, 32 * nb, scr, F.lane); continue; } r -= I_U;
        if (r < I_U) { const int kb = r / (DM / 32), nb = r % (DM / 32); p0_transpose_item(inp(a, 19) + (size_t)l * AW * DM, DM, 32 * nb, 64 * kb, nullptr, WU + (size_t)DM * AW, AW, 32 * nb, scr, F.lane); continue; } r -= I_U;
        { const int kb = r / (DM / 32), nb = r % (DM / 32); p0_transpose_item(inp(a, 20) + (size_t)l * DM * DM, DM, 32 * nb, 64 * kb, nullptr, WO, DM, 32 * nb, scr, F.lane); }
    }
    {
        const int gt = F.vcu * (NWAVES * 64) + F.tid, NT = F.G * NWAVES * 64;
        const int n0 = 128 * DM * 2 / 16, n1 = 96 * DM * 2 / 16;
        GAS v4u* z0 = (GAS v4u*)(ws + WS_WA + (size_t)4224 * DM * 2); GAS v4u* z1 = (GAS v4u*)(ws + WS_WA + WA_BYTES + (size_t)4256 * DM * 2);
        for (int i = gt; i < n0; i += NT) z0[i] = (v4u){0u, 0u, 0u, 0u};
        for (int i = gt; i < n1; i += NT) z1[i] = (v4u){0u, 0u, 0u, 0u};
    }
    const float* x = inp(a, 0); bf16* XB = (bf16*)(ws + WS_XB); float* rinv = (float*)(ws + WS_RINV);
    for (int m = gw; m < M; m += NGW) row_to_bf16_rinv(x + (size_t)m * DM, XB + (size_t)m * DM, rinv + m, F.lane);
}

__device__ __forceinline__ void kmean_phase(Frame& F, const Args& a) {
    const bf16* K = (const bf16*)(a.ws + WS_K); float* KM = (float*)(a.ws + WS_KMEAN);
    for (int u = F.vcu; u < NB * NBLK; u += F.G) {
        const bf16* kp = K + (size_t)u * BLK * AW + F.tid; float s = 0.f;
        for (int t = 0; t < BLK; ++t) s += bf2f(kp[(size_t)t * AW]);
        KM[(size_t)u * AW + F.tid] = s * (1.0f / BLK);
    }
}

__device__ __forceinline__ void norm_phase(Frame& F, const Args& a, int l) {
    const int gw = F.vcu * NWAVES + F.wave, NGW = F.G * NWAVES, lane = F.lane;
    const float* Y = (const float*)(a.ws + WS_Y); const float* xold = (l == 0) ? inp(a, 0) : a.out; const float* gp = inp(a, 2) + l * DM;
    bf16* XB = (bf16*)(a.ws + WS_XB); float* rinv = (float*)(a.ws + WS_RINV);
    f32x4 gv[4];
#pragma unroll
    for (int j = 0; j < 4; ++j) gv[j] = ((const f32x4*)gp)[lane + 64 * j];
    for (int m = gw; m < M; m += NGW) {
        const f32x4* yr = (const f32x4*)(Y + (size_t)m * DM) + lane; const f32x4* xr = (const f32x4*)(xold + (size_t)m * DM) + lane;
        f32x4 y[4], x[4]; float s = 0.f;
#pragma unroll
        for (int j = 0; j < 4; ++j) { y[j] = yr[64 * j]; x[j] = xr[64 * j]; s += (y[j].x * y[j].x + y[j].y * y[j].y) + (y[j].z * y[j].z + y[j].w * y[j].w); }
        const float ry = 1.0f / sqrtf(wave_sum(s) * (1.0f / DM) + RMS_EPS); float s2 = 0.f;
#pragma unroll
        for (int j = 0; j < 4; ++j) { x[j] = x[j] + y[j] * ry * gv[j]; s2 += (x[j].x * x[j].x + x[j].y * x[j].y) + (x[j].z * x[j].z + x[j].w * x[j].w); }
        f32x4* orow = (f32x4*)(a.out + (size_t)m * DM) + lane;
#pragma unroll
        for (int j = 0; j < 4; ++j) orow[64 * j] = x[j];
        if (l == 0) {
            s2 = wave_sum(s2);
            GAS unsigned long long* o8 = (GAS unsigned long long*)(XB + (size_t)m * DM) + lane;
#pragma unroll
            for (int j = 0; j < 4; ++j) o8[64 * j] = (unsigned long long)pk2(x[j].x, x[j].y) | ((unsigned long long)pk2(x[j].z, x[j].w) << 32);
            if (lane == 0) rinv[m] = 1.0f / sqrtf(s2 * (1.0f / DM) + RMS_EPS);
        }
    }
}

__global__ void __launch_bounds__(NWAVES * 64, 2) mk_fwd(Args args) {
    extern __shared__ __attribute__((aligned(16))) unsigned char lds[];
    Frame F;
    F.lds = (LAS unsigned char*)lds;
    F.MISC = (volatile LAS unsigned*)(F.lds + MISC_OFF);
    F.tid = threadIdx.x; F.lane = F.tid & 63; F.wave = __builtin_amdgcn_readfirstlane(F.tid >> 6);
    F.G = gridDim.x; { const int bx = blockIdx.x; F.vcu = (F.G % 8 == 0) ? (bx % 8) * (F.G / 8) + bx / 8 : bx; }
    const int vcu0 = F.vcu;
    unsigned char* ws = args.ws;
    F.ctl = (gu32*)(ws + WS_CTL);
    for (int u = F.tid; u < (LDS_BYTES - LDSCTL_OFF) / 4; u += NWAVES * 64) ((LAS unsigned*)(F.lds + LDSCTL_OFF))[u] = 0u;
    __syncthreads();
    XcdBarrier bar; bar.bar = (unsigned*)(F.ctl + CW_BAR); bar.x = 0; bar.st = nullptr;
    const bool use_bar = (args.ph_hi - args.ph_lo) > 1;
    if (use_bar) bar = xcd_barrier_post((unsigned*)(F.ctl + CW_BAR), F.MISC + 8);

#ifndef PROBE_SP
#define PROBE_SP (-1)
#endif
#ifndef PROBE_REP
#define PROBE_REP 1
#endif
    int ph_ = args.ph_lo, rep_ = 0;
    while (ph_ < args.ph_hi) {
        int ph = ph_, rep = rep_; asm volatile("" : "+s"(ph), "+s"(rep));
        { int t_ = threadIdx.x; asm volatile("" : "+v"(t_)); F.tid = t_; F.lane = t_ & 63; F.wave = __builtin_amdgcn_readfirstlane(t_ >> 6); int g_ = gridDim.x, v_ = vcu0; asm volatile("" : "+s"(g_), "+s"(v_)); F.G = g_; F.vcu = v_; }
        const bool dry = rep > 0;
        if (ph == 0) p0_prologue(F, args);
        else {
            const int l = (ph - 1) / NPH_LAYER, sp = (ph - 1) % NPH_LAYER;
            const float* rinv = (const float*)(ws + WS_RINV);
            pg8::bf16_t* XB = (pg8::bf16_t*)(ws + WS_XB);
            if (sp == 0) {
                pg8::Gemm g{XB, (const pg8::bf16_t*)(ws + WS_WA + l * WA_BYTES), M, NA, DM}; pg8::StaticOrder S; S.init(M, NA, F.G, (int)blockIdx.x);
                pg8::EpiProjA E{rinv, (pg8::bf16_t*)(ws + WS_Q)};
                pg8::gemm_phase<pg8::EpiProjA, pg8::StaticOrder, true, true>(F.lds + RING_OFF, g, S, E);
            } else if (sp == 1) kmean_phase(F, args);
            else if (sp == 2) att::moba_phase(F.tid, F.vcu, F.G, (unsigned short*)(ws + WS_Q), (const unsigned short*)(ws + WS_K), (const unsigned short*)(ws + WS_V), (const unsigned short*)(ws + WS_AZ), (const float*)(ws + WS_KMEAN), (att::lds_cptr)(F.lds + RING_OFF), dry);
            else if (sp >= 3 && sp <= 5) {
                rw7::Ctx C; C.tid = F.tid; C.lane = F.lane; C.wave = F.wave; C.vcu = F.vcu; C.G = F.G; C.layer = l; C.dry = dry; C.lds = (rw7::ldsp)(F.lds + RING_OFF); C.ws = ws; C.a = &args;
                if (sp == 3) rw7::pass1(C); else if (sp == 4) rw7::pass2(C); else rw7::pass3(C);
            }
            else if (sp == 6) {
                pg8::Gemm g{XB, (const pg8::bf16_t*)(ws + WS_WB + l * WB_BYTES), M, NBW, DM}; pg8::StaticOrder S; S.init(M, NBW, F.G, (int)blockIdx.x);
                pg8::EpiProjB E{rinv, (pg8::bf16_t*)(ws + WS_GA), (pg8::bf16_t*)(ws + WS_GR)};
                pg8::gemm_phase<pg8::EpiProjB, pg8::StaticOrder, true, true>(F.lds + RING_OFF, g, S, E);
            } else if (sp == 7) {
                pg8::Gemm g{(const pg8::bf16_t*)(ws + WS_Q), (const pg8::bf16_t*)(ws + WS_WUP + l * WUP_BYTES), M, DM, AW}; pg8::StaticOrder S; S.init(M, DM, F.G, (int)blockIdx.x);
                pg8::EpiUp<false> E{(const pg8::bf16_t*)(ws + WS_GA), (pg8::bf16_t*)(ws + WS_U)};
                pg8::gemm_phase<pg8::EpiUp<false>, pg8::StaticOrder, true, true>(F.lds + RING_OFF, g, S, E);
            } else if (sp == 8) {
                pg8::Gemm g{(const pg8::bf16_t*)(ws + WS_RZ), (const pg8::bf16_t*)(ws + WS_WUP + l * WUP_BYTES + (size_t)DM * AW * 2), M, DM, AW}; pg8::StaticOrder S; S.init(M, DM, F.G, (int)blockIdx.x);
                pg8::EpiUp<true> E{(const pg8::bf16_t*)(ws + WS_GR), (pg8::bf16_t*)(ws + WS_U)};
                pg8::gemm_phase<pg8::EpiUp<true>, pg8::StaticOrder, true, true>(F.lds + RING_OFF, g, S, E);
            } else if (sp == 9) {
                pg8::Gemm g{(const pg8::bf16_t*)(ws + WS_U), (const pg8::bf16_t*)(ws + WS_WOUT + l * WOUT_BYTES), M, DM, DM}; pg8::StaticOrder S; S.init(M, DM, F.G, (int)blockIdx.x);
                pg8::EpiF32 E{(float*)(ws + WS_Y), DM};
                pg8::gemm_phase<pg8::EpiF32, pg8::StaticOrder, true, true>(F.lds + RING_OFF, g, S, E);
            } else norm_phase(F, args, l);
        }
        if (ph_ > 0 && (ph_ - 1) % NPH_LAYER == PROBE_SP && rep_ < PROBE_REP) ++rep_; else { ++ph_; rep_ = 0; }
        if (ph_ < args.ph_hi) xcd_barrier(bar);
    }
}

extern "C" void kernel_launch(void* const* d_in, const int* in_sizes, int n_in, void* d_out, int out_size, void* d_ws, size_t ws_size, hipStream_t stream) {
    static int grid = 0;
    if (grid == 0) {
        if (n_in != 21 || in_sizes[0] != M * DM || out_size != M * DM || ws_size < WS_END) { fprintf(stderr, "kernel_launch: unexpected shapes (n_in %d, in0 %d, out %d, ws %zu); nothing launched\n", n_in, n_in > 0 ? in_sizes[0] : -1, out_size, ws_size); grid = -1; return; }
        int dev = 0, cus = 0;
        if (hipGetDevice(&dev) != hipSuccess || hipDeviceGetAttribute(&cus, hipDeviceAttributeMultiprocessorCount, dev) != hipSuccess) { grid = -1; return; }
        if (hipFuncSetAttribute((const void*)mk_fwd, hipFuncAttributeMaxDynamicSharedMemorySize, LDS_BYTES) != hipSuccess) { fprintf(stderr, "kernel_launch: hipFuncSetAttribute failed\n"); grid = -1; return; }
        (void)hipGetLastError();
        grid = cus;
    }
    if (grid < 0) return;
    if (hipMemsetAsync((char*)d_ws + WS_CTL, 0, CTL_ZERO_BYTES, stream) != hipSuccess) return;
    Args a{};
    for (int i = 0; i < 21; ++i) a.in[i] = (const float*)d_in[i];
    a.out = (float*)d_out; a.ws = (unsigned char*)d_ws;
#if MK_SINGLE
    a.ph_lo = 0; a.ph_hi = NPHASE;
    hipLaunchKernelGGL(mk_fwd, dim3(grid), dim3(NWAVES * 64), LDS_BYTES, stream, a);
#else
    for (int p = 0; p < NPHASE; ++p) { a.ph_lo = p; a.ph_hi = p + 1; hipLaunchKernelGGL(mk_fwd, dim3(grid), dim3(NWAVES * 64), LDS_BYTES, stream, a); }
#endif
}
```

```cpp
#ifndef MK_SINGLE
#define MK_SINGLE 1
#endif
#include <hip/hip_runtime.h>
#include <cstdio>
#include <cstdint>
namespace pg8 {
#define PG8_LAS __attribute__((address_space(3)))
typedef unsigned short bf16_t;
typedef short bf16x8 __attribute__((ext_vector_type(8)));
typedef float f32x4 __attribute__((ext_vector_type(4)));
typedef unsigned u32x4 __attribute__((ext_vector_type(4)));
constexpr int BM = 256, BK = 64, HALF = 128, HTB = HALF * BK * 2  , STAGE_BYTES = 8 * HTB, NXCD = 8, WGM = 8;

__host__ __device__ __forceinline__ int lds_byte(int r, int c) { const int st = (r >> 4) * 2 + (c >> 5), rr = r & 15, cc = c & 31, ob = rr * 64 + cc * 2; return st * 1024 + (ob ^ (((ob >> 9) & 1) << 5)); }
__host__ __device__ __forceinline__ void stage_rc(int b, int& R, int& C) { const int st = b / 1024, sb = b % 1024, swz = sb ^ (((sb >> 9) & 1) << 5); R = (st >> 1) * 16 + swz / 64; C = (st & 1) * 32 + (swz % 64) / 2; }
__host__ __device__ __forceinline__ int perm32(int rho) { const int n = rho >> 4, i = rho & 15; return 8 * (i >> 2) + 4 * n + (i & 3); }

struct Unit { int pm, pn; };
struct Gemm { const bf16_t* A; const bf16_t* Bt; int M, N, K; };

struct StaticOrder {
    int nM, nN, nwg, G, c;
    __host__ __device__ void init(int M, int N, int G_, int c_) { nM = M / BM; nN = N / BM; nwg = nM * nN; G = G_; c = c_; }
    __host__ __device__ bool next(int i, Unit& u) const {
        const long L = (long)i * G + c; if (L >= nwg) return false;
        int wgid = (int)L; { const int q = nwg / NXCD, r = nwg % NXCD, xcd = wgid % NXCD, off = wgid / NXCD; wgid = (xcd < r ? xcd * (q + 1) : r * (q + 1) + (xcd - r) * q) + off; }
        const int nig = WGM * nN, gid = wgid / nig, fm = gid * WGM, gsz = (nM - fm) < WGM ? (nM - fm) : WGM;
        u.pm = fm + ((wgid % nig) % gsz); u.pn = (wgid % nig) / gsz; return true;
    }
    __device__ __forceinline__ void a_ready(const Unit&) const {}
    __device__ __forceinline__ void done(const Unit&) const {}
};


__device__ __forceinline__ unsigned cvt_pk_bf16(float lo, float hi) { unsigned r; asm volatile("v_cvt_pk_bf16_f32 %0, %1, %2" : "=v"(r) : "v"(lo), "v"(hi)); return r; }
__device__ __forceinline__ float bf_lo(unsigned w) { return __builtin_bit_cast(float, w << 16); }
__device__ __forceinline__ float bf_hi(unsigned w) { return __builtin_bit_cast(float, w & 0xffff0000u); }
__device__ __forceinline__ float sigmoidf_(float x) { return 1.0f / (1.0f + __expf(-x)); }

struct EpiProjA {
    static constexpr bool PERM = true, AFTER_DRAIN = false;
    const float* rinv; bf16_t* base0; float* KM;
    __device__ __forceinline__ void operator()(const f32x4 (&acc)[2][2][4][2], const Unit& u, int wr, int wc, int fr, int fq) const {
        const int row0 = u.pm * BM + wr * 64 + fr;
#pragma unroll
        for (int bj = 0; bj < 2; ++bj) {
            const int colw = u.pn * BM + bj * HALF + wc * 32;
            size_t boff; int ld, c;
            if (colw < 2048) { boff = (size_t)(colw >> 9) * (8u << 20); ld = 512; c = colw & 511; }
            else if (colw < 3712) { boff = (size_t)5 * (8u << 20); ld = 1664; c = colw - 2048; }
            else if (colw < 4224) { boff = (size_t)4 * (8u << 20); ld = 512; c = colw - 3712; }
            else if (colw < 4256) { boff = (size_t)5 * (8u << 20) + (size_t)26 * (1u << 20); ld = 32; c = colw - 4224; }
            else continue;
            bf16_t* base = base0 + boff + c + 8 * fq;
            const float qs = colw < 512 ? 0.18033688011112042f : 1.0f;
            f32x4 ks0 = {0.f, 0.f, 0.f, 0.f}, ks1 = {0.f, 0.f, 0.f, 0.f};
#pragma unroll
            for (int ai = 0; ai < 2; ++ai)
#pragma unroll
                for (int m = 0; m < 4; ++m) {
                    const int row = row0 + ai * HALF + m * 16; const float rs = rinv[row] * qs;
                    const f32x4 v0 = acc[ai][bj][m][0] * rs, v1 = acc[ai][bj][m][1] * rs;
                    ks0 += v0; ks1 += v1;
                    u32x4 w; w.x = cvt_pk_bf16(v0[0], v0[1]); w.y = cvt_pk_bf16(v0[2], v0[3]); w.z = cvt_pk_bf16(v1[0], v1[1]); w.w = cvt_pk_bf16(v1[2], v1[3]);
                    *(u32x4*)(base + (size_t)row * ld) = w;
                }
            if (colw >= 512 && colw < 1024) {
#pragma unroll
                for (int e_ = 0; e_ < 4; ++e_) {
#define PG8_RROR(v, n) __builtin_bit_cast(float, __builtin_amdgcn_update_dpp(0, __builtin_bit_cast(int, v), 0x120 + (n), 0xF, 0xF, false))
                    float a = ks0[e_], b = ks1[e_];
                    a += PG8_RROR(a, 8); b += PG8_RROR(b, 8); a += PG8_RROR(a, 4); b += PG8_RROR(b, 4); a += PG8_RROR(a, 2); b += PG8_RROR(b, 2); a += PG8_RROR(a, 1); b += PG8_RROR(b, 1);
#undef PG8_RROR
                    if (fr == 0) { float* kmp = KM + (size_t)u.pm * 512 + (colw - 512) + 8 * fq; atomicAdd(kmp + e_, a * (1.0f / 256.0f)); atomicAdd(kmp + 4 + e_, b * (1.0f / 256.0f)); }
                }
            }
        }
    }
};
struct EpiProjB {
    static constexpr bool PERM = true, AFTER_DRAIN = false;
    const float* rinv; bf16_t *GA, *GR;
    __device__ __forceinline__ void operator()(const f32x4 (&acc)[2][2][4][2], const Unit& u, int wr, int wc, int fr, int fq) const {
        const int row0 = u.pm * BM + wr * 64 + fr;
#pragma unroll
        for (int bj = 0; bj < 2; ++bj) {
            const int colw = u.pn * BM + bj * HALF + wc * 32;
            bf16_t* base = (colw < 1024 ? GA : GR) + (colw & 1023) + 8 * fq;
#pragma unroll
            for (int ai = 0; ai < 2; ++ai)
#pragma unroll
                for (int m = 0; m < 4; ++m) {
                    const int row = row0 + ai * HALF + m * 16; const float rs = rinv[row];
                    f32x4 v0 = acc[ai][bj][m][0] * rs, v1 = acc[ai][bj][m][1] * rs;
#pragma unroll
                    for (int e = 0; e < 4; ++e) { v0[e] = sigmoidf_(v0[e]); v1[e] = sigmoidf_(v1[e]); }
                    u32x4 w; w.x = cvt_pk_bf16(v0[0], v0[1]); w.y = cvt_pk_bf16(v0[2], v0[3]); w.z = cvt_pk_bf16(v1[0], v1[1]); w.w = cvt_pk_bf16(v1[2], v1[3]);
                    *(u32x4*)(base + (size_t)row * 1024) = w;
                }
        }
    }
};
template <bool ADD> struct EpiUp {
    static constexpr bool PERM = true, AFTER_DRAIN = false;
    const bf16_t* G; bf16_t* U;
    __device__ __forceinline__ void operator()(const f32x4 (&acc)[2][2][4][2], const Unit& u, int wr, int wc, int fr, int fq) const {
        const int row0 = u.pm * BM + wr * 64 + fr;
#pragma unroll
        for (int bj = 0; bj < 2; ++bj) {
            const int c = u.pn * BM + bj * HALF + wc * 32 + 8 * fq;
#pragma unroll
            for (int ai = 0; ai < 2; ++ai)
#pragma unroll
                for (int m = 0; m < 4; ++m) {
                    const size_t off = (size_t)(row0 + ai * HALF + m * 16) * 1024 + c;
                    const u32x4 g = *(const u32x4*)(G + off);
                    f32x4 v0 = acc[ai][bj][m][0], v1 = acc[ai][bj][m][1];
                    v0[0] *= bf_lo(g.x); v0[1] *= bf_hi(g.x); v0[2] *= bf_lo(g.y); v0[3] *= bf_hi(g.y);
                    v1[0] *= bf_lo(g.z); v1[1] *= bf_hi(g.z); v1[2] *= bf_lo(g.w); v1[3] *= bf_hi(g.w);
                    if (ADD) { const u32x4 p = *(const u32x4*)(U + off);
                        v0[0] += bf_lo(p.x); v0[1] += bf_hi(p.x); v0[2] += bf_lo(p.y); v0[3] += bf_hi(p.y);
                        v1[0] += bf_lo(p.z); v1[1] += bf_hi(p.z); v1[2] += bf_lo(p.w); v1[3] += bf_hi(p.w); }
                    u32x4 w; w.x = cvt_pk_bf16(v0[0], v0[1]); w.y = cvt_pk_bf16(v0[2], v0[3]); w.z = cvt_pk_bf16(v1[0], v1[1]); w.w = cvt_pk_bf16(v1[2], v1[3]);
                    *(u32x4*)(U + off) = w;
                }
        }
    }
};
struct EpiF32 {
    static constexpr bool PERM = false, AFTER_DRAIN = false;
    float* O; int ldc;
    __device__ __forceinline__ void operator()(const f32x4 (&acc)[2][2][4][2], const Unit& u, int wr, int wc, int fr, int fq) const {
        const int row0 = u.pm * BM + wr * 64 + fr, col0 = u.pn * BM + wc * 32 + 4 * fq;
#pragma unroll
        for (int ai = 0; ai < 2; ++ai)
#pragma unroll
            for (int m = 0; m < 4; ++m) { float* rowp = O + (size_t)(row0 + ai * HALF + m * 16) * ldc + col0;
#pragma unroll
                for (int bj = 0; bj < 2; ++bj)
#pragma unroll
                    for (int n = 0; n < 2; ++n) *(f32x4*)(rowp + bj * HALF + n * 16) = acc[ai][bj][m][n]; }
    }
};
template <class Epi, class Sched, bool ALIGN_EPI = false, bool SP2 = false>
__device__ __forceinline__ void gemm_phase(PG8_LAS unsigned char* lds, const Gemm g, const Sched& S, const Epi& E) {
    int tid_o = threadIdx.x; asm volatile("" : "+v"(tid_o));
    const int tid = tid_o, wid = __builtin_amdgcn_readfirstlane(tid >> 6), lane = tid & 63, wr = wid >> 2, wc = wid & 3, fr = lane & 15, fq = lane >> 4;
    const int K = g.K, nt = K / BK;
    unsigned voffA[2], voffB[2];
#pragma unroll
    for (int i = 0; i < 2; ++i) { int R, C; stage_rc(tid * 16 + i * 8192, R, C); const int Rb = Epi::PERM ? ((R & ~31) + perm32(R & 31)) : R;
        voffA[i] = (unsigned)(R * K + C) * 2u; voffB[i] = (unsigned)(Rb * K + C) * 2u; }
    const size_t kstep = (size_t)(BK * 2);
    const size_t hstep = (size_t)HALF * K * 2;
    const size_t tstep = 2 * hstep;
    const unsigned ldsw = (unsigned)wid * 1024u;
    const int aoff = lds_byte(wr * 64 + fr, fq * 8), boff = lds_byte(wc * 32 + fr, fq * 8);
#define PG8_SA(b, h) (((b) * 2 + (h)) * HTB)
#define PG8_SB(b, h) ((4 + (b) * 2 + (h)) * HTB)
#define PG8_STAGE(bufoff, gbase, voff) do { _Pragma("unroll") for (int _i = 0; _i < 2; ++_i) \
        __builtin_amdgcn_global_load_lds((const unsigned*)((const char*)(gbase) + (voff)[_i]), (PG8_LAS unsigned*)(lds + (bufoff) + ldsw + _i * 8192), 16, 0, 0); } while (0)
#define PG8_LDA(dst, b, h) do { _Pragma("unroll") for (int m = 0; m < 4; ++m) _Pragma("unroll") for (int k = 0; k < 2; ++k) dst[m][k] = *(const PG8_LAS bf16x8*)(lds + PG8_SA(b, h) + aoff + m * 2048 + k * 1024); } while (0)
#define PG8_LDB(dst, b, h) do { _Pragma("unroll") for (int n = 0; n < 2; ++n) _Pragma("unroll") for (int k = 0; k < 2; ++k) dst[n][k] = *(const PG8_LAS bf16x8*)(lds + PG8_SB(b, h) + boff + n * 2048 + k * 1024); } while (0)
#define PG8_MMA(ai, bj, At, Bt) do { __builtin_amdgcn_s_setprio(1); _Pragma("unroll") for (int m = 0; m < 4; ++m) _Pragma("unroll") for (int n = 0; n < 2; ++n) _Pragma("unroll") for (int k = 0; k < 2; ++k) \
        acc[ai][bj][m][n] = __builtin_amdgcn_mfma_f32_16x16x32_bf16(Bt[n][k], At[m][k], acc[ai][bj][m][n], 0, 0, 0); __builtin_amdgcn_s_setprio(0); } while (0)
#define PG8_WAIT_V(n) asm volatile("s_waitcnt vmcnt(" #n ")" ::: "memory")
#define PG8_WAIT_L(n) asm volatile("s_waitcnt lgkmcnt(" #n ")" ::: "memory")
#define PG8_BAR __builtin_amdgcn_s_barrier()
#define PG8_SCHED __builtin_amdgcn_sched_barrier(0)
    Unit cur, nxt; int ui = 0;
    if (!S.next(0, cur)) return;
    f32x4 acc[2][2][4][2];
#pragma unroll
    for (int a = 0; a < 2; ++a)
#pragma unroll
        for (int b = 0; b < 2; ++b)
#pragma unroll
            for (int m = 0; m < 4; ++m)
#pragma unroll
                for (int n = 0; n < 2; ++n) acc[a][b][m][n] = (f32x4){0.f, 0.f, 0.f, 0.f};
    bf16x8 At[4][2], B0[2][2], B1[2][2];
    const char* cA = (const char*)g.A + (size_t)cur.pm * tstep; const char* cB = (const char*)g.Bt + (size_t)cur.pn * tstep;
    S.a_ready(cur);
    if constexpr (SP2) {
        PG8_STAGE(PG8_SB(0, 0), cB, voffB); PG8_STAGE(PG8_SB(0, 1), cB + hstep, voffB); PG8_STAGE(PG8_SA(0, 0), cA, voffA); PG8_STAGE(PG8_SA(0, 1), cA + hstep, voffA);
        if (wr == 1) PG8_BAR;
        PG8_WAIT_V(2); PG8_BAR;
        PG8_STAGE(PG8_SB(1, 0), cB + kstep, voffB); PG8_STAGE(PG8_SA(1, 0), cA + kstep, voffA); PG8_STAGE(PG8_SB(1, 1), cB + hstep + kstep, voffB);
        PG8_WAIT_V(6); PG8_BAR;
    } else {
        PG8_STAGE(PG8_SB(0, 0), cB, voffB); PG8_STAGE(PG8_SA(0, 0), cA, voffA); PG8_STAGE(PG8_SB(0, 1), cB + hstep, voffB); PG8_STAGE(PG8_SA(0, 1), cA + hstep, voffA);
        if (wr == 1) PG8_BAR;
        PG8_WAIT_V(4); PG8_BAR;
        PG8_STAGE(PG8_SB(1, 0), cB + kstep, voffB); PG8_STAGE(PG8_SA(1, 0), cA + kstep, voffA); PG8_STAGE(PG8_SB(1, 1), cB + hstep + kstep, voffB);
        PG8_WAIT_V(6); PG8_BAR;
    }
    for (;;) {
        const bool has_next = S.next(ui + 1, nxt);
        const char* nA = has_next ? (const char*)g.A + (size_t)nxt.pm * tstep : cA; const char* nB = has_next ? (const char*)g.Bt + (size_t)nxt.pn * tstep : cB;
        for (int t = 0; t < nt; t += 2) {
            const bool last = (t == nt - 2);
            const char* a1 = cA + (size_t)(t + 1) * kstep;
            const char* a2 = last ? nA : cA + (size_t)(t + 2) * kstep; const char* b2 = last ? nB : cB + (size_t)(t + 2) * kstep;
            const char* a3 = a2 + kstep; const char* b3 = b2 + kstep;
            if (last && has_next) S.a_ready(nxt);
            if constexpr (SP2) {
            PG8_LDB(B0, 0, 0); PG8_LDB(B1, 0, 1); PG8_SCHED; PG8_LDA(At, 0, 0); PG8_STAGE(PG8_SA(1, 1), a1 + hstep, voffA);
            PG8_WAIT_V(8); PG8_WAIT_L(0); PG8_BAR; PG8_MMA(0, 0, At, B0); PG8_MMA(0, 1, At, B1); PG8_BAR; PG8_SCHED;
            PG8_LDA(At, 0, 1); PG8_STAGE(PG8_SB(0, 0), b2, voffB); PG8_STAGE(PG8_SB(0, 1), b2 + hstep, voffB); PG8_STAGE(PG8_SA(0, 0), a2, voffA);
            PG8_WAIT_V(8); PG8_WAIT_L(0); PG8_BAR; PG8_MMA(1, 0, At, B0); PG8_MMA(1, 1, At, B1); PG8_BAR; PG8_SCHED;
            PG8_LDB(B0, 1, 0); PG8_LDB(B1, 1, 1); PG8_SCHED; PG8_LDA(At, 1, 0); PG8_STAGE(PG8_SA(0, 1), a2 + hstep, voffA);
            PG8_WAIT_V(8); PG8_WAIT_L(0); PG8_BAR; PG8_MMA(0, 0, At, B0); PG8_MMA(0, 1, At, B1); PG8_BAR; PG8_SCHED;
            PG8_LDA(At, 1, 1); PG8_STAGE(PG8_SB(1, 0), b3, voffB); PG8_STAGE(PG8_SB(1, 1), b3 + hstep, voffB); PG8_STAGE(PG8_SA(1, 0), a3, voffA);
            PG8_WAIT_V(8); PG8_WAIT_L(0); PG8_BAR; PG8_MMA(1, 0, At, B0); PG8_MMA(1, 1, At, B1); PG8_BAR; PG8_SCHED;
            } else {
            PG8_LDB(B0, 0, 0); PG8_SCHED; PG8_LDA(At, 0, 0); PG8_STAGE(PG8_SA(1, 1), a1 + hstep, voffA);
            PG8_WAIT_L(8); PG8_BAR; PG8_WAIT_L(0); PG8_MMA(0, 0, At, B0); PG8_BAR; PG8_SCHED;
            PG8_LDB(B1, 0, 1); PG8_STAGE(PG8_SB(0, 0), b2, voffB);
            PG8_BAR; PG8_WAIT_L(0); PG8_MMA(0, 1, At, B1); PG8_BAR;
            PG8_LDA(At, 0, 1); PG8_STAGE(PG8_SA(0, 0), a2, voffA);
            PG8_BAR; PG8_WAIT_L(0); PG8_MMA(1, 0, At, B0); PG8_BAR; PG8_SCHED;
            PG8_STAGE(PG8_SB(0, 1), b2 + hstep, voffB);
            PG8_WAIT_V(6); PG8_BAR; PG8_MMA(1, 1, At, B1); PG8_BAR;
            PG8_LDB(B0, 1, 0); PG8_SCHED; PG8_LDA(At, 1, 0); PG8_STAGE(PG8_SA(0, 1), a2 + hstep, voffA);
            PG8_WAIT_L(8); PG8_BAR; PG8_WAIT_L(0); PG8_MMA(0, 0, At, B0); PG8_BAR; PG8_SCHED;
            PG8_LDB(B1, 1, 1); PG8_STAGE(PG8_SB(1, 0), b3, voffB);
            PG8_BAR; PG8_WAIT_L(0); PG8_MMA(0, 1, At, B1); PG8_BAR;
            PG8_LDA(At, 1, 1); PG8_STAGE(PG8_SA(1, 0), a3, voffA);
            PG8_BAR; PG8_WAIT_L(0); PG8_MMA(1, 0, At, B0); PG8_BAR; PG8_SCHED;
            PG8_STAGE(PG8_SB(1, 1), b3 + hstep, voffB);
            PG8_WAIT_V(6); PG8_BAR; PG8_MMA(1, 1, At, B1); PG8_BAR;
            }
        }
        if constexpr (ALIGN_EPI) { if (wr == 0) PG8_BAR; }
        if constexpr (!Epi::AFTER_DRAIN) { E(acc, cur, wr, wc, fr, fq); S.done(cur); }
        if (!has_next) break;
#pragma unroll
        for (int a = 0; a < 2; ++a)
#pragma unroll
            for (int b = 0; b < 2; ++b)
#pragma unroll
                for (int m = 0; m < 4; ++m)
#pragma unroll
                    for (int n = 0; n < 2; ++n) acc[a][b][m][n] = (f32x4){0.f, 0.f, 0.f, 0.f};
        cur = nxt; cA = nA; cB = nB; ++ui;
        if constexpr (ALIGN_EPI) { if (wr == 1) PG8_BAR; }
    }
    PG8_WAIT_V(0);
    if constexpr (!ALIGN_EPI) { if (wr == 0) PG8_BAR; }
    PG8_BAR;
    if constexpr (Epi::AFTER_DRAIN) { E.fused(acc, cur, wr, wc, fr, fq, lds, wid, lane); S.done(cur); }
#undef PG8_SA
#undef PG8_SB
#undef PG8_STAGE
#undef PG8_LDA
#undef PG8_LDB
#undef PG8_MMA
#undef PG8_WAIT_V
#undef PG8_WAIT_L
#undef PG8_BAR
#undef PG8_SCHED
}
}
#define GAS __attribute__((address_space(1)))
#define LAS __attribute__((address_space(3)))
typedef unsigned short bf16;
typedef unsigned v4u __attribute__((ext_vector_type(4)));
typedef float f32x4 __attribute__((ext_vector_type(4)));
typedef short bf16x8 __attribute__((ext_vector_type(8)));
typedef GAS unsigned gu32;
typedef GAS unsigned long long gu64;
#define RLX_AGENT __ATOMIC_RELAXED, __HIP_MEMORY_SCOPE_AGENT
#define LDS_WAIT() asm volatile("s_waitcnt lgkmcnt(0)" ::: "memory")
#define VM_WAIT() asm volatile("s_waitcnt vmcnt(0)" ::: "memory")
__device__ __forceinline__ unsigned long long rt() { return __builtin_amdgcn_s_memrealtime(); }
__device__ __forceinline__ unsigned f2bf(float f) { unsigned u = __builtin_bit_cast(unsigned, f); return (u + 0x7fffu + ((u >> 16) & 1u)) >> 16; }
__device__ __forceinline__ unsigned pk2(float lo, float hi) { return f2bf(lo) | (f2bf(hi) << 16); }

#define XB_TMO      128
#define XB_XCNT(j)  (256  + 64 * (j))
#define XB_XSUB(j)  (1280 + 64 * (j))
#define XB_XGEN(j)  (2304 + 64 * (j))
#define XB_TOP      3328
#define XB_TOPGEN   3392
#define XCD_BAR_WORDS 3456
#define XB_SPIN_CAP (1u << 18)

__device__ __forceinline__ unsigned xb_ld(unsigned* p)              { return __hip_atomic_load(p, __ATOMIC_RELAXED, __HIP_MEMORY_SCOPE_AGENT); }
__device__ __forceinline__ unsigned xb_add(unsigned* p, unsigned v) { return __hip_atomic_fetch_add(p, v, __ATOMIC_RELAXED, __HIP_MEMORY_SCOPE_AGENT); }
__device__ __forceinline__ unsigned xb_xcc_id() { return (unsigned)__builtin_amdgcn_s_getreg((3 << 11) | 20) & 0xFu; }
#define XB_SPIN(cond, bar) do { unsigned _sp = 0; while (cond) { __builtin_amdgcn_s_sleep(1); \
    if ((++_sp & 255u) == 0u) { if (xb_ld(&(bar)[XB_TMO])) break; if (_sp > XB_SPIN_CAP) { atomicAdd(&(bar)[XB_TMO], 1u); break; } } } } while (0)

struct XcdBarrier {
    unsigned* bar; unsigned x;
    volatile LAS unsigned* st;
};

__device__ __forceinline__ XcdBarrier xcd_barrier_post(unsigned* bar, volatile LAS unsigned* st) {
    XcdBarrier b; b.bar = bar; b.x = xb_xcc_id(); b.st = st;
    if (threadIdx.x == 0) (void)xb_add(&bar[XB_XCNT(b.x)], 1u);
    return b;
}
__device__ __forceinline__ void xcd_barrier_complete(unsigned* bar, unsigned x, unsigned& nloc, unsigned& nx) {
    const unsigned G = gridDim.x * gridDim.y * gridDim.z;
    unsigned sum, cnt, mine, sp = 0u;
    for (;;) {
        sum = 0u; cnt = 0u; mine = 0u;
#pragma unroll
        for (unsigned j = 0; j < 16; ++j) { const unsigned c = xb_ld(&bar[XB_XCNT(j)]); sum += c; cnt += (c > 0u) ? 1u : 0u; mine = (j == x) ? c : mine; }
        if (sum == G) break;
        __builtin_amdgcn_s_sleep(1);
        if ((++sp & 255u) == 0u) { if (xb_ld(&bar[XB_TMO])) break; if (sp > XB_SPIN_CAP) { atomicAdd(&bar[XB_TMO], 1u); break; } }
    }
    nloc = mine > 0u ? mine : 1u; nx = cnt > 0u ? cnt : 1u;
}

__device__ __forceinline__ void xcd_barrier(const XcdBarrier& b) {
    asm volatile("s_waitcnt vmcnt(0)" ::: "memory");
    __syncthreads();
    if (threadIdx.x == 0) {
        unsigned* bar = b.bar; asm volatile("" : "+s"(bar));
        __builtin_amdgcn_s_waitcnt(0);
        unsigned nloc = b.st[0], nx = b.st[1];
        if (nloc == 0u) { xcd_barrier_complete(bar, b.x, nloc, nx); b.st[0] = nloc; b.st[1] = nx; }
        const unsigned old = xb_add(&bar[XB_XSUB(b.x)], 1u);
        const unsigned gen = old / nloc;
        if (old + 1u == (gen + 1u) * nloc) {
            __builtin_amdgcn_fence(__ATOMIC_RELEASE, "agent");
            asm volatile("s_waitcnt vmcnt(0)" ::: "memory");
            const unsigned og = xb_add(&bar[XB_TOP], 1u);
            const unsigned tg = og / nx;
            if (og + 1u == (tg + 1u) * nx) xb_add(&bar[XB_TOPGEN], 1u);
            else XB_SPIN(xb_ld(&bar[XB_TOPGEN]) == tg, bar);
            __builtin_amdgcn_fence(__ATOMIC_ACQUIRE, "agent");
            xb_add(&bar[XB_XGEN(b.x)], 1u);
            asm volatile("s_waitcnt vmcnt(0)" ::: "memory");
        } else {
            XB_SPIN(xb_ld(&bar[XB_XGEN(b.x)]) == gen, bar);
            __builtin_amdgcn_fence(__ATOMIC_ACQUIRE, "agent");
            asm volatile("s_waitcnt vmcnt(0)" ::: "memory");
        }
    }
    __syncthreads();
}
__device__ __forceinline__ float bf_lo_(unsigned w) { return __builtin_bit_cast(float, w << 16); }
__device__ __forceinline__ float bf_hi_(unsigned w) { return __builtin_bit_cast(float, w & 0xffff0000u); }

constexpr int NWAVES = 8;
constexpr int NB = 8, SEQ = 2048, DM = 1024, M = NB * SEQ;
constexpr int NH = 8, HD = 64, AW = 512;
constexpr int RWS = 1664;
constexpr int DIN = 6272;
constexpr int NA = 4352, NBW = 2048;
constexpr int BLK = 256, NBLK = SEQ / BLK, TOPK = 3;
constexpr float RMS_EPS = 1e-6f, GN_EPS = 64e-5f;
#ifndef MK_SINGLE
#define MK_SINGLE 0
#endif
constexpr int NPH_LAYER = 9, NPHASE = 1 + 2 * NPH_LAYER;

constexpr size_t MiB = 1u << 20;
constexpr size_t WS_CTL = 0, CTL_ZERO_BYTES = 64 * 1024;
constexpr size_t WS_RINV = 1 * MiB, WS_KMEAN = 1 * MiB + 256 * 1024;
constexpr size_t WS_WA = 2 * MiB, WA_BYTES = (size_t)NA * DM * 2;
constexpr size_t WS_WB = 19 * MiB, WB_BYTES = (size_t)NBW * DM * 2;
constexpr size_t WS_WUP = 27 * MiB, WUP_BYTES = 2 * MiB;
constexpr size_t WS_WOUT = 31 * MiB, WOUT_BYTES = 2 * MiB;
constexpr size_t WS_XB = 35 * MiB, WS_VFIRST = 67 * MiB, WS_U = 83 * MiB;
constexpr size_t WS_Q = 115 * MiB, WS_K = 131 * MiB, WS_V = 147 * MiB, WS_AZ = 163 * MiB, WS_RZ = 179 * MiB, WS_RW = 195 * MiB, WS_VD = 247 * MiB;
static_assert(WS_K - WS_Q == 16 * MiB && WS_V - WS_Q == 32 * MiB && WS_AZ - WS_Q == 48 * MiB && WS_RZ - WS_Q == 64 * MiB && WS_RW - WS_Q == 80 * MiB && WS_VD - WS_RW == 52 * MiB, "EpiProjA routing offsets");
constexpr size_t WS_GA = WS_K, WS_GR = WS_RW, WS_Y = WS_Q, WS_END = 248 * MiB;
constexpr int CW_BAR = 1024;

constexpr int RING_OFF = 0, RING_BYTES = 158720;
constexpr int LDSCTL_OFF = RING_BYTES, MISC_OFF = LDSCTL_OFF + 320;
constexpr int LDS_BYTES = 163840;

struct Frame {
    LAS unsigned char* lds;
    volatile LAS unsigned* MISC;
    gu32* ctl;
    int tid, lane, wave, vcu, G;
};
__device__ __forceinline__ float wave_sum(float v) {
#pragma unroll
    for (int o = 1; o < 64; o <<= 1) v += __shfl_xor(v, o);
    return v;
}
__device__ __forceinline__ float wave_max(float v) {
#pragma unroll
    for (int o = 1; o < 64; o <<= 1) v = fmaxf(v, __shfl_xor(v, o));
    return v;
}
__device__ __forceinline__ float bf2f(bf16 v) { return __builtin_bit_cast(float, (unsigned)v << 16); }
__device__ __forceinline__ float rl(float v, int l) { return __builtin_bit_cast(float, __builtin_amdgcn_readlane(__builtin_bit_cast(int, v), l)); }

struct Args { const float* in[21]; float* out; unsigned char* ws; int ph_lo, ph_hi; };
__device__ __forceinline__ const float* inp(const Args& a, int i) { asm volatile("" : "+s"(i)); return a.in[i]; }


namespace att {
typedef short bf16x8 __attribute__((ext_vector_type(8)));
typedef short s16x4 __attribute__((ext_vector_type(4)));
typedef float f32x16 __attribute__((ext_vector_type(16)));
typedef unsigned u32x4 __attribute__((ext_vector_type(4)));
typedef __attribute__((address_space(3))) const char* lds_cptr;
constexpr int AW_ = 512, SLOTB = 8192;
constexpr int L_K = 0, L_V = 2 * SLOTB, L_WS = 4 * SLOTB, L_OST = L_WS + 8 * 256, L_BYTES = L_OST + 8 * 4096;
constexpr float LOG2E = 1.4426950408889634f, C2 = 0.125f * LOG2E;
__device__ __forceinline__ int crow(int r, int hi) { return (r & 3) + 8 * (r >> 2) + 4 * hi; }
__device__ __forceinline__ void glds16(const void* gsrc, unsigned lds_dst) { unsigned keep;
    asm volatile("s_mov_b32 %0, m0\n\ts_mov_b32 m0, %2\n\ts_nop 0\n\tglobal_load_lds_dwordx4 %1, off\n\ts_mov_b32 m0, %0" : "=&s"(keep) : "v"(gsrc), "s"(lds_dst) : "memory"); }
typedef float f32x2_t __attribute__((ext_vector_type(2))); typedef __bf16 bf16x2_t __attribute__((ext_vector_type(2)));
__device__ __forceinline__ unsigned cvtpk_s(float lo, float hi) { f32x2_t v = {lo, hi}; bf16x2_t b = __builtin_convertvector(v, bf16x2_t); return __builtin_bit_cast(unsigned, b); }
__device__ __forceinline__ void qkt(f32x16& p0, f32x16& p1, lds_cptr Kslot, const bf16x8* qr, int r32, int hi) {
    lds_cptr kb = Kslot + hi * 1024 + r32 * 16;
    const f32x16 z = {};
#pragma unroll
    for (int d0 = 0; d0 < 4; ++d0) {
        const bf16x8 b0 = *(const __attribute__((address_space(3))) bf16x8*)(kb + d0 * 2048);
        const bf16x8 b1 = *(const __attribute__((address_space(3))) bf16x8*)(kb + d0 * 2048 + 512);
        if (d0 == 0) { p0 = __builtin_amdgcn_mfma_f32_32x32x16_bf16(b0, qr[0], z, 0, 0, 0); p1 = __builtin_amdgcn_mfma_f32_32x32x16_bf16(b1, qr[0], z, 0, 0, 0); }
        else { p0 = __builtin_amdgcn_mfma_f32_32x32x16_bf16(b0, qr[d0], p0, 0, 0, 0); p1 = __builtin_amdgcn_mfma_f32_32x32x16_bf16(b1, qr[d0], p1, 0, 0, 0); } }
}
__device__ __forceinline__ void pv(f32x16* o, int vb, bf16x8 pa0, bf16x8 pa1, bf16x8 pa2, bf16x8 pa3) {
#pragma unroll
    for (int d0 = 0; d0 < 2; ++d0) { s16x4 lo[4], hi[4];
#pragma unroll
        for (int ks = 0; ks < 4; ++ks) {
            asm volatile("ds_read_b64_tr_b16 %0,%1 offset:%c2" : "=&v"(lo[ks]) : "v"(vb), "i"(d0 * 4096 + ks * 1024) : "memory");
            asm volatile("ds_read_b64_tr_b16 %0,%1 offset:%c2" : "=&v"(hi[ks]) : "v"(vb), "i"(d0 * 4096 + ks * 1024 + 512) : "memory"); }
        asm volatile("s_waitcnt lgkmcnt(0)" ::: "memory"); __builtin_amdgcn_sched_barrier(0);
#define ATT_PK(k) (bf16x8){lo[k][0], lo[k][1], lo[k][2], lo[k][3], hi[k][0], hi[k][1], hi[k][2], hi[k][3]}
        o[d0] = __builtin_amdgcn_mfma_f32_32x32x16_bf16(pa0, ATT_PK(0), o[d0], 0, 0, 0);
        o[d0] = __builtin_amdgcn_mfma_f32_32x32x16_bf16(pa1, ATT_PK(1), o[d0], 0, 0, 0);
        o[d0] = __builtin_amdgcn_mfma_f32_32x32x16_bf16(pa2, ATT_PK(2), o[d0], 0, 0, 0);
        o[d0] = __builtin_amdgcn_mfma_f32_32x32x16_bf16(pa3, ATT_PK(3), o[d0], 0, 0, 0);
#undef ATT_PK
    }
}
__device__ __forceinline__ float swapmax(float m) { auto rr = __builtin_amdgcn_permlane32_swap(__float_as_uint(m), __float_as_uint(m), false, false); return fmaxf(__uint_as_float(rr[0]), __uint_as_float(rr[1])); }
__device__ __forceinline__ float swapadd(float m) { auto rr = __builtin_amdgcn_permlane32_swap(__float_as_uint(m), __float_as_uint(m), false, false); return __uint_as_float(rr[0]) + __uint_as_float(rr[1]); }

__device__ __forceinline__ void moba_unit(int tid, int b, int h, int qblk, unsigned short* Qb, const unsigned short* Kb, const unsigned short* Vb, const unsigned short* AZb, const float* KM, lds_cptr shm3, bool dry = false) {
    const int lane = tid & 63, r32 = lane & 31, hi = lane >> 5; const int wid = __builtin_amdgcn_readfirstlane(tid >> 6);
    const long rowbase = (long)b * 2048; const int q0 = qblk * 256 + wid * 32, qpos = q0 + r32;
    const unsigned short* Qw = Qb + (rowbase + q0) * AW_ + h * 64;
    const unsigned short* Kh = Kb + rowbase * AW_ + h * 64; const unsigned short* Vh = Vb + rowbase * AW_ + h * 64;
    const unsigned lds0 = (unsigned)(size_t)shm3;
    __attribute__((address_space(3))) float* wsf = (__attribute__((address_space(3))) float*)(shm3 + L_WS) + wid * 64;
    const unsigned short* ksrc = Kh + (long)lane * AW_ + wid * 8;
    const unsigned short* vsrc = Vh + (long)(16 * (wid & 3) + (lane >> 2)) * AW_ + (wid >> 2) * 32 + (lane & 3) * 8;
    const unsigned kdst = lds0 + L_K + wid * 1024, vdst = lds0 + L_V + wid * 1024;
    const int vb0 = (int)(lds0 + L_V) + ((lane >> 4) & 1) * 32 + (lane & 3) * 8 + (4 * hi + ((lane & 15) >> 2)) * 64;
    const int NT = 4 * (qblk + 1);
#define ATT_BASE(s) ((s) < 4 ? qblk * 256 + 64 * (s) : (qblk - 1 - (((s) - 4) >> 2)) * 256 + 64 * (((s) - 4) & 3))
    { const int kb0 = ATT_BASE(0); glds16(ksrc + (long)kb0 * AW_, (unsigned)__builtin_amdgcn_readfirstlane(kdst)); glds16(vsrc + (long)kb0 * AW_, (unsigned)__builtin_amdgcn_readfirstlane(vdst)); }
    bf16x8 qr[4];
#pragma unroll
    for (int d0 = 0; d0 < 4; ++d0) qr[d0] = *reinterpret_cast<const bf16x8*>(&Qw[(long)r32 * AW_ + d0 * 16 + hi * 8]);
    unsigned selmask = 0u;
    if (qblk > 0) {
        float g[8];
#pragma unroll
        for (int j = 0; j < 8; ++j) { g[j] = 0.f;
            if (j < qblk) { const float* km = KM + ((long)(b * 8 + j)) * AW_ + h * 64 + hi * 8;
#pragma unroll
                for (int d0 = 0; d0 < 4; ++d0) { const f32x4 a0 = *(const f32x4*)(km + d0 * 16), a1 = *(const f32x4*)(km + d0 * 16 + 4);
#pragma unroll
                    for (int e = 0; e < 4; ++e) { g[j] += __builtin_bit_cast(float, (unsigned)(unsigned short)qr[d0][e] << 16) * a0[e]; g[j] += __builtin_bit_cast(float, (unsigned)(unsigned short)qr[d0][4 + e] << 16) * a1[e]; } }
                g[j] = swapadd(g[j]); }
            else g[j] = -1e30f; }
#pragma unroll
        for (int j = 0; j < 8; ++j) { int rank = 0;
#pragma unroll
            for (int i = 0; i < 8; ++i) rank += (g[i] > g[j] || (g[i] == g[j] && i < j)) ? 1 : 0;
            if (rank < 3 && j < qblk) selmask |= 1u << j; }
    }
    const float cb = exp2f(-(float)(h + 1)) * LOG2E;
    float mrun = -1e30f, l_reg = 0.f; f32x16 o[2]; o[0] = f32x16{}; o[1] = f32x16{};
    for (int s = 0; s < NT; ++s) {
        asm volatile("s_waitcnt vmcnt(0) lgkmcnt(0)\n\ts_barrier" ::: "memory");
        if (s + 1 < NT) { const int kb1 = ATT_BASE(s + 1); const unsigned so = ((s + 1) & 1) * SLOTB;
            glds16(ksrc + (long)kb1 * AW_, (unsigned)__builtin_amdgcn_readfirstlane(kdst + so)); glds16(vsrc + (long)kb1 * AW_, (unsigned)__builtin_amdgcn_readfirstlane(vdst + so)); }
        const int base = ATT_BASE(s); const bool own = s < 4; const int j = own ? qblk : (qblk - 1 - ((s - 4) >> 2));
        const bool mine = own ? true : (((selmask >> j) & 1u) != 0u);
        const bool skip = own ? (base > q0 + 31) : !__any(mine);
        if (skip) continue;
        const int slot = (s & 1) * SLOTB;
        f32x16 p0, p1;
        qkt(p0, p1, shm3 + L_K + slot, qr, r32, hi);
        const float fb = cb * (float)(base + 4 * hi - qpos);
        float rm = -1e30f;
#pragma unroll
        for (int r = 0; r < 16; ++r) { const int ko = (r & 3) + 8 * (r >> 2); const int kv = base + 4 * hi + ko;
            float s0 = p0[r] + (fb + cb * (float)ko), s1 = p1[r] + (fb + cb * (float)(ko + 32));
            if (own) { if (kv > qpos) s0 = -1e30f; if (kv + 32 > qpos) s1 = -1e30f; } else if (!mine) { s0 = -1e30f; s1 = -1e30f; }
            p0[r] = s0; p1[r] = s1; rm = fmaxf(rm, fmaxf(s0, s1)); }
        rm = swapmax(rm);
        const float mnew = fmaxf(mrun, rm), alpha = exp2f(mrun - mnew); mrun = mnew;
        float sacc = 0.f;
#pragma unroll
        for (int r = 0; r < 16; ++r) { p0[r] = exp2f(p0[r] - mnew); p1[r] = exp2f(p1[r] - mnew); sacc += p0[r] + p1[r]; }
        l_reg = l_reg * alpha + sacc;
        if (hi == 0) wsf[r32] = alpha;
        asm volatile("s_waitcnt lgkmcnt(0)" ::: "memory");
#pragma unroll
        for (int r = 0; r < 16; ++r) { const float f = wsf[crow(r, hi)]; o[0][r] *= f; o[1][r] *= f; }
        u32x4 pw0, pw1, pw2, pw3;
        pw0 = (u32x4){cvtpk_s(p0[0], p0[1]), cvtpk_s(p0[2], p0[3]), cvtpk_s(p0[4], p0[5]), cvtpk_s(p0[6], p0[7])};
        pw1 = (u32x4){cvtpk_s(p0[8], p0[9]), cvtpk_s(p0[10], p0[11]), cvtpk_s(p0[12], p0[13]), cvtpk_s(p0[14], p0[15])};
        pw2 = (u32x4){cvtpk_s(p1[0], p1[1]), cvtpk_s(p1[2], p1[3]), cvtpk_s(p1[4], p1[5]), cvtpk_s(p1[6], p1[7])};
        pw3 = (u32x4){cvtpk_s(p1[8], p1[9]), cvtpk_s(p1[10], p1[11]), cvtpk_s(p1[12], p1[13]), cvtpk_s(p1[14], p1[15])};
        __builtin_amdgcn_sched_barrier(0);
        pv(o, vb0 + slot, __builtin_bit_cast(bf16x8, pw0), __builtin_bit_cast(bf16x8, pw1), __builtin_bit_cast(bf16x8, pw2), __builtin_bit_cast(bf16x8, pw3));
    }
#undef ATT_BASE
    l_reg = swapadd(l_reg);
    if (hi == 0) wsf[32 + r32] = l_reg;
    asm volatile("s_waitcnt lgkmcnt(0)" ::: "memory");
    float rli[16];
#pragma unroll
    for (int r = 0; r < 16; ++r) rli[r] = 1.0f / wsf[32 + crow(r, hi)];
    {
        __attribute__((address_space(3))) unsigned short* stg = (__attribute__((address_space(3))) unsigned short*)(shm3 + L_OST) + wid * 2048;
#pragma unroll
        for (int r = 0; r < 16; ++r) { const int orow = crow(r, hi);
#pragma unroll
            for (int d0 = 0; d0 < 2; ++d0) stg[orow * 64 + d0 * 32 + r32] = (unsigned short)(cvtpk_s(o[d0][r] * rli[r], 0.f) & 0xffffu); }
        asm volatile("s_waitcnt lgkmcnt(0)" ::: "memory");
        const unsigned short* AZw = AZb + (rowbase + q0) * AW_ + h * 64; unsigned short* Ow = Qb + (rowbase + q0) * AW_ + h * 64;
#pragma unroll
        for (int i = 0; i < 4; ++i) { const int row = i * 8 + (lane >> 3), ch = lane & 7;
            const u32x4 v = *(const __attribute__((address_space(3))) u32x4*)(stg + row * 64 + ch * 8); const u32x4 z = *(const u32x4*)(AZw + (long)row * AW_ + ch * 8);
            u32x4 w;
#pragma unroll
            for (int e = 0; e < 4; ++e) { const float z0 = __builtin_bit_cast(float, z[e] << 16), z1 = __builtin_bit_cast(float, z[e] & 0xffff0000u);
                const float v0 = __builtin_bit_cast(float, v[e] << 16), v1 = __builtin_bit_cast(float, v[e] & 0xffff0000u);
                w[e] = cvtpk_s(v0 * (z0 / (1.0f + __expf(-z0))), v1 * (z1 / (1.0f + __expf(-z1)))); }
            if (!dry) *(u32x4*)(Ow + (long)row * AW_ + ch * 8) = w; }
    }
    asm volatile("s_waitcnt lgkmcnt(0)" ::: "memory");
}
__device__ __forceinline__ void moba_phase(int tid, int vcu, int G, unsigned short* Qb, const unsigned short* Kb, const unsigned short* Vb, const unsigned short* AZb, const float* KM, lds_cptr shm3, bool dry = false) {
    for (int u = vcu; u < 512; u += G) {
        const int v = u & 255, bh = v >> 2, s = v & 3, qblk = (u < 256) ? s : 7 - s;
        moba_unit(tid, bh >> 3, bh & 7, qblk, Qb, Kb, Vb, AZb, KM, shm3, dry);
    }
    asm volatile("s_waitcnt vmcnt(0) lgkmcnt(0)\n\ts_barrier" ::: "memory");
}
}

namespace rw7 {
typedef short bf16x8 __attribute__((ext_vector_type(8)));
typedef float f32x16 __attribute__((ext_vector_type(16)));
typedef unsigned u32x2 __attribute__((ext_vector_type(2)));
typedef unsigned u32x4 __attribute__((ext_vector_type(4)));
typedef unsigned short u16;
#define RLAS __attribute__((address_space(3)))
typedef RLAS unsigned char* ldsp;
constexpr int PIT = 144, TILE = 64 * PIT;
constexpr int SEQ_ = 2048, AW_ = 512, RWS_ = 1664;
constexpr int F_OFF = 6 * TILE, F_BYTES = 16384;
constexpr int NSLOT = 17, X_OFF = NSLOT * TILE;
constexpr int GC_OFF = X_OFF, CB_OFF = X_OFF + 256, ST_OFF = X_OFF + 512;
constexpr int PART_OFF = 16 * TILE;
#define SLOT(n) ((n) * TILE)
#define RW7_BAR() asm volatile("s_waitcnt lgkmcnt(0)\n\ts_barrier" ::: "memory")
__device__ __forceinline__ int crow(int r, int hi) { return (r & 3) + 8 * (r >> 2) + 4 * hi; }
__device__ __forceinline__ unsigned cvtpk(float lo, float hi) { typedef float f2 __attribute__((ext_vector_type(2))); typedef __bf16 b2 __attribute__((ext_vector_type(2))); f2 v = {lo, hi}; b2 b = __builtin_convertvector(v, b2); return __builtin_bit_cast(unsigned, b); }
__device__ __forceinline__ u16 tobf(float x) { return (u16)(cvtpk(x, 0.f) & 0xffffu); }
__device__ __forceinline__ float frombf(u16 v) { return __builtin_bit_cast(float, (unsigned)v << 16); }
#define RW7_DPP(v, ctrl, rmask) __builtin_bit_cast(float, __builtin_amdgcn_update_dpp(0, __builtin_bit_cast(int, v), ctrl, rmask, 0xF, false))
__device__ __forceinline__ float wsum(float v) {
    v += RW7_DPP(v, 0xB1, 0xF); v += RW7_DPP(v, 0x4E, 0xF); v += RW7_DPP(v, 0x124, 0xF); v += RW7_DPP(v, 0x128, 0xF);
    v += RW7_DPP(v, 0x142, 0xA); v += RW7_DPP(v, 0x143, 0xC);
    return __builtin_bit_cast(float, __builtin_amdgcn_readlane(__builtin_bit_cast(int, v), 63));
}
__device__ __forceinline__ float sigm(float x) { return __builtin_amdgcn_rcpf(1.0f + __expf(-x)); }
__device__ __forceinline__ float swapadd(float m) { auto rr = __builtin_amdgcn_permlane32_swap(__float_as_uint(m), __float_as_uint(m), false, false); return __uint_as_float(rr[0]) + __uint_as_float(rr[1]); }
__device__ __forceinline__ f32x16 mm(f32x16 acc, ldsp A, ldsp B, int ti, int tj, int lane) {
    const int row = lane & 31, h = lane >> 5;
    const RLAS unsigned char* ap = A + (32 * ti + row) * PIT + h * 16; const RLAS unsigned char* bp = B + (32 * tj + row) * PIT + h * 16;
#pragma unroll
    for (int ks = 0; ks < 4; ++ks) { const bf16x8 a = *(const RLAS bf16x8*)(ap + ks * 32), b = *(const RLAS bf16x8*)(bp + ks * 32); acc = __builtin_amdgcn_mfma_f32_32x32x16_bf16(a, b, acc, 0, 0, 0); }
    return acc;
}
__device__ __forceinline__ f32x16 mm_ga(f32x16 acc, const u16* Ag, ldsp B, int ti, int tj, int lane) {
    const int row = lane & 31, h = lane >> 5;
    const u16* ap = Ag + (32 * ti + row) * 64 + h * 8; const RLAS unsigned char* bp = B + (32 * tj + row) * PIT + h * 16;
#pragma unroll
    for (int ks = 0; ks < 4; ++ks) { const bf16x8 a = *(const bf16x8*)(ap + ks * 16), b = *(const RLAS bf16x8*)(bp + ks * 32); acc = __builtin_amdgcn_mfma_f32_32x32x16_bf16(a, b, acc, 0, 0, 0); }
    return acc;
}
__device__ __forceinline__ f32x16 mm_gb(f32x16 acc, ldsp A, const u16* Bg, int ti, int tj, int lane) {
    const int row = lane & 31, h = lane >> 5;
    const RLAS unsigned char* ap = A + (32 * ti + row) * PIT + h * 16; const u16* bp = Bg + (32 * tj + row) * 64 + h * 8;
#pragma unroll
    for (int ks = 0; ks < 4; ++ks) { const bf16x8 a = *(const RLAS bf16x8*)(ap + ks * 32), b = *(const bf16x8*)(bp + ks * 16); acc = __builtin_amdgcn_mfma_f32_32x32x16_bf16(a, b, acc, 0, 0, 0); }
    return acc;
}
__device__ __forceinline__ void wr_n(const f32x16& acc, ldsp O, int ti, int tj, int lane) {
    const int c = lane & 31, hi = lane >> 5;
#pragma unroll
    for (int r = 0; r < 16; ++r) *(RLAS u16*)(O + (32 * ti + crow(r, hi)) * PIT + (32 * tj + c) * 2) = tobf(acc[r]);
}
__device__ __forceinline__ void wr_t(const f32x16& acc, ldsp O, int ti, int tj, int lane) {
    const int c = lane & 31, hi = lane >> 5;
#pragma unroll
    for (int g = 0; g < 4; ++g) { u32x2 w; w.x = cvtpk(acc[4 * g], acc[4 * g + 1]); w.y = cvtpk(acc[4 * g + 2], acc[4 * g + 3]);
        *(RLAS u32x2*)(O + (32 * tj + c) * PIT + (32 * ti + 8 * g + 4 * hi) * 2) = w; }
}
__device__ __forceinline__ void wr_t_glob(const f32x16& acc, u16* Og, int ti, int tj, int lane) {
    const int c = lane & 31, hi = lane >> 5;
#pragma unroll
    for (int g = 0; g < 4; ++g) { u32x2 w; w.x = cvtpk(acc[4 * g], acc[4 * g + 1]); w.y = cvtpk(acc[4 * g + 2], acc[4 * g + 3]);
        *(u32x2*)(Og + (32 * tj + c) * 64 + 32 * ti + 8 * g + 4 * hi) = w; }
}

struct Ctx {
    int tid, lane, wave, vcu, G, layer; bool dry;
    ldsp lds; unsigned char* ws; const Args* a;
    __device__ __forceinline__ const u16* RW() const { return (const u16*)(ws + WS_RW); }
    __device__ __forceinline__ u16* RZ() const { return (u16*)(ws + WS_RZ); }
    __device__ __forceinline__ const u16* VD() const { return (const u16*)(ws + WS_VD); }
    __device__ __forceinline__ u16* VF() const { return (u16*)(ws + WS_VFIRST); }
    __device__ __forceinline__ u16* PT() const { return (u16*)(ws + WS_K); }
    __device__ __forceinline__ u16* QG() const { return (u16*)(ws + WS_V); }
    __device__ __forceinline__ u16* W2() const { return (u16*)(ws + WS_AZ); }
    __device__ __forceinline__ u16* O0() const { return (u16*)(ws + WS_U); }
    __device__ __forceinline__ u16* BON() const { return (u16*)(ws + WS_U + 16 * MiB); }
    __device__ __forceinline__ const float* P(int i, int stride) const { return inp(*a, i) + (size_t)layer * stride; }
};

__device__ __forceinline__ void load_weights(const Ctx& C, int h) {
    const int k = C.lane, w = C.wave, col = h * 64 + k;
    u32x4 a, b, c;
    float x[8], y[8], z[8];
    const float* wup = C.P(6, 64 * AW_); const float* aup = C.P(8, 64 * AW_); const float* vup = inp(*C.a, 16);
#pragma unroll
    for (int jj = 0; jj < 8; ++jj) { const int j = 8 * w + jj; x[jj] = wup[(size_t)j * AW_ + col]; y[jj] = aup[(size_t)j * AW_ + col]; const float zz = vup[(size_t)(j & 31) * AW_ + col]; z[jj] = (w < 4) ? zz : 0.f; }
    a = (u32x4){cvtpk(x[0], x[1]), cvtpk(x[2], x[3]), cvtpk(x[4], x[5]), cvtpk(x[6], x[7])};
    b = (u32x4){cvtpk(y[0], y[1]), cvtpk(y[2], y[3]), cvtpk(y[4], y[5]), cvtpk(y[6], y[7])};
    c = (u32x4){cvtpk(z[0], z[1]), cvtpk(z[2], z[3]), cvtpk(z[4], z[5]), cvtpk(z[6], z[7])};
    *(RLAS u32x4*)(C.lds + SLOT(0) + k * PIT + w * 16) = a; *(RLAS u32x4*)(C.lds + SLOT(1) + k * PIT + w * 16) = b; *(RLAS u32x4*)(C.lds + SLOT(2) + k * PIT + w * 16) = c;
}

__device__ __forceinline__ void prep(const Ctx& C, int b, int h, int c) {
    const int k = C.lane, w = C.wave, col = h * 64 + k;
    const long row0 = (long)b * SEQ_ + c * 64 + 8 * w;
    const bool seq0 = (c == 0 && w == 0);
    ldsp L = C.lds;
    {
        const float* mu = C.P(4, RWS_); const float m_wd = mu[1536 + k], m_ad = mu[1600 + k]; const float m_vd = inp(*C.a, 15)[k & 31];
        float cw[9], ca[9], cv[9];
        const long prow = seq0 ? row0 : row0 - 1; const float psc = seq0 ? 0.f : 1.f;
        cw[0] = frombf(C.RW()[prow * RWS_ + 1536 + k]) * psc; ca[0] = frombf(C.RW()[prow * RWS_ + 1600 + k]) * psc; cv[0] = frombf(C.VD()[prow * 32 + (k & 31)]) * psc;
#pragma unroll
        for (int i = 0; i < 8; ++i) { cw[i + 1] = frombf(C.RW()[(row0 + i) * RWS_ + 1536 + k]); ca[i + 1] = frombf(C.RW()[(row0 + i) * RWS_ + 1600 + k]); cv[i + 1] = frombf(C.VD()[(row0 + i) * 32 + (k & 31)]); }
#pragma unroll
        for (int i = 0; i < 8; ++i) { const int t = 8 * w + i;
            const float wd = cw[i + 1] + (cw[i] - cw[i + 1]) * m_wd, ad = ca[i + 1] + (ca[i] - ca[i + 1]) * m_ad, vd = cv[i + 1] + (cv[i] - cv[i + 1]) * m_vd;
            const float th = 1.0f - 2.0f * __builtin_amdgcn_rcpf(1.0f + __expf(2.0f * wd));
            *(RLAS u16*)(L + SLOT(3) + t * PIT + k * 2) = tobf(th); *(RLAS u16*)(L + SLOT(4) + t * PIT + k * 2) = tobf(ad);
            *(RLAS u16*)(L + SLOT(5) + t * PIT + k * 2) = (k < 32) ? tobf(vd) : (u16)0; }
    }
    float cr[9], ck[9], cvv[9], crz[8], cvf[8];
    { const long prow = seq0 ? row0 : row0 - 1; const float psc = seq0 ? 0.f : 1.f;
      cr[0] = frombf(C.RW()[prow * RWS_ + col]) * psc; ck[0] = frombf(C.RW()[prow * RWS_ + 512 + col]) * psc; cvv[0] = frombf(C.RW()[prow * RWS_ + 1024 + col]) * psc; }
#pragma unroll
    for (int i = 0; i < 8; ++i) { const long row = row0 + i; cr[i + 1] = frombf(C.RW()[row * RWS_ + col]); ck[i + 1] = frombf(C.RW()[row * RWS_ + 512 + col]); cvv[i + 1] = frombf(C.RW()[row * RWS_ + 1024 + col]);
        crz[i] = frombf(C.RZ()[row * AW_ + col]); cvf[i] = frombf(C.VF()[row * AW_ + col]); }
    RW7_BAR();
    {
        const int nj = (C.layer == 1) ? 12 : 8;
        for (int job = w; job < nj; job += 8) { const int prod = job >> 2, ti = (job >> 1) & 1, tj = job & 1;
            f32x16 acc = {}; acc = mm(acc, L + SLOT(3 + prod), L + SLOT(prod), ti, tj, C.lane);
            RLAS float* F = (RLAS float*)(L + F_OFF + prod * F_BYTES); const int cc = C.lane & 31, hi = C.lane >> 5;
#pragma unroll
            for (int r = 0; r < 16; ++r) F[(32 * ti + crow(r, hi)) * 64 + 32 * tj + cc] = acc[r]; }
    }
    RW7_BAR();
    float lw[8], rr[8], km[8], vr[8], kk[8], be[8];
    {
        const float* mu = C.P(4, RWS_); const float m_r = mu[col], m_k = mu[512 + col], m_v = mu[1024 + col];
        const float w0 = C.P(5, AW_)[col], a0 = C.P(7, AW_)[col], k_k = C.P(9, AW_)[col], k_a = C.P(10, AW_)[col], r_k = C.P(11, AW_)[col]; const float v0 = inp(*C.a, 17)[col];
        const RLAS float* F0 = (const RLAS float*)(L + F_OFF); const RLAS float* F1 = F0 + 4096; const RLAS float* F2 = F1 + 4096;
        float sl = 0.f;
#pragma unroll
        for (int i = 0; i < 8; ++i) { const long row = row0 + i; const int t = 8 * w + i;
            const float r = cr[i + 1] + (cr[i] - cr[i + 1]) * m_r, ks = ck[i + 1] + (ck[i] - ck[i + 1]) * m_k, vs = cvv[i + 1] + (cvv[i] - cvv[i + 1]) * m_v;
            lw[i] = -0.60653065971f * sigm(F0[t * 64 + k] + w0); sl += lw[i];
            const float a = sigm(F1[t * 64 + k] + a0);
            const float v = (C.layer == 1) ? vs + (cvf[i] - vs) * sigm(F2[t * 64 + k] + v0) : vs;
            if (!C.dry) C.VF()[row * AW_ + col] = tobf((C.layer == 1) ? cvf[i] : vs);
            const float kkv = ks * k_k; const float kn = kkv * __builtin_amdgcn_rsqf(fmaxf(wsum(kkv * kkv), 1e-24f));
            const float kmod = ks * (1.0f + (a - 1.0f) * k_a);
            const float cb = wsum(r * kmod * r_k), sz = crz[i] * sigm(crz[i]);
            if (!C.dry) { C.RZ()[row * AW_ + col] = tobf(sz); C.BON()[row * AW_ + col] = tobf(cb * v * sz); }
            rr[i] = r; km[i] = kmod; vr[i] = v; kk[i] = kn; be[i] = kn * a; }
        *(RLAS float*)(L + PART_OFF + (w * 64 + k) * 4) = sl;
    }
    RW7_BAR();
    {
        float off = 0.f, tot = 0.f;
#pragma unroll
        for (int ww = 0; ww < 8; ++ww) { const float p = *(const RLAS float*)(L + PART_OFF + (ww * 64 + k) * 4); if (ww < w) off += p; tot += p; }
        if (w == 0) *(RLAS float*)(L + GC_OFF + k * 4) = __expf(tot);
        float ab[8], bb[8], kb[8], rb[8];
        float Lx = off;
#pragma unroll
        for (int i = 0; i < 8; ++i) { const float Li = Lx + lw[i]; const float eLx = __expf(Lx), eL = __expf(Li), eN = __builtin_amdgcn_rcpf(eL);
            ab[i] = -kk[i] * eLx; bb[i] = be[i] * eN; kb[i] = km[i] * eN; rb[i] = rr[i] * eL; Lx = Li; }
#pragma unroll
        for (int i = 0; i < 8; ++i) { const int t = 8 * w + i;
            *(RLAS u16*)(L + SLOT(3) + t * PIT + k * 2) = tobf(ab[i]); *(RLAS u16*)(L + SLOT(4) + t * PIT + k * 2) = tobf(bb[i]); *(RLAS u16*)(L + SLOT(5) + t * PIT + k * 2) = tobf(kb[i]);
            *(RLAS u16*)(L + SLOT(6) + t * PIT + k * 2) = tobf(rb[i]); }
#define RW7_PK8(x) (u32x4){cvtpk(x[0], x[1]), cvtpk(x[2], x[3]), cvtpk(x[4], x[5]), cvtpk(x[6], x[7])}
        *(RLAS u32x4*)(L + SLOT(7) + k * PIT + w * 16) = RW7_PK8(ab); *(RLAS u32x4*)(L + SLOT(8) + k * PIT + w * 16) = RW7_PK8(bb);
        *(RLAS u32x4*)(L + SLOT(9) + k * PIT + w * 16) = RW7_PK8(kb); *(RLAS u32x4*)(L + SLOT(10) + k * PIT + w * 16) = RW7_PK8(vr);
#undef RW7_PK8
    }
    RW7_BAR();
}

__device__ __forceinline__ void pass1(const Ctx& C) {
    ldsp L = C.lds; const int lane = C.lane, w = C.wave, half = w >> 2, ti = (w >> 1) & 1, tj = w & 1;
    int hcur = -1;
    for (int u = C.vcu; u < 2048; u += C.G) {
        const int h = u & 7, n = u >> 3, b = n >> 5, c = n & 31;
        if (h != hcur) { RW7_BAR(); load_weights(C, h); hcur = h; }
        prep(C, b, h, c);
        int lo_ = lane; asm volatile("" : "+v"(lo_)); const int cc = lo_ & 31, hi = lo_ >> 5;
#define RW7_MASK(acc, OP) _Pragma("unroll") for (int r = 0; r < 16; ++r) { const int s_ = 32 * ti + crow(r, hi), t_ = 32 * tj + cc; if (!(s_ OP t_)) acc[r] = 0.f; }
        f32x16 acc = {};
        if (half == 0) { acc = mm(acc, L + SLOT(4), L + SLOT(3), ti, tj, lane);
            RW7_MASK(acc, <)
            wr_n(acc, L + SLOT(11), ti, tj, lane); wr_t(acc, L + SLOT(12), ti, tj, lane);
#pragma unroll
            for (int r = 0; r < 16; ++r) { const int s_ = 32 * ti + crow(r, hi), t_ = 32 * tj + cc; if (s_ == t_) acc[r] += 1.0f; }
            wr_n(acc, L + SLOT(13), ti, tj, lane);
            acc = f32x16{}; acc = mm(acc, L + SLOT(4), L + SLOT(6), ti, tj, lane);
            RW7_MASK(acc, <=)
            wr_t(acc, L + SLOT(15), ti, tj, lane);
        } else { acc = mm(acc, L + SLOT(5), L + SLOT(3), ti, tj, lane);
            RW7_MASK(acc, <)
            wr_t(acc, L + SLOT(14), ti, tj, lane);
            acc = f32x16{}; acc = mm(acc, L + SLOT(5), L + SLOT(6), ti, tj, lane);
            RW7_MASK(acc, <=)
            wr_t(acc, L + SLOT(16), ti, tj, lane); }
        RW7_BAR();
        f32x16 tm = {};
        if (half == 0) { acc = f32x16{}; acc = mm(acc, L + SLOT(11), L + SLOT(12), ti, tj, lane); wr_n(acc, L + SLOT(3), ti, tj, lane); wr_t(acc, L + SLOT(4), ti, tj, lane); }
        else { acc = f32x16{}; acc = mm(acc, L + SLOT(10), L + SLOT(14), ti, tj, lane); wr_n(acc, L + SLOT(5), ti, tj, lane);
#pragma unroll
            for (int r = 0; r < 16; ++r) tm[r] = frombf(*(const RLAS u16*)(L + SLOT(13) + (32 * ti + crow(r, hi)) * PIT + (32 * tj + cc) * 2)); }
        RW7_BAR();
#pragma unroll
        for (int lv = 1; lv <= 5; ++lv) {
            const int pwn = (lv & 1) ? 3 : 11, pwt = (lv & 1) ? 4 : 12;
            const int qn = (lv & 1) ? 11 : 3, qt = (lv & 1) ? 12 : 4;
            const int tsrc = (lv & 1) ? 13 : 14, tdst = (lv & 1) ? 14 : 13;
            if (half == 0) { if (lv < 5) { acc = f32x16{}; acc = mm(acc, L + SLOT(pwn), L + SLOT(pwt), ti, tj, lane); wr_n(acc, L + SLOT(qn), ti, tj, lane); wr_t(acc, L + SLOT(qt), ti, tj, lane); } }
            else { tm = mm(tm, L + SLOT(tsrc), L + SLOT(pwt), ti, tj, lane);
                if (lv < 5) wr_n(tm, L + SLOT(tdst), ti, tj, lane); else wr_t(tm, L + SLOT(14), ti, tj, lane); }
            RW7_BAR();
        }
        acc = f32x16{};
        if (half == 0) { acc = mm(acc, L + SLOT(7), L + SLOT(14), ti, tj, lane); wr_n(acc, L + SLOT(11), ti, tj, lane); }
        else { acc = mm(acc, L + SLOT(5), L + SLOT(14), ti, tj, lane); wr_n(acc, L + SLOT(12), ti, tj, lane); }
        RW7_BAR();
        if (half == 0) {
#pragma unroll
            for (int g = 0; g < 4; ++g) { const u32x2 v = *(const RLAS u32x2*)(L + SLOT(6) + (32 * tj + cc) * PIT + (32 * ti + 8 * g + 4 * hi) * 2);
                acc[4 * g] = __builtin_bit_cast(float, v.x << 16); acc[4 * g + 1] = __builtin_bit_cast(float, v.x & 0xffff0000u); acc[4 * g + 2] = __builtin_bit_cast(float, v.y << 16); acc[4 * g + 3] = __builtin_bit_cast(float, v.y & 0xffff0000u); }
            acc = mm(acc, L + SLOT(11), L + SLOT(15), ti, tj, lane);
            wr_t_glob(acc, C.W2() + (size_t)u * 4096, ti, tj, lane);
            acc = f32x16{}; acc = mm(acc, L + SLOT(8), L + SLOT(12), ti, tj, lane); acc = mm(acc, L + SLOT(9), L + SLOT(10), ti, tj, lane);
#pragma unroll
            for (int r = 0; r < 16; ++r) acc[r] *= *(const RLAS float*)(L + GC_OFF + (32 * ti + crow(r, hi)) * 4);
            wr_t_glob(acc, C.QG() + (size_t)u * 4096, ti, tj, lane);
        } else {
            acc = f32x16{}; acc = mm(acc, L + SLOT(12), L + SLOT(15), ti, tj, lane); acc = mm(acc, L + SLOT(10), L + SLOT(16), ti, tj, lane);
            wr_t_glob(acc, C.O0() + (size_t)u * 4096, ti, tj, lane);
            acc = f32x16{}; acc = mm(acc, L + SLOT(11), L + SLOT(8), ti, tj, lane);
            const float g = *(const RLAS float*)(L + GC_OFF + (32 * tj + cc) * 4);
#pragma unroll
            for (int r = 0; r < 16; ++r) { const int i_ = 32 * ti + crow(r, hi), j_ = 32 * tj + cc; acc[r] = (acc[r] + (i_ == j_ ? 1.0f : 0.f)) * g; }
            wr_t_glob(acc, C.PT() + (size_t)u * 4096, ti, tj, lane);
        }
#undef RW7_MASK
        RW7_BAR();
    }
}

__device__ __forceinline__ void pass2(const Ctx& C) {
    ldsp L = C.lds; const int lane = C.lane, w = C.wave, ti = (w >> 1) & 1, tj = w & 1, cc = lane & 31, hi = lane >> 5, row = lane & 31;
    for (int bh = C.vcu; bh < 64; bh += C.G) {
        const int b = bh >> 3, h = bh & 7;
        f32x16 s = {};
        bf16x8 pa[4], pn[4]; u32x2 qv[4], qn[4];
        const size_t u0 = ((size_t)(b * 32) * 8 + h);
        if (w < 4) {
            const u16* q = C.QG() + u0 * 4096 + (32 * tj + cc) * 64 + 32 * ti + 4 * hi;
#pragma unroll
            for (int g = 0; g < 4; ++g) qv[g] = *(const u32x2*)(q + 8 * g);
            const u16* p = C.PT() + (u0 + 8) * 4096 + (32 * ti + row) * 64 + hi * 8; const u16* q1 = q + 8 * 4096;
#pragma unroll
            for (int ks = 0; ks < 4; ++ks) pn[ks] = *(const bf16x8*)(p + ks * 16);
#pragma unroll
            for (int g = 0; g < 4; ++g) qn[g] = *(const u32x2*)(q1 + 8 * g);
#pragma unroll
            for (int g = 0; g < 4; ++g) { s[4 * g] = __builtin_bit_cast(float, qv[g].x << 16); s[4 * g + 1] = __builtin_bit_cast(float, qv[g].x & 0xffff0000u); s[4 * g + 2] = __builtin_bit_cast(float, qv[g].y << 16); s[4 * g + 3] = __builtin_bit_cast(float, qv[g].y & 0xffff0000u); }
        }
        for (int c = 1; c < 31; ++c) {
            const size_t u = u0 + (size_t)c * 8;
            if (w < 4) wr_t(s, L + SLOT(c & 1), ti, tj, lane);
            RW7_BAR();
            if (w < 4) {
#pragma unroll
                for (int ks = 0; ks < 4; ++ks) pa[ks] = pn[ks];
#pragma unroll
                for (int g = 0; g < 4; ++g) qv[g] = qn[g];
                if (c < 30) { const u16* p = C.PT() + (u + 8) * 4096 + (32 * ti + row) * 64 + hi * 8; const u16* q1 = C.QG() + (u + 8) * 4096 + (32 * tj + cc) * 64 + 32 * ti + 4 * hi;
#pragma unroll
                    for (int ks = 0; ks < 4; ++ks) pn[ks] = *(const bf16x8*)(p + ks * 16);
#pragma unroll
                    for (int g = 0; g < 4; ++g) qn[g] = *(const u32x2*)(q1 + 8 * g); }
#pragma unroll
                for (int g = 0; g < 4; ++g) { s[4 * g] = __builtin_bit_cast(float, qv[g].x << 16); s[4 * g + 1] = __builtin_bit_cast(float, qv[g].x & 0xffff0000u); s[4 * g + 2] = __builtin_bit_cast(float, qv[g].y << 16); s[4 * g + 3] = __builtin_bit_cast(float, qv[g].y & 0xffff0000u); }
                const RLAS unsigned char* bp = L + SLOT(c & 1) + (32 * tj + row) * PIT + hi * 16;
#pragma unroll
                for (int ks = 0; ks < 4; ++ks) { const bf16x8 bb = *(const RLAS bf16x8*)(bp + ks * 32); s = __builtin_amdgcn_mfma_f32_32x32x16_bf16(pa[ks], bb, s, 0, 0, 0); }
                if (!C.dry) wr_t_glob(s, C.QG() + u * 4096, ti, tj, lane);
            }
        }
        RW7_BAR();
    }
}

__device__ __forceinline__ void pass3(const Ctx& C) {
    const int lane = C.lane, cc = lane & 31, hi = lane >> 5, row = lane & 31;
    const int gw = C.vcu * 8 + C.wave, NGW = C.G * 8;
    const float* lng = C.P(12, AW_); const float* lnb = C.P(13, AW_);
    for (int job = gw; job < 4096; job += NGW) {
        const int u = job >> 1, tj = job & 1; const int h = u & 7, n = u >> 3, b = n >> 5, c = n & 31;
        const u16* W2 = C.W2() + (size_t)u * 4096; const u16* O0 = C.O0() + (size_t)u * 4096; const u16* S = C.QG() + (size_t)(u - 8) * 4096;
        f32x16 o[2];
#pragma unroll
        for (int ti = 0; ti < 2; ++ti) {
            const u16* q = O0 + (32 * tj + cc) * 64 + 32 * ti + 4 * hi;
#pragma unroll
            for (int g = 0; g < 4; ++g) { const u32x2 v = *(const u32x2*)(q + 8 * g); o[ti][4 * g] = __builtin_bit_cast(float, v.x << 16); o[ti][4 * g + 1] = __builtin_bit_cast(float, v.x & 0xffff0000u);
                o[ti][4 * g + 2] = __builtin_bit_cast(float, v.y << 16); o[ti][4 * g + 3] = __builtin_bit_cast(float, v.y & 0xffff0000u); }
            if (c > 0) {
                const u16* ap = S + (32 * ti + row) * 64 + hi * 8; const u16* bp = W2 + (32 * tj + row) * 64 + hi * 8;
#pragma unroll
                for (int ks = 0; ks < 4; ++ks) { const bf16x8 a = *(const bf16x8*)(ap + ks * 16), bb = *(const bf16x8*)(bp + ks * 16); o[ti] = __builtin_amdgcn_mfma_f32_32x32x16_bf16(a, bb, o[ti], 0, 0, 0); }
            }
        }
        float s1 = 0.f, s2 = 0.f;
#pragma unroll
        for (int ti = 0; ti < 2; ++ti)
#pragma unroll
            for (int r = 0; r < 16; ++r) { s1 += o[ti][r]; s2 += o[ti][r] * o[ti][r]; }
        s1 = swapadd(s1); s2 = swapadd(s2);
        float i64 = 0.015625f; asm volatile("" : "+v"(i64));
        const float mean = s1 * i64, var = fmaxf(s2 * i64 - mean * mean, 0.f), rstd = __builtin_amdgcn_rsqf(var + 64e-5f);
        const int t = 32 * tj + cc; const long grow = (long)b * SEQ_ + c * 64 + t;
        u16* rz = C.RZ() + grow * AW_ + h * 64; const u16* bo = C.BON() + grow * AW_ + h * 64;
#pragma unroll
        for (int ti = 0; ti < 2; ++ti)
#pragma unroll
            for (int g = 0; g < 4; ++g) { const int v0 = 32 * ti + 8 * g + 4 * hi;
                const u32x2 z = *(const u32x2*)(rz + v0), bz = *(const u32x2*)(bo + v0);
                const float zz[4] = {__builtin_bit_cast(float, z.x << 16), __builtin_bit_cast(float, z.x & 0xffff0000u), __builtin_bit_cast(float, z.y << 16), __builtin_bit_cast(float, z.y & 0xffff0000u)};
                const float bb[4] = {__builtin_bit_cast(float, bz.x << 16), __builtin_bit_cast(float, bz.x & 0xffff0000u), __builtin_bit_cast(float, bz.y << 16), __builtin_bit_cast(float, bz.y & 0xffff0000u)};
                const f32x4 gg = *(const f32x4*)(lng + h * 64 + v0), gb = *(const f32x4*)(lnb + h * 64 + v0);
                float y[4];
#pragma unroll
                for (int e = 0; e < 4; ++e) y[e] = ((o[ti][4 * g + e] - mean) * rstd * gg[e] + gb[e]) * zz[e] + bb[e];
                u32x2 wv; wv.x = cvtpk(y[0], y[1]); wv.y = cvtpk(y[2], y[3]); if (!C.dry) *(u32x2*)(rz + v0) = wv; }
    }
}
#undef SLOT
#undef RW7_BAR
#undef RLAS
}
__device__ __forceinline__ void p0_transpose_item(const float* W, int ldw, int c0, int k0, const float* g, bf16* WT, int ldk, int n_row0, LAS float* scr, int lane) {
#pragma unroll 8
    for (int i = 0; i < 32; ++i) { const int kk = 2 * i + (lane >> 5); const float s = g ? g[k0 + kk] : 1.0f; scr[kk * 33 + (lane & 31)] = W[(size_t)(k0 + kk) * ldw + c0 + (lane & 31)] * s; }
    LDS_WAIT(); asm volatile("" ::: "memory");
    const int c = lane & 7;
#pragma unroll
    for (int j = 0; j < 4; ++j) { const int n = (lane >> 3) + 8 * j; const LAS float* s = scr + (8 * c) * 33 + n;
        v4u o; o.x = pk2(s[0 * 33], s[1 * 33]); o.y = pk2(s[2 * 33], s[3 * 33]); o.z = pk2(s[4 * 33], s[5 * 33]); o.w = pk2(s[6 * 33], s[7 * 33]);
        *(GAS v4u*)(WT + (size_t)(n_row0 + n) * ldk + k0 + 8 * c) = o; }
    LDS_WAIT(); asm volatile("" ::: "memory");
}
__device__ __forceinline__ void row_to_bf16_rinv(const float* xrow, bf16* orow, float* rinv, int lane) {
    const GAS f32x4* xr = (const GAS f32x4*)xrow + lane;
    f32x4 v[4]; float s = 0.f;
#pragma unroll
    for (int j = 0; j < 4; ++j) { v[j] = xr[64 * j]; s += (v[j].x * v[j].x + v[j].y * v[j].y) + (v[j].z * v[j].z + v[j].w * v[j].w); }
    s = wave_sum(s);
    GAS unsigned long long* o8 = (GAS unsigned long long*)orow + lane;
#pragma unroll
    for (int j = 0; j < 4; ++j) o8[64 * j] = (unsigned long long)pk2(v[j].x, v[j].y) | ((unsigned long long)pk2(v[j].z, v[j].w) << 32);
    if (lane == 0) *rinv = 1.0f / sqrtf(s * (1.0f / DM) + RMS_EPS);
}

__device__ __forceinline__ void p0_prologue(Frame& F, const Args& a) {
    LAS float* scr = (LAS float*)(F.lds + RING_OFF + F.wave * 16384);
    const int gw = F.vcu * NWAVES + F.wave, NGW = F.G * NWAVES;
    unsigned char* ws = a.ws;
    constexpr int I_A = 16 * (4224 / 32), I_V = 16, I_B = 16 * (NBW / 32), I_U = 8 * (DM / 32), I_O = 16 * (DM / 32);
    constexpr int I_LAYER = I_A + I_V + I_B + 2 * I_U + I_O;
    for (int it = gw; it < 2 * I_LAYER; it += NGW) {
        const int l = it / I_LAYER; int r = it % I_LAYER;
        const float* w_in = inp(a, 3) + (size_t)l * DM * DIN; const float* g = inp(a, 1) + l * DM;
        bf16* WA = (bf16*)(ws + WS_WA + l * WA_BYTES); bf16* WB = (bf16*)(ws + WS_WB + l * WB_BYTES);
        bf16* WU = (bf16*)(ws + WS_WUP + l * WUP_BYTES); bf16* WO = (bf16*)(ws + WS_WOUT + l * WOUT_BYTES);
        if (r < I_A) { const int kb = r / (4224 / 32), nb = r % (4224 / 32); p0_transpose_item(w_in, DIN, 32 * nb, 64 * kb, g, WA, DM, 32 * nb, scr, F.lane); continue; } r -= I_A;
        if (r < I_V) { if (l == 1) p0_transpose_item(inp(a, 14), 32, 0, 64 * r, g, WA, DM, 4224, scr, F.lane); continue; } r -= I_V;
        if (r < I_B) { const int kb = r / (NBW / 32), nb = r % (NBW / 32); p0_transpose_item(w_in, DIN, 4224 + 32 * nb, 64 * kb, g, WB, DM, 32 * nb, scr, F.lane); continue; } r -= I_B;
        if (r < I_U) { const int kb = r / (DM / 32), nb = r % (DM / 32); p0_transpose_item(inp(a, 18) + (size_t)l * AW * DM, DM, 32 * nb, 64 * kb, nullptr, WU, AW, 32 * nb, scr, F.lane); continue; } r -= I_U;
        if (r < I_U) { const int kb = r / (DM / 32), nb = r % (DM / 32); p0_transpose_item(inp(a, 19) + (size_t)l * AW * DM, DM, 32 * nb, 64 * kb, nullptr, WU + (size_t)DM * AW, AW, 32 * nb, scr, F.lane); continue; } r -= I_U;
        { const int kb = r / (DM / 32), nb = r % (DM / 32); p0_transpose_item(inp(a, 20) + (size_t)l * DM * DM, DM, 32 * nb, 64 * kb, nullptr, WO, DM, 32 * nb, scr, F.lane); }
    }
    {
        const int gt = F.vcu * (NWAVES * 64) + F.tid, NT = F.G * NWAVES * 64;
        const int n0 = 128 * DM * 2 / 16, n1 = 96 * DM * 2 / 16;
        GAS v4u* z0 = (GAS v4u*)(ws + WS_WA + (size_t)4224 * DM * 2); GAS v4u* z1 = (GAS v4u*)(ws + WS_WA + WA_BYTES + (size_t)4256 * DM * 2);
        for (int i = gt; i < n0; i += NT) z0[i] = (v4u){0u, 0u, 0u, 0u};
        for (int i = gt; i < n1; i += NT) z1[i] = (v4u){0u, 0u, 0u, 0u};
    }
    { const int gt = F.vcu * (NWAVES * 64) + F.tid, NT = F.G * NWAVES * 64; GAS v4u* z = (GAS v4u*)(ws + WS_KMEAN); for (int i = gt; i < 2 * NB * NBLK * AW * 4 / 16; i += NT) z[i] = (v4u){0u, 0u, 0u, 0u}; }
    const float* x = inp(a, 0); bf16* XB = (bf16*)(ws + WS_XB); float* rinv = (float*)(ws + WS_RINV);
    for (int m = gw; m < M; m += NGW) row_to_bf16_rinv(x + (size_t)m * DM, XB + (size_t)m * DM, rinv + m, F.lane);
}

__device__ __forceinline__ void norm_phase(Frame& F, const Args& a, int l) {
    const int gw = F.vcu * NWAVES + F.wave, NGW = F.G * NWAVES, lane = F.lane;
    const float* Y = (const float*)(a.ws + WS_Y); const float* xold = (l == 0) ? inp(a, 0) : a.out; const float* gp = inp(a, 2) + l * DM;
    bf16* XB = (bf16*)(a.ws + WS_XB); float* rinv = (float*)(a.ws + WS_RINV);
    f32x4 gv[4];
#pragma unroll
    for (int j = 0; j < 4; ++j) gv[j] = ((const f32x4*)gp)[lane + 64 * j];
    for (int m = gw; m < M; m += NGW) {
        const f32x4* yr = (const f32x4*)(Y + (size_t)m * DM) + lane; const f32x4* xr = (const f32x4*)(xold + (size_t)m * DM) + lane;
        f32x4 y[4], x[4]; float s = 0.f;
#pragma unroll
        for (int j = 0; j < 4; ++j) { y[j] = yr[64 * j]; x[j] = xr[64 * j]; s += (y[j].x * y[j].x + y[j].y * y[j].y) + (y[j].z * y[j].z + y[j].w * y[j].w); }
        const float ry = 1.0f / sqrtf(wave_sum(s) * (1.0f / DM) + RMS_EPS); float s2 = 0.f;
#pragma unroll
        for (int j = 0; j < 4; ++j) { x[j] = x[j] + y[j] * ry * gv[j]; s2 += (x[j].x * x[j].x + x[j].y * x[j].y) + (x[j].z * x[j].z + x[j].w * x[j].w); }
        f32x4* orow = (f32x4*)(a.out + (size_t)m * DM) + lane;
#pragma unroll
        for (int j = 0; j < 4; ++j) orow[64 * j] = x[j];
        if (l == 0) {
            s2 = wave_sum(s2);
            GAS unsigned long long* o8 = (GAS unsigned long long*)(XB + (size_t)m * DM) + lane;
#pragma unroll
            for (int j = 0; j < 4; ++j) o8[64 * j] = (unsigned long long)pk2(x[j].x, x[j].y) | ((unsigned long long)pk2(x[j].z, x[j].w) << 32);
            if (lane == 0) rinv[m] = 1.0f / sqrtf(s2 * (1.0f / DM) + RMS_EPS);
        }
    }
}

__global__ void __launch_bounds__(NWAVES * 64, 2) mk_fwd(Args args) {
    extern __shared__ __attribute__((aligned(16))) unsigned char lds[];
    Frame F;
    F.lds = (LAS unsigned char*)lds;
    F.MISC = (volatile LAS unsigned*)(F.lds + MISC_OFF);
    F.tid = threadIdx.x; F.lane = F.tid & 63; F.wave = __builtin_amdgcn_readfirstlane(F.tid >> 6);
    F.G = gridDim.x; { const int bx = blockIdx.x; F.vcu = (F.G % 8 == 0) ? (bx % 8) * (F.G / 8) + bx / 8 : bx; }
    const int vcu0 = F.vcu;
    unsigned char* ws = args.ws;
    F.ctl = (gu32*)(ws + WS_CTL);
    for (int u = F.tid; u < (LDS_BYTES - LDSCTL_OFF) / 4; u += NWAVES * 64) ((LAS unsigned*)(F.lds + LDSCTL_OFF))[u] = 0u;
    __syncthreads();
    XcdBarrier bar; bar.bar = (unsigned*)(F.ctl + CW_BAR); bar.x = 0; bar.st = nullptr;
    const bool use_bar = (args.ph_hi - args.ph_lo) > 1;
    if (use_bar) bar = xcd_barrier_post((unsigned*)(F.ctl + CW_BAR), F.MISC + 8);

#ifndef PROBE_SP
#define PROBE_SP (-1)
#endif
#ifndef PROBE_REP
#define PROBE_REP 1
#endif
    int ph_ = args.ph_lo, rep_ = 0;
    while (ph_ < args.ph_hi) {
        int ph = ph_, rep = rep_; asm volatile("" : "+s"(ph), "+s"(rep));
        { int t_ = threadIdx.x; asm volatile("" : "+v"(t_)); F.tid = t_; F.lane = t_ & 63; F.wave = __builtin_amdgcn_readfirstlane(t_ >> 6); int g_ = gridDim.x, v_ = vcu0; asm volatile("" : "+s"(g_), "+s"(v_)); F.G = g_; F.vcu = v_; }
        const bool dry = rep > 0;
        if (ph == 0) p0_prologue(F, args);
        else {
            const int l = (ph - 1) / NPH_LAYER, sp = (ph - 1) % NPH_LAYER;
            const float* rinv = (const float*)(ws + WS_RINV);
            pg8::bf16_t* XB = (pg8::bf16_t*)(ws + WS_XB);
            if (sp == 0) {
                pg8::Gemm g{XB, (const pg8::bf16_t*)(ws + WS_WA + l * WA_BYTES), M, NA, DM}; pg8::StaticOrder S; S.init(M, NA, F.G, (int)blockIdx.x);
                pg8::EpiProjA E{rinv, (pg8::bf16_t*)(ws + WS_Q), (float*)(ws + WS_KMEAN) + (size_t)l * NB * NBLK * AW};
                pg8::gemm_phase<pg8::EpiProjA, pg8::StaticOrder, true, true>(F.lds + RING_OFF, g, S, E);
            } else if (sp >= 1 && sp <= 3) {
                rw7::Ctx C; C.tid = F.tid; C.lane = F.lane; C.wave = F.wave; C.vcu = F.vcu; C.G = F.G; C.layer = l; C.dry = dry; C.lds = (rw7::ldsp)(F.lds + RING_OFF); C.ws = ws; C.a = &args;
                if (sp == 1) {
                    att::moba_phase(F.tid, F.vcu, F.G, (unsigned short*)(ws + WS_Q), (const unsigned short*)(ws + WS_K), (const unsigned short*)(ws + WS_V), (const unsigned short*)(ws + WS_AZ), (const float*)(ws + WS_KMEAN) + (size_t)l * NB * NBLK * AW, (att::lds_cptr)(F.lds + RING_OFF), dry);
                    rw7::pass1(C);
                } else if (sp == 2) rw7::pass2(C); else rw7::pass3(C);
            }
            else if (sp == 4) {
                pg8::Gemm g{XB, (const pg8::bf16_t*)(ws + WS_WB + l * WB_BYTES), M, NBW, DM}; pg8::StaticOrder S; S.init(M, NBW, F.G, (int)blockIdx.x);
                pg8::EpiProjB E{rinv, (pg8::bf16_t*)(ws + WS_GA), (pg8::bf16_t*)(ws + WS_GR)};
                pg8::gemm_phase<pg8::EpiProjB, pg8::StaticOrder, true, true>(F.lds + RING_OFF, g, S, E);
            } else if (sp == 5) {
                pg8::Gemm g{(const pg8::bf16_t*)(ws + WS_Q), (const pg8::bf16_t*)(ws + WS_WUP + l * WUP_BYTES), M, DM, AW}; pg8::StaticOrder S; S.init(M, DM, F.G, (int)blockIdx.x);
                pg8::EpiUp<false> E{(const pg8::bf16_t*)(ws + WS_GA), (pg8::bf16_t*)(ws + WS_U)};
                pg8::gemm_phase<pg8::EpiUp<false>, pg8::StaticOrder, true, true>(F.lds + RING_OFF, g, S, E);
            } else if (sp == 6) {
                pg8::Gemm g{(const pg8::bf16_t*)(ws + WS_RZ), (const pg8::bf16_t*)(ws + WS_WUP + l * WUP_BYTES + (size_t)DM * AW * 2), M, DM, AW}; pg8::StaticOrder S; S.init(M, DM, F.G, (int)blockIdx.x);
                pg8::EpiUp<true> E{(const pg8::bf16_t*)(ws + WS_GR), (pg8::bf16_t*)(ws + WS_U)};
                pg8::gemm_phase<pg8::EpiUp<true>, pg8::StaticOrder, true, true>(F.lds + RING_OFF, g, S, E);
            } else if (sp == 7) {
                pg8::Gemm g{(const pg8::bf16_t*)(ws + WS_U), (const pg8::bf16_t*)(ws + WS_WOUT + l * WOUT_BYTES), M, DM, DM}; pg8::StaticOrder S; S.init(M, DM, F.G, (int)blockIdx.x);
                pg8::EpiF32 E{(float*)(ws + WS_Y), DM};
                pg8::gemm_phase<pg8::EpiF32, pg8::StaticOrder, true, true>(F.lds + RING_OFF, g, S, E);
            } else norm_phase(F, args, l);
        }
        if (ph_ > 0 && (ph_ - 1) % NPH_LAYER == PROBE_SP && rep_ < PROBE_REP) ++rep_; else { ++ph_; rep_ = 0; }
        if (ph_ < args.ph_hi) xcd_barrier(bar);
    }
}

extern "C" void kernel_launch(void* const* d_in, const int* in_sizes, int n_in, void* d_out, int out_size, void* d_ws, size_t ws_size, hipStream_t stream) {
    static int grid = 0;
    if (grid == 0) {
        if (n_in != 21 || in_sizes[0] != M * DM || out_size != M * DM || ws_size < WS_END) { fprintf(stderr, "kernel_launch: unexpected shapes (n_in %d, in0 %d, out %d, ws %zu); nothing launched\n", n_in, n_in > 0 ? in_sizes[0] : -1, out_size, ws_size); grid = -1; return; }
        int dev = 0, cus = 0;
        if (hipGetDevice(&dev) != hipSuccess || hipDeviceGetAttribute(&cus, hipDeviceAttributeMultiprocessorCount, dev) != hipSuccess) { grid = -1; return; }
        if (hipFuncSetAttribute((const void*)mk_fwd, hipFuncAttributeMaxDynamicSharedMemorySize, LDS_BYTES) != hipSuccess) { fprintf(stderr, "kernel_launch: hipFuncSetAttribute failed\n"); grid = -1; return; }
        (void)hipGetLastError();
        grid = cus;
    }
    if (grid < 0) return;
    if (hipMemsetAsync((char*)d_ws + WS_CTL, 0, CTL_ZERO_BYTES, stream) != hipSuccess) return;
    Args a{};
    for (int i = 0; i < 21; ++i) a.in[i] = (const float*)d_in[i];
    a.out = (float*)d_out; a.ws = (unsigned char*)d_ws;
#if MK_SINGLE
    a.ph_lo = 0; a.ph_hi = NPHASE;
    hipLaunchKernelGGL(mk_fwd, dim3(grid), dim3(NWAVES * 64), LDS_BYTES, stream, a);
#else
    for (int p = 0; p < NPHASE; ++p) { a.ph_lo = p; a.ph_hi = p + 1; hipLaunchKernelGGL(mk_fwd, dim3(grid), dim3(NWAVES * 64), LDS_BYTES, stream, a); }
#endif
}
```
